# Optimizing an MI355X kernel written in HIP

```python
import math
import jax
import jax.numpy as jnp
from jax import lax
import numpy as np

D_MODEL = 1024
BATCH = 2
SEQ = 8192
DEPTH = 4

EPS = 1e-6
MIX_HALF = D_MODEL // 2
N_EVEN = (DEPTH + 1) // 2
N_ODD = DEPTH // 2
HG_DK = 128
HG_HEADS = MIX_HALF // HG_DK
HG_WIDTH = HG_HEADS * HG_DK
HG_CHUNK = 64
M2_HEADDIM = 64
M2_HEADS = MIX_HALF // M2_HEADDIM
M2_INNER = M2_HEADS * M2_HEADDIM
M2_GROUPS = 2
M2_STATE = 128
M2_CONV = 5
M2_CHUNK = 128
M2_XBC = M2_INNER + 2 * M2_GROUPS * M2_STATE
RW_HEADSIZE = 64
RW_HEADS = MIX_HALF // RW_HEADSIZE
RW_WIDTH = RW_HEADS * RW_HEADSIZE
RW_DECAY_LORA = 32
RW_ICLR_LORA = 32
RW_GATE_LORA = 96
RW_LN_EPS = 64e-5
S5_GROUP_CH = 16
S5_GROUPS = MIX_HALF // S5_GROUP_CH
S5_WIDTH = S5_GROUPS * S5_GROUP_CH
S5_STATE = 64
D_FF = ((8 * D_MODEL + 3 * 256 - 1) // (3 * 256)) * 256

EVEN_SPLITS = (HG_WIDTH,) * 5 + (M2_INNER, M2_XBC, M2_HEADS, M2_HEADS)
EVEN_IN = sum(EVEN_SPLITS)
RW_SPLITS = (RW_WIDTH,) * 3 + (RW_DECAY_LORA,) * 2 + (RW_ICLR_LORA,) * 2 + (RW_GATE_LORA,)
RW_IN = sum(RW_SPLITS)
ODD_IN = RW_IN + S5_WIDTH
EVEN_MIX = HG_WIDTH + M2_INNER
ODD_MIX = RW_WIDTH + S5_WIDTH

kernel_name = 'hybrid_bidir_hgrn2_ssd_rwkv7_s5'


def _rmsnorm(x, w):
    x32 = x.astype(jnp.float32)
    y = x32 * lax.rsqrt(jnp.mean(x32 * x32, axis=-1, keepdims=True) + EPS)
    return (y * w.astype(jnp.float32)).astype(x.dtype)


def _split(t, sizes):
    return jnp.split(t, [int(s) for s in np.cumsum(sizes)[:-1]], axis=-1)


def _swiglu(h, w_in, w_out):
    gate, up = jnp.split(h @ w_in, 2, axis=-1)
    return (jax.nn.silu(gate) * up) @ w_out


def _both(t_fwd, t_bwd):
    return jnp.stack([t_fwd, jnp.flip(t_bwd, axis=1)])


def _unboth(y):
    return y[0] + jnp.flip(y[1], axis=1)


def _masked_exp(diff, mask):
    return jnp.where(mask, jnp.exp(jnp.where(mask, diff, 0.0)), 0.0)


def _gla_chunk_scan(q, k, v, g):
    z, bsz, seq, nh, dk = q.shape
    dv = v.shape[-1]
    c = HG_CHUNK
    n = seq // c
    to_chunks = lambda t: t.reshape(z, bsz, n, c, nh, t.shape[-1]).transpose(2, 0, 1, 4, 3, 5)
    incl = jnp.tril(jnp.ones((c, c), bool))[:, :, None]

    def step(state, inp):
        qc, kc, vc, gc = inp
        bcs = jnp.cumsum(gc, axis=-2)
        b_last = bcs[..., -1:, :]
        o_inter = jnp.einsum('zbhik,zbhkv->zbhiv', qc * jnp.exp(bcs), state)
        rel = _masked_exp(bcs[..., :, None, :] - bcs[..., None, :, :], incl)
        scores = jnp.einsum('zbhijk,zbhjk->zbhij', qc[..., :, None, :] * rel, kc)
        o = o_inter + jnp.einsum('zbhij,zbhjv->zbhiv', scores, vc)
        state = jnp.exp(b_last[..., 0, :])[..., :, None] * state + jnp.einsum('zbhjk,zbhjv->zbhkv', kc * jnp.exp(b_last - bcs), vc)
        return state, o

    state0 = jnp.zeros((z, bsz, nh, dk, dv), q.dtype)
    _, o = lax.scan(step, state0, (to_chunks(q), to_chunks(k), to_chunks(v), to_chunks(g)))
    return o.transpose(1, 2, 0, 4, 3, 5).reshape(z, bsz, seq, nh, dv)


def _hgrn2_mixer(q, f_f, f_b, i, gate, lb, norm_w):
    f32 = jnp.float32
    bsz, seq, _ = q.shape
    heads = lambda t: t.astype(f32).reshape(bsz, seq, HG_HEADS, HG_DK)
    lb = lb.astype(f32)
    def log_forget(f):
        u = f.astype(f32)
        return heads(jax.nn.log_sigmoid(u) + jnp.log1p(lb * jnp.exp(-u)))
    qh = heads(jax.nn.silu(q.astype(f32))) * HG_DK ** -0.5
    vh = heads(i)
    g = _both(log_forget(f_f), log_forget(f_b))
    o = _unboth(_gla_chunk_scan(_both(qh, qh), -jnp.expm1(g), _both(vh, vh), g))
    o = o * lax.rsqrt(jnp.mean(o * o, axis=-1, keepdims=True) + EPS) * norm_w.astype(f32)
    return o.reshape(bsz, seq, HG_WIDTH) * jax.nn.silu(gate.astype(f32))


def _segsum_exp(a):
    t = a.shape[-1]
    a_rep = jnp.broadcast_to(a[..., :, None], a.shape + (t,))
    ss = jnp.cumsum(jnp.where(jnp.tril(jnp.ones((t, t), bool), -1), a_rep, 0.0), axis=-2)
    return _masked_exp(ss, jnp.tril(jnp.ones((t, t), bool)))


def _ssd(x, dt, a, b_in, c_out):
    bsz, seq, nh, hd = x.shape
    grp = b_in.shape[2]
    rep = nh // grp
    s = M2_CHUNK
    nc = seq // s
    x = x.reshape(bsz, nc, s, grp, rep, hd)
    dt = dt.reshape(bsz, nc, s, grp, rep)
    b_in = b_in.reshape(bsz, nc, s, grp, -1)
    c_out = c_out.reshape(bsz, nc, s, grp, -1)
    da = jnp.moveaxis(dt * a.reshape(grp, rep), 2, -1)
    a_cs = jnp.cumsum(da, axis=-1)
    xdt = x * dt[..., None]
    cb = jnp.einsum('bcsgn,bctgn->bcgst', c_out, b_in)
    y_diag = jnp.einsum('bcgrst,bctgrp->bcsgrp', cb[:, :, :, None] * _segsum_exp(da), xdt)
    states = jnp.einsum('bcsgn,bcgrs,bcsgrp->bcgrpn', b_in, jnp.exp(a_cs[..., -1:] - a_cs), xdt)
    states = jnp.concatenate([jnp.zeros_like(states[:, :1]), states], axis=1)
    chunk_tot = jnp.pad(jnp.moveaxis(a_cs[..., -1], 1, -1), ((0, 0), (0, 0), (0, 0), (1, 0)))
    states_in = jnp.einsum('bgrzc,bcgrpn->bzgrpn', _segsum_exp(chunk_tot), states)[:, :-1]
    y_off = jnp.einsum('bcsgn,bcgrpn,bcgrs->bcsgrp', c_out, states_in, jnp.exp(a_cs))
    return (y_diag + y_off).reshape(bsz, seq, nh, hd)


def _mamba2_mixer(z, xbc, dt_f, dt_b, conv_w, conv_b, dt_bias, a_log, d_skip, norm_w):
    f32 = jnp.float32
    bsz, seq, _ = z.shape
    pad = M2_CONV // 2
    xbc = lax.conv_general_dilated(xbc, conv_w[:, None, :].astype(xbc.dtype), window_strides=(1,),
                                   padding=[(pad, pad)], dimension_numbers=('NWC', 'WIO', 'NWC'),
                                   feature_group_count=xbc.shape[-1])
    xbc = jax.nn.silu(xbc.astype(f32) + conv_b.astype(f32))
    xs, b_in, c_out = _split(xbc, (M2_INNER, M2_GROUPS * M2_STATE, M2_GROUPS * M2_STATE))
    xs = xs.reshape(bsz, seq, M2_HEADS, M2_HEADDIM)
    b_in = b_in.reshape(bsz, seq, M2_GROUPS, M2_STATE)
    c_out = c_out.reshape(bsz, seq, M2_GROUPS, M2_STATE)
    a = -jnp.exp(a_log.astype(f32))
    dt_bias = dt_bias.astype(f32)
    dtf = jax.nn.softplus(dt_f.astype(f32) + dt_bias[0])
    dtb = jax.nn.softplus(dt_b.astype(f32) + dt_bias[1])
    flip = lambda t: jnp.flip(t, axis=1)
    y = (_ssd(xs, dtf, a[0], b_in, c_out)
         + flip(_ssd(flip(xs), flip(dtb), a[1], flip(b_in), flip(c_out)))
         + xs * d_skip.astype(f32)[:, None])
    y = (y.reshape(bsz, seq, M2_INNER) * jax.nn.silu(z.astype(f32))).reshape(bsz, seq, M2_GROUPS, M2_INNER // M2_GROUPS)
    y = y * lax.rsqrt(jnp.mean(y * y, axis=-1, keepdims=True) + EPS)
    return y.reshape(bsz, seq, M2_INNER) * norm_w.astype(f32)


def _token_shift_bidir(h, mu):
    prev = jnp.pad(h[:, :-1], ((0, 0), (1, 0), (0, 0)))
    nxt = jnp.pad(h[:, 1:], ((0, 0), (0, 1), (0, 0)))
    return h + (prev - h) * mu[0] + (nxt - h) * mu[1]


def _rwkv7_scan(r, w, k, v, kk, b):
    def step(state, inp):
        r_t, w_t, k_t, v_t, kk_t, b_t = inp
        sa = jnp.einsum('zbhvk,zbhk->zbhv', state, -kk_t)
        state = state * w_t[..., None, :] + sa[..., :, None] * b_t[..., None, :] + v_t[..., :, None] * k_t[..., None, :]
        return state, jnp.einsum('zbhvk,zbhk->zbhv', state, r_t)

    z, bsz, _, nh, n = r.shape
    seq_major = lambda t: jnp.moveaxis(t, 2, 0)
    state0 = jnp.zeros((z, bsz, nh, n, n), r.dtype)
    _, y = lax.scan(step, state0, (seq_major(r), seq_major(w), seq_major(k), seq_major(v), seq_major(kk), seq_major(b)))
    return jnp.moveaxis(y, 0, 2)


def _rwkv7_mixer(p, mu, w0, w2, a0, a2, g2, k_k, k_a, r_k, ln_w, ln_b):
    f32 = jnp.float32
    bsz, seq, _ = p.shape
    p = _token_shift_bidir(p.astype(f32), mu.astype(f32))
    r, k, v, wl_f, wl_b, al_f, al_b, gl = _split(p, RW_SPLITS)
    w0, w2, a0, a2 = w0.astype(f32), w2.astype(f32), a0.astype(f32), a2.astype(f32)
    decay = lambda wl, d0, d2: jnp.exp(-jnp.exp(-jax.nn.softplus(-(d0 + jnp.tanh(wl) @ d2)) - 0.5))
    w_f, w_b = decay(wl_f, w0[0], w2[0]), decay(wl_b, w0[1], w2[1])
    a_f = jax.nn.sigmoid(a0[0] + al_f @ a2[0])
    a_b = jax.nn.sigmoid(a0[1] + al_b @ a2[1])
    g = jax.nn.sigmoid(gl) @ g2.astype(f32)
    heads = lambda t: t.reshape(bsz, seq, RW_HEADS, RW_HEADSIZE)
    kk = heads(k * k_k.astype(f32))
    kk = kk / jnp.maximum(jnp.sqrt(jnp.sum(kk * kk, axis=-1, keepdims=True)), 1e-12)
    k_a = k_a.astype(f32)
    k_f, k_b = k * (1.0 + (a_f - 1.0) * k_a), k * (1.0 + (a_b - 1.0) * k_a)
    y = _unboth(_rwkv7_scan(_both(heads(r), heads(r)), _both(heads(w_f), heads(w_b)),
                            _both(heads(k_f), heads(k_b)), _both(heads(v), heads(v)),
                            _both(kk, kk), _both(kk * heads(a_f), kk * heads(a_b))))
    mean = jnp.mean(y, axis=-1, keepdims=True)
    var = jnp.mean(jnp.square(y - mean), axis=-1, keepdims=True)
    y = ((y - mean) * lax.rsqrt(var + RW_LN_EPS)).reshape(bsz, seq, RW_WIDTH) * ln_w.astype(f32) + ln_b.astype(f32)
    bonus = jnp.sum(heads(r) * heads(k_f + k_b) * r_k.astype(f32), axis=-1, keepdims=True) * heads(v)
    return (y + bonus.reshape(bsz, seq, RW_WIDTH)) * g


def _lin_rec(e1, e2):
    a1, b1 = e1
    a2, b2 = e2
    return a2 * a1, a2 * b1 + b2


def _s5_mixer(u, a_re, a_im, b_re, b_im, c_re, c_im, d_skip, log_step, glu_w, glu_b):
    f32 = jnp.float32
    bsz, seq, _ = u.shape
    u32 = u.astype(f32).reshape(bsz, seq, S5_GROUPS, S5_GROUP_CH)
    lam = lax.complex(a_re.astype(f32), a_im.astype(f32))
    b_mat = lax.complex(b_re.astype(f32), b_im.astype(f32))
    c_mat = lax.complex(c_re.astype(f32), c_im.astype(f32))

    def one_direction(step_log, c_dir, reverse):
        lam_bar = jnp.exp(lam * jnp.exp(step_log.astype(f32))[:, None])
        b_bar = ((lam_bar - 1.0) / lam)[..., None] * b_mat
        bu = jnp.einsum('gpi,blgi->blgp', b_bar, u32.astype(b_bar.dtype))
        _, states = lax.associative_scan(_lin_rec, (jnp.broadcast_to(lam_bar, bu.shape), bu), reverse=reverse, axis=1)
        return jnp.einsum('gip,blgp->blgi', c_dir, states).real

    y = (one_direction(log_step[0], c_mat[0], False) + one_direction(log_step[1], c_mat[1], True)
         + u32 * d_skip.astype(f32).reshape(S5_GROUPS, S5_GROUP_CH))
    y = jax.nn.gelu(y.reshape(bsz, seq, S5_WIDTH))
    return y * jax.nn.sigmoid(y @ glu_w.astype(f32) + glu_b.astype(f32))


def _even_mixer(h, w_in, w_out, lb, hg_norm_w, conv_w, conv_b, dt_bias, a_log, d_skip, m2_norm_w):
    q, f_f, f_b, i, gate, z, xbc, dt_f, dt_b = _split(h @ w_in, EVEN_SPLITS)
    o_a = _hgrn2_mixer(q, f_f, f_b, i, gate, lb, hg_norm_w)
    o_b = _mamba2_mixer(z, xbc, dt_f, dt_b, conv_w, conv_b, dt_bias, a_log, d_skip, m2_norm_w)
    return (jnp.concatenate([o_a, o_b], axis=-1) @ w_out).astype(h.dtype)


def _odd_mixer(h, w_in, w_out, mu, w0, w2, a0, a2, g2, k_k, k_a, r_k, ln_w, ln_b,
               a_re, a_im, b_re, b_im, c_re, c_im, d_skip, log_step, glu_w, glu_b):
    p = h @ w_in
    o_c = _rwkv7_mixer(p[..., :RW_IN], mu, w0, w2, a0, a2, g2, k_k, k_a, r_k, ln_w, ln_b)
    o_d = _s5_mixer(p[..., RW_IN:], a_re, a_im, b_re, b_im, c_re, c_im, d_skip, log_step, glu_w, glu_b)
    return (jnp.concatenate([o_c, o_d], axis=-1) @ w_out).astype(h.dtype)


def setup_inputs(seed: int = 0) -> dict:
    key = jax.random.key(seed)
    ks = iter(jax.random.split(key, 64))
    nrm = lambda shape, scale: scale * jax.random.normal(next(ks), shape, jnp.float32)
    unif = lambda shape, lo, hi: jax.random.uniform(next(ks), shape, jnp.float32, lo, hi)
    E, O, D = N_EVEN, N_ODD, D_MODEL
    dt0 = jnp.exp(unif((E, 2, M2_HEADS), math.log(1e-3), math.log(1e-1)))
    return {
        'x': nrm((BATCH, SEQ, D), 1.0),
        'norm_mix_w': 1.0 + nrm((DEPTH, D), 0.02),
        'norm_ffn_w': 1.0 + nrm((DEPTH, D), 0.02),
        'norm_final_w': 1.0 + nrm((D,), 0.02),
        'ffn_w_in': nrm((DEPTH, D, 2 * D_FF), D ** -0.5),
        'ffn_w_out': nrm((DEPTH, D_FF, D), D_FF ** -0.5),
        'ev_w_in': nrm((E, D, EVEN_IN), D ** -0.5),
        'ev_w_out': nrm((E, EVEN_MIX, D), EVEN_MIX ** -0.5),
        'hg_lb_param': nrm((E, HG_WIDTH), 1.0),
        'hg_norm_w': 1.0 + nrm((E, HG_DK), 0.02),
        'm2_conv_w': nrm((E, M2_CONV, M2_XBC), M2_CONV ** -0.5),
        'm2_conv_b': nrm((E, M2_XBC), 0.02),
        'm2_dt_bias': dt0 + jnp.log(-jnp.expm1(-dt0)),
        'm2_a_log': jnp.log(unif((E, 2, M2_HEADS), 1.0, 16.0)),
        'm2_d': 1.0 + nrm((E, M2_HEADS), 0.02),
        'm2_norm_w': 1.0 + nrm((E, M2_INNER), 0.02),
        'od_w_in': nrm((O, D, ODD_IN), D ** -0.5),
        'od_w_out': nrm((O, ODD_MIX, D), ODD_MIX ** -0.5),
        'rw_mu': unif((O, 2, RW_IN), 0.0, 0.5),
        'rw_w0': unif((O, 2, RW_WIDTH), -6.0, -1.0),
        'rw_w2': nrm((O, 2, RW_DECAY_LORA, RW_WIDTH), 0.5 * RW_DECAY_LORA ** -0.5),
        'rw_a0': nrm((O, 2, RW_WIDTH), 0.1),
        'rw_a2': nrm((O, 2, RW_ICLR_LORA, RW_WIDTH), 0.5 * RW_ICLR_LORA ** -0.5),
        'rw_g2': nrm((O, RW_GATE_LORA, RW_WIDTH), RW_GATE_LORA ** -0.5),
        'rw_k_k': 0.85 + nrm((O, RW_WIDTH), 0.02),
        'rw_k_a': 1.0 + nrm((O, RW_WIDTH), 0.02),
        'rw_r_k': nrm((O, RW_HEADS, RW_HEADSIZE), 0.1),
        'rw_ln_w': 1.0 + nrm((O, RW_WIDTH), 0.02),
        'rw_ln_b': nrm((O, RW_WIDTH), 0.02),
        's5_a_re': -0.5 + nrm((O, S5_GROUPS, S5_STATE), 0.01),
        's5_a_im': jnp.pi * jnp.arange(S5_STATE, dtype=jnp.float32) + nrm((O, S5_GROUPS, S5_STATE), 0.01),
        's5_b_re': nrm((O, S5_GROUPS, S5_STATE, S5_GROUP_CH), (2 * S5_GROUP_CH) ** -0.5),
        's5_b_im': nrm((O, S5_GROUPS, S5_STATE, S5_GROUP_CH), (2 * S5_GROUP_CH) ** -0.5),
        's5_c_re': nrm((O, 2, S5_GROUPS, S5_GROUP_CH, S5_STATE), S5_STATE ** -0.5),
        's5_c_im': nrm((O, 2, S5_GROUPS, S5_GROUP_CH, S5_STATE), S5_STATE ** -0.5),
        's5_d': nrm((O, S5_WIDTH), 1.0),
        's5_log_step': unif((O, 2, S5_GROUPS), math.log(1e-3), math.log(1e-1)),
        's5_glu_w': nrm((O, S5_WIDTH, S5_WIDTH), S5_WIDTH ** -0.5),
        's5_glu_b': nrm((O, S5_WIDTH), 0.02),
    }


def reference(x, norm_mix_w, norm_ffn_w, norm_final_w, ffn_w_in, ffn_w_out,
              ev_w_in, ev_w_out, hg_lb_param, hg_norm_w, m2_conv_w, m2_conv_b, m2_dt_bias, m2_a_log, m2_d, m2_norm_w,
              od_w_in, od_w_out, rw_mu, rw_w0, rw_w2, rw_a0, rw_a2, rw_g2, rw_k_k, rw_k_a, rw_r_k, rw_ln_w, rw_ln_b,
              s5_a_re, s5_a_im, s5_b_re, s5_b_im, s5_c_re, s5_c_im, s5_d, s5_log_step, s5_glu_w, s5_glu_b):
    lb_w = jax.nn.softmax(hg_lb_param.astype(jnp.float32), axis=0)
    lower_bounds = jnp.cumsum(lb_w, axis=0) - lb_w[0]
    h = x
    for layer in range(DEPTH):
        j = layer // 2
        hn = _rmsnorm(h, norm_mix_w[layer])
        if layer % 2 == 0:
            mix = _even_mixer(hn, ev_w_in[j], ev_w_out[j], lower_bounds[j], hg_norm_w[j], m2_conv_w[j], m2_conv_b[j],
                              m2_dt_bias[j], m2_a_log[j], m2_d[j], m2_norm_w[j])
        else:
            mix = _odd_mixer(hn, od_w_in[j], od_w_out[j], rw_mu[j], rw_w0[j], rw_w2[j], rw_a0[j], rw_a2[j], rw_g2[j],
                             rw_k_k[j], rw_k_a[j], rw_r_k[j], rw_ln_w[j], rw_ln_b[j],
                             s5_a_re[j], s5_a_im[j], s5_b_re[j], s5_b_im[j], s5_c_re[j], s5_c_im[j],
                             s5_d[j], s5_log_step[j], s5_glu_w[j], s5_glu_b[j])
        h = h + mix
        h = h + _swiglu(_rmsnorm(h, norm_ffn_w[layer]), ffn_w_in[layer], ffn_w_out[layer]).astype(h.dtype)
    return _rmsnorm(h, norm_final_w)
```

```cpp
#include <hip/hip_runtime.h>
#include <hip/hip_cooperative_groups.h>
#include <cstdio>
#include <cstdint>
namespace cg = cooperative_groups;
#ifndef ONE_LAUNCH
#define ONE_LAUNCH 1
#endif
__device__ __forceinline__ int otid() { int t = threadIdx.x; asm volatile("" : "+v"(t)); return t; }
__device__ __forceinline__ int obid() { int b = blockIdx.x; asm volatile("" : "+s"(b)); return b; }
namespace pg8 {
#define PG8_LAS __attribute__((address_space(3)))
typedef unsigned short bf16_t;
typedef short bf16x8 __attribute__((ext_vector_type(8)));
typedef float f32x4 __attribute__((ext_vector_type(4)));
typedef unsigned u32x4 __attribute__((ext_vector_type(4)));
constexpr int BM = 256, BK = 64, HALF = 128, HTB = HALF * BK * 2  , STAGE_BYTES = 8 * HTB, NXCD = 8, WGM = 8;

__host__ __device__ __forceinline__ int lds_byte(int r, int c) { const int st = (r >> 4) * 2 + (c >> 5), rr = r & 15, cc = c & 31, ob = rr * 64 + cc * 2; return st * 1024 + (ob ^ (((ob >> 9) & 1) << 5)); }
__host__ __device__ __forceinline__ void stage_rc(int b, int& R, int& C) { const int st = b / 1024, sb = b % 1024, swz = sb ^ (((sb >> 9) & 1) << 5); R = (st >> 1) * 16 + swz / 64; C = (st & 1) * 32 + (swz % 64) / 2; }
__host__ __device__ __forceinline__ int perm32(int rho) { const int n = rho >> 4, i = rho & 15; return 8 * (i >> 2) + 4 * n + (i & 3); }

struct Unit { int pm, pn; };
struct Gemm { const bf16_t* A; const bf16_t* Bt; int M, N, K, lda, ldb; };

struct StaticOrder {
    int nM, nN, nwg, G, c;
    __host__ __device__ void init(int M, int N, int G_, int c_) { nM = M / BM; nN = N / BM; nwg = nM * nN; G = G_; c = c_; }
    __host__ __device__ bool next(int i, Unit& u) const {
        const long L = (long)i * G + c; if (L >= nwg) return false;
        int wgid = (int)L; { const int q = nwg / NXCD, r = nwg % NXCD, xcd = wgid % NXCD, off = wgid / NXCD; wgid = (xcd < r ? xcd * (q + 1) : r * (q + 1) + (xcd - r) * q) + off; }
        const int nig = WGM * nN, gid = wgid / nig, fm = gid * WGM, gsz = (nM - fm) < WGM ? (nM - fm) : WGM;
        u.pm = fm + ((wgid % nig) % gsz); u.pn = (wgid % nig) / gsz; return true;
    }
    __device__ __forceinline__ void a_ready(const Unit&) const {}
    __device__ __forceinline__ void done(const Unit&) const {}
};
template <class Epi, class Sched, bool ALIGN_EPI = false, bool SP2 = false>
__device__ __forceinline__ void gemm_phase(PG8_LAS unsigned char* lds, const Gemm g, const Sched& S, const Epi& E) {
    const int tid = otid(), wid = __builtin_amdgcn_readfirstlane(tid >> 6), lane = tid & 63, wr = wid >> 2, wc = wid & 3, fr = lane & 15, fq = lane >> 4;
    const int K = g.K, nt = K / BK;
    unsigned voffA[2], voffB[2];
#pragma unroll
    for (int i = 0; i < 2; ++i) { int R, C; stage_rc(tid * 16 + i * 8192, R, C); const int Rb = Epi::PERM ? ((R & ~31) + perm32(R & 31)) : R;
        voffA[i] = (unsigned)(R * g.lda + C) * 2u; voffB[i] = (unsigned)(Rb * g.ldb + C) * 2u; }
    const size_t kstep = (size_t)(BK * 2);
    const size_t hstepA = (size_t)HALF * g.lda * 2, hstepB = (size_t)HALF * g.ldb * 2;
    const size_t tstepA = 2 * hstepA, tstepB = 2 * hstepB;
    const unsigned ldsw = (unsigned)wid * 1024u;
    const int aoff = lds_byte(wr * 64 + fr, fq * 8), boff = lds_byte(wc * 32 + fr, fq * 8);
#define PG8_SA(b, h) (((b) * 2 + (h)) * HTB)
#define PG8_SB(b, h) ((4 + (b) * 2 + (h)) * HTB)
#define PG8_STAGE(bufoff, gbase, voff) do { _Pragma("unroll") for (int _i = 0; _i < 2; ++_i) \
        __builtin_amdgcn_global_load_lds((const unsigned*)((const char*)(gbase) + (voff)[_i]), (PG8_LAS unsigned*)(lds + (bufoff) + ldsw + _i * 8192), 16, 0, 0); } while (0)
#define PG8_LDA(dst, b, h) do { _Pragma("unroll") for (int m = 0; m < 4; ++m) _Pragma("unroll") for (int k = 0; k < 2; ++k) dst[m][k] = *(const PG8_LAS bf16x8*)(lds + PG8_SA(b, h) + aoff + m * 2048 + k * 1024); } while (0)
#define PG8_LDB(dst, b, h) do { _Pragma("unroll") for (int n = 0; n < 2; ++n) _Pragma("unroll") for (int k = 0; k < 2; ++k) dst[n][k] = *(const PG8_LAS bf16x8*)(lds + PG8_SB(b, h) + boff + n * 2048 + k * 1024); } while (0)
#define PG8_MMA(ai, bj, At, Bt) do { __builtin_amdgcn_s_setprio(1); _Pragma("unroll") for (int m = 0; m < 4; ++m) _Pragma("unroll") for (int n = 0; n < 2; ++n) _Pragma("unroll") for (int k = 0; k < 2; ++k) \
        acc[ai][bj][m][n] = __builtin_amdgcn_mfma_f32_16x16x32_bf16(Bt[n][k], At[m][k], acc[ai][bj][m][n], 0, 0, 0); __builtin_amdgcn_s_setprio(0); } while (0)
#define PG8_WAIT_V(n) asm volatile("s_waitcnt vmcnt(" #n ")" ::: "memory")
#define PG8_WAIT_L(n) asm volatile("s_waitcnt lgkmcnt(" #n ")" ::: "memory")
#define PG8_BAR __builtin_amdgcn_s_barrier()
#define PG8_SCHED __builtin_amdgcn_sched_barrier(0)
    Unit cur, nxt; int ui = 0;
    if (!S.next(0, cur)) return;
    f32x4 acc[2][2][4][2];
#pragma unroll
    for (int a = 0; a < 2; ++a)
#pragma unroll
        for (int b = 0; b < 2; ++b)
#pragma unroll
            for (int m = 0; m < 4; ++m)
#pragma unroll
                for (int n = 0; n < 2; ++n) acc[a][b][m][n] = (f32x4){0.f, 0.f, 0.f, 0.f};
    bf16x8 At[4][2], B0[2][2], B1[2][2];
    const char* cA = (const char*)g.A + (size_t)cur.pm * tstepA; const char* cB = (const char*)g.Bt + (size_t)cur.pn * tstepB;
    S.a_ready(cur);
    if constexpr (SP2) {
        PG8_STAGE(PG8_SB(0, 0), cB, voffB); PG8_STAGE(PG8_SB(0, 1), cB + hstepB, voffB); PG8_STAGE(PG8_SA(0, 0), cA, voffA); PG8_STAGE(PG8_SA(0, 1), cA + hstepA, voffA);
        if (wr == 1) PG8_BAR;
        PG8_WAIT_V(2); PG8_BAR;
        PG8_STAGE(PG8_SB(1, 0), cB + kstep, voffB); PG8_STAGE(PG8_SA(1, 0), cA + kstep, voffA); PG8_STAGE(PG8_SB(1, 1), cB + hstepB + kstep, voffB);
        PG8_WAIT_V(6); PG8_BAR;
    } else {
        PG8_STAGE(PG8_SB(0, 0), cB, voffB); PG8_STAGE(PG8_SA(0, 0), cA, voffA); PG8_STAGE(PG8_SB(0, 1), cB + hstepB, voffB); PG8_STAGE(PG8_SA(0, 1), cA + hstepA, voffA);
        if (wr == 1) PG8_BAR;
        PG8_WAIT_V(4); PG8_BAR;
        PG8_STAGE(PG8_SB(1, 0), cB + kstep, voffB); PG8_STAGE(PG8_SA(1, 0), cA + kstep, voffA); PG8_STAGE(PG8_SB(1, 1), cB + hstepB + kstep, voffB);
        PG8_WAIT_V(6); PG8_BAR;
    }
    for (;;) {
        const bool has_next = S.next(ui + 1, nxt);
        const char* nA = has_next ? (const char*)g.A + (size_t)nxt.pm * tstepA : cA; const char* nB = has_next ? (const char*)g.Bt + (size_t)nxt.pn * tstepB : cB;
        for (int t = 0; t < nt; t += 2) {
            const bool last = (t == nt - 2);
            const char* a1 = cA + (size_t)(t + 1) * kstep;
            const char* a2 = last ? nA : cA + (size_t)(t + 2) * kstep; const char* b2 = last ? nB : cB + (size_t)(t + 2) * kstep;
            const char* a3 = a2 + kstep; const char* b3 = b2 + kstep;
            if (last && has_next) S.a_ready(nxt);
            if constexpr (SP2) {
            PG8_LDB(B0, 0, 0); PG8_LDB(B1, 0, 1); PG8_SCHED; PG8_LDA(At, 0, 0); PG8_STAGE(PG8_SA(1, 1), a1 + hstepA, voffA);
            PG8_WAIT_V(8); PG8_WAIT_L(0); PG8_BAR; PG8_MMA(0, 0, At, B0); PG8_MMA(0, 1, At, B1); PG8_BAR; PG8_SCHED;
            PG8_LDA(At, 0, 1); PG8_STAGE(PG8_SB(0, 0), b2, voffB); PG8_STAGE(PG8_SB(0, 1), b2 + hstepB, voffB); PG8_STAGE(PG8_SA(0, 0), a2, voffA);
            PG8_WAIT_V(8); PG8_WAIT_L(0); PG8_BAR; PG8_MMA(1, 0, At, B0); PG8_MMA(1, 1, At, B1); PG8_BAR; PG8_SCHED;
            PG8_LDB(B0, 1, 0); PG8_LDB(B1, 1, 1); PG8_SCHED; PG8_LDA(At, 1, 0); PG8_STAGE(PG8_SA(0, 1), a2 + hstepA, voffA);
            PG8_WAIT_V(8); PG8_WAIT_L(0); PG8_BAR; PG8_MMA(0, 0, At, B0); PG8_MMA(0, 1, At, B1); PG8_BAR; PG8_SCHED;
            PG8_LDA(At, 1, 1); PG8_STAGE(PG8_SB(1, 0), b3, voffB); PG8_STAGE(PG8_SB(1, 1), b3 + hstepB, voffB); PG8_STAGE(PG8_SA(1, 0), a3, voffA);
            PG8_WAIT_V(8); PG8_WAIT_L(0); PG8_BAR; PG8_MMA(1, 0, At, B0); PG8_MMA(1, 1, At, B1); PG8_BAR; PG8_SCHED;
            } else {
            PG8_LDB(B0, 0, 0); PG8_SCHED; PG8_LDA(At, 0, 0); PG8_STAGE(PG8_SA(1, 1), a1 + hstepA, voffA);
            PG8_WAIT_L(8); PG8_BAR; PG8_WAIT_L(0); PG8_MMA(0, 0, At, B0); PG8_BAR; PG8_SCHED;
            PG8_LDB(B1, 0, 1); PG8_STAGE(PG8_SB(0, 0), b2, voffB);
            PG8_BAR; PG8_WAIT_L(0); PG8_MMA(0, 1, At, B1); PG8_BAR;
            PG8_LDA(At, 0, 1); PG8_STAGE(PG8_SA(0, 0), a2, voffA);
            PG8_BAR; PG8_WAIT_L(0); PG8_MMA(1, 0, At, B0); PG8_BAR; PG8_SCHED;
            PG8_STAGE(PG8_SB(0, 1), b2 + hstepB, voffB);
            PG8_WAIT_V(6); PG8_BAR; PG8_MMA(1, 1, At, B1); PG8_BAR;
            PG8_LDB(B0, 1, 0); PG8_SCHED; PG8_LDA(At, 1, 0); PG8_STAGE(PG8_SA(0, 1), a2 + hstepA, voffA);
            PG8_WAIT_L(8); PG8_BAR; PG8_WAIT_L(0); PG8_MMA(0, 0, At, B0); PG8_BAR; PG8_SCHED;
            PG8_LDB(B1, 1, 1); PG8_STAGE(PG8_SB(1, 0), b3, voffB);
            PG8_BAR; PG8_WAIT_L(0); PG8_MMA(0, 1, At, B1); PG8_BAR;
            PG8_LDA(At, 1, 1); PG8_STAGE(PG8_SA(1, 0), a3, voffA);
            PG8_BAR; PG8_WAIT_L(0); PG8_MMA(1, 0, At, B0); PG8_BAR; PG8_SCHED;
            PG8_STAGE(PG8_SB(1, 1), b3 + hstepB, voffB);
            PG8_WAIT_V(6); PG8_BAR; PG8_MMA(1, 1, At, B1); PG8_BAR;
            }
        }
        if constexpr (ALIGN_EPI) { if (wr == 0) PG8_BAR; }
        if constexpr (!Epi::AFTER_DRAIN) { E(acc, cur, wr, wc, fr, fq); S.done(cur); }
        if (!has_next) break;
#pragma unroll
        for (int a = 0; a < 2; ++a)
#pragma unroll
            for (int b = 0; b < 2; ++b)
#pragma unroll
                for (int m = 0; m < 4; ++m)
#pragma unroll
                    for (int n = 0; n < 2; ++n) acc[a][b][m][n] = (f32x4){0.f, 0.f, 0.f, 0.f};
        cur = nxt; cA = nA; cB = nB; ++ui;
        if constexpr (ALIGN_EPI) { if (wr == 1) PG8_BAR; }
    }
    PG8_WAIT_V(0);
    if constexpr (!ALIGN_EPI) { if (wr == 0) PG8_BAR; }
    PG8_BAR;
    if constexpr (Epi::AFTER_DRAIN) { E.fused(acc, cur, wr, wc, fr, fq, lds, wid, lane); S.done(cur); }
#undef PG8_SA
#undef PG8_SB
#undef PG8_STAGE
#undef PG8_LDA
#undef PG8_LDB
#undef PG8_MMA
#undef PG8_WAIT_V
#undef PG8_WAIT_L
#undef PG8_BAR
#undef PG8_SCHED
}
}

typedef unsigned short u16;
using pg8::f32x4;
constexpr int T_TOK = 16384, SEQ = 8192, DM = 1024, DFF = 2816;
constexpr int EV_N = 4352, OD_N = 2304, RWIN = 1760;
constexpr int NSEG = 16, LSEG = 512;
constexpr int LDS_BYTES = 144 * 1024;
#ifndef PH_MASK
#define PH_MASK 0xFFF
#endif
constexpr size_t MiB = 1048576;
constexpr size_t WS_WIN = 0, WS_WOUT = 9 * MiB, WS_WFI = 11 * MiB, WS_WFO = 22 * MiB, WS_WGLU = 28 * MiB;
constexpr size_t WS_XA = 30 * MiB, WS_R0 = 62 * MiB;
constexpr size_t WS_P = WS_R0, WS_ACT = WS_R0;
constexpr size_t EV_XBC = WS_R0 + 136 * MiB, EV_DT = EV_XBC + 32 * MiB, EV_AOF = EV_DT + 1 * MiB, EV_AOB = EV_AOF + 16 * MiB,
                 EV_BYF = EV_AOB + 16 * MiB, EV_BYB = EV_BYF + 16 * MiB, EV_ALC = EV_BYB + 16 * MiB, EV_BLC = EV_ALC + 16 * MiB,
                 EV_ADEC = EV_BLC + 16 * MiB, EV_BDEC = EV_ADEC + 1 * MiB;
constexpr size_t OD_CYF = WS_R0, OD_CYB = WS_R0 + 16 * MiB;
constexpr size_t OD_PREP = WS_R0 + 72 * MiB;
constexpr size_t OD_R = OD_PREP, OD_V = OD_PREP + 16 * MiB, OD_KK = OD_PREP + 32 * MiB, OD_G = OD_PREP + 48 * MiB, OD_KF = OD_PREP + 64 * MiB,
                 OD_KB = OD_PREP + 80 * MiB, OD_AF = OD_PREP + 96 * MiB, OD_AB = OD_PREP + 112 * MiB, OD_WF1 = OD_PREP + 128 * MiB, OD_WB1 = OD_PREP + 144 * MiB;
constexpr size_t OD_A1 = OD_PREP + 160 * MiB, OD_CLC = OD_A1 + 32 * MiB, OD_CPM = OD_CLC + 8 * MiB;
constexpr size_t OD_XLOC = WS_XA, OD_BT1 = WS_R0 + 32 * MiB, OD_BT0 = WS_R0 + 40 * MiB;
constexpr size_t OD_TINV = WS_R0 + 44 * MiB;
constexpr size_t OD_KP = OD_KF, OD_XL = WS_XA + 16 * MiB, OD_BTL = OD_CPM + 8 * MiB;
constexpr size_t OD_YG = OD_WF1;
constexpr size_t WS_NEED = 344 * MiB;

struct Params { const float* in[39]; float* out; unsigned char* ws; int lo, hi; };
enum { I_X = 0, I_NMIX, I_NFFN, I_NFIN, I_FFI, I_FFO, I_EVIN, I_EVOUT, I_HGLB, I_HGNW, I_M2CW, I_M2CB, I_M2DTB, I_M2ALOG, I_M2D, I_M2NW,
       I_ODIN, I_ODOUT, I_MU, I_W0, I_W2, I_A0, I_A2, I_G2, I_KK, I_KA, I_RK, I_LNW, I_LNB, I_SARE, I_SAIM, I_SBRE, I_SBIM, I_SCRE, I_SCIM, I_SD, I_SLS, I_GLUW, I_GLUB };


__device__ __forceinline__ const float* inp_(const Params& p, int i) { asm volatile("" : "+s"(i)); return p.in[i]; }
__device__ __forceinline__ unsigned char* wsp_(const Params& p) { size_t z = 0; asm volatile("" : "+s"(z)); return p.ws + z; }
__device__ __forceinline__ float* outp_(const Params& p) { size_t z = 0; asm volatile("" : "+s"(z)); return p.out + z; }
#define INP(p, i) inp_(p, i)
#define WSP(p) wsp_(p)
#define OUTP(p) outp_(p)


constexpr size_t WS_BAR = 29 * MiB;
#define LAS __attribute__((address_space(3)))
#define XB_TMO      128
#define XB_XCNT(j)  (256  + 64 * (j))
#define XB_XSUB(j)  (1280 + 64 * (j))
#define XB_XGEN(j)  (2304 + 64 * (j))
#define XB_TOP      3328
#define XB_TOPGEN   3392
#define XCD_BAR_WORDS 3456
#define XB_SPIN_CAP (1u << 18)

__device__ __forceinline__ unsigned xb_ld(unsigned* p)              { return __hip_atomic_load(p, __ATOMIC_RELAXED, __HIP_MEMORY_SCOPE_AGENT); }
__device__ __forceinline__ unsigned xb_add(unsigned* p, unsigned v) { return __hip_atomic_fetch_add(p, v, __ATOMIC_RELAXED, __HIP_MEMORY_SCOPE_AGENT); }
__device__ __forceinline__ unsigned xb_xcc_id() { return (unsigned)__builtin_amdgcn_s_getreg((3 << 11) | 20) & 0xFu; }
#define XB_SPIN(cond, bar) do { unsigned _sp = 0; while (cond) { __builtin_amdgcn_s_sleep(1); \
    if ((++_sp & 255u) == 0u) { if (xb_ld(&(bar)[XB_TMO])) break; if (_sp > XB_SPIN_CAP) { atomicAdd(&(bar)[XB_TMO], 1u); break; } } } } while (0)

struct XcdBarrier {
    unsigned* bar; unsigned x;
    volatile LAS unsigned* st;
};

__device__ __forceinline__ XcdBarrier xcd_barrier_post(unsigned* bar, volatile LAS unsigned* st) {
    XcdBarrier b; b.bar = bar; b.x = xb_xcc_id(); b.st = st;
    if (otid() == 0) (void)xb_add(&bar[XB_XCNT(b.x)], 1u);
    return b;
}
__device__ __forceinline__ void xcd_barrier_complete(unsigned* bar, unsigned x, unsigned& nloc, unsigned& nx) {
    const unsigned G = gridDim.x * gridDim.y * gridDim.z;
    unsigned sum, cnt, mine, sp = 0u;
    for (;;) {
        sum = 0u; cnt = 0u; mine = 0u;
#pragma unroll
        for (unsigned j = 0; j < 16; ++j) { const unsigned c = xb_ld(&bar[XB_XCNT(j)]); sum += c; cnt += (c > 0u) ? 1u : 0u; mine = (j == x) ? c : mine; }
        if (sum == G) break;
        __builtin_amdgcn_s_sleep(1);
        if ((++sp & 255u) == 0u) { if (xb_ld(&bar[XB_TMO])) break; if (sp > XB_SPIN_CAP) { atomicAdd(&bar[XB_TMO], 1u); break; } }
    }
    nloc = mine > 0u ? mine : 1u; nx = cnt > 0u ? cnt : 1u;
}

__device__ __forceinline__ void xcd_barrier(const XcdBarrier& b) {
    asm volatile("s_waitcnt vmcnt(0)" ::: "memory");
    __syncthreads();
    if (otid() == 0) {
        unsigned* bar = b.bar;
        __builtin_amdgcn_s_waitcnt(0);
        unsigned nloc = b.st[0], nx = b.st[1];
        if (nloc == 0u) { xcd_barrier_complete(bar, b.x, nloc, nx); b.st[0] = nloc; b.st[1] = nx; }
        const unsigned old = xb_add(&bar[XB_XSUB(b.x)], 1u);
        const unsigned gen = old / nloc;
        if (old + 1u == (gen + 1u) * nloc) {
            __builtin_amdgcn_fence(__ATOMIC_RELEASE, "agent");
            asm volatile("s_waitcnt vmcnt(0)" ::: "memory");
            const unsigned og = xb_add(&bar[XB_TOP], 1u);
            const unsigned tg = og / nx;
            if (og + 1u == (tg + 1u) * nx) xb_add(&bar[XB_TOPGEN], 1u);
            else XB_SPIN(xb_ld(&bar[XB_TOPGEN]) == tg, bar);
            __builtin_amdgcn_fence(__ATOMIC_ACQUIRE, "agent");
            xb_add(&bar[XB_XGEN(b.x)], 1u);
            asm volatile("s_waitcnt vmcnt(0)" ::: "memory");
        } else {
            XB_SPIN(xb_ld(&bar[XB_XGEN(b.x)]) == gen, bar);
            __builtin_amdgcn_fence(__ATOMIC_ACQUIRE, "agent");
            asm volatile("s_waitcnt vmcnt(0)" ::: "memory");
        }
    }
    __syncthreads();
}

__device__ __forceinline__ float bf2f(unsigned b) { return __builtin_bit_cast(float, b << 16); }
typedef float f32x2_t __attribute__((ext_vector_type(2)));
typedef __bf16 bf16x2_t __attribute__((ext_vector_type(2)));
__device__ __forceinline__ unsigned pk2(float lo, float hi) { const f32x2_t v = {lo, hi}; const bf16x2_t b = __builtin_convertvector(v, bf16x2_t); return __builtin_bit_cast(unsigned, b); }
__device__ __forceinline__ unsigned f2bf(float f) { return pk2(f, f) & 0xffffu; }
__device__ __forceinline__ float h2f(unsigned h) { return (float)__builtin_bit_cast(_Float16, (u16)h); }
__device__ __forceinline__ unsigned f2h(float f) { return (unsigned)__builtin_bit_cast(u16, (_Float16)f); }
__device__ __forceinline__ unsigned pk2h(float lo, float hi) { return f2h(lo) | (f2h(hi) << 16); }
#define UNPACK8_BF(v, o) do { o[0] = bf2f((v).x & 0xffffu); o[1] = __builtin_bit_cast(float, (v).x & 0xffff0000u); o[2] = bf2f((v).y & 0xffffu); o[3] = __builtin_bit_cast(float, (v).y & 0xffff0000u); \
    o[4] = bf2f((v).z & 0xffffu); o[5] = __builtin_bit_cast(float, (v).z & 0xffff0000u); o[6] = bf2f((v).w & 0xffffu); o[7] = __builtin_bit_cast(float, (v).w & 0xffff0000u); } while (0)
#define UNPACK8_H(v, o) do { o[0] = h2f((v).x & 0xffffu); o[1] = h2f((v).x >> 16); o[2] = h2f((v).y & 0xffffu); o[3] = h2f((v).y >> 16); \
    o[4] = h2f((v).z & 0xffffu); o[5] = h2f((v).z >> 16); o[6] = h2f((v).w & 0xffffu); o[7] = h2f((v).w >> 16); } while (0)
#define PACK8_BF(o) make_uint4(pk2(o[0], o[1]), pk2(o[2], o[3]), pk2(o[4], o[5]), pk2(o[6], o[7]))
#define PACK8_H(o) make_uint4(pk2h(o[0], o[1]), pk2h(o[2], o[3]), pk2h(o[4], o[5]), pk2h(o[6], o[7]))
__device__ __forceinline__ float sigmoidf_(float x) { return __builtin_amdgcn_rcpf(1.f + __expf(-x)); }
__device__ __forceinline__ float siluf_(float x) { return x * __builtin_amdgcn_rcpf(1.f + __expf(-x)); }
__device__ __forceinline__ float tanhf_(float x) { x = fminf(fmaxf(x, -15.f), 15.f); const float t = __expf(2.f * x); return (t - 1.f) * __builtin_amdgcn_rcpf(t + 1.f); }
__device__ __forceinline__ float softplusf_(float x) { return fmaxf(x, 0.f) + log1pf(__expf(-fabsf(x))); }
__device__ __forceinline__ float dppf(float x, const int ctrl_sel) {
    const int v = __builtin_bit_cast(int, x); int r;
    if (ctrl_sel == 0) r = __builtin_amdgcn_update_dpp(0, v, 0xB1, 0xF, 0xF, true);
    else if (ctrl_sel == 1) r = __builtin_amdgcn_update_dpp(0, v, 0x4E, 0xF, 0xF, true);
    else if (ctrl_sel == 2) r = __builtin_amdgcn_update_dpp(0, v, 0x141, 0xF, 0xF, true);
    else r = __builtin_amdgcn_update_dpp(0, v, 0x140, 0xF, 0xF, true);
    return __builtin_bit_cast(float, r);
}
__device__ __forceinline__ float red4(float x) { x += dppf(x, 0); x += dppf(x, 1); return x; }
__device__ __forceinline__ float red8(float x) { x = red4(x); x += dppf(x, 2); return x; }
__device__ __forceinline__ float red16(float x) { x = red8(x); x += dppf(x, 3); return x; }
__device__ __forceinline__ float lane_xor(float x, int m) { return __builtin_bit_cast(float, __builtin_amdgcn_ds_bpermute((((otid() & 63) ^ m) << 2), __builtin_bit_cast(int, x))); }
__device__ __forceinline__ float red32(float x) { x = red16(x); x += lane_xor(x, 16); return x; }
__device__ __forceinline__ float red64(float x) { x = red32(x); x += lane_xor(x, 32); return x; }

struct EpiPlain {
    static constexpr bool PERM = true, AFTER_DRAIN = false;
    u16* O; int ld, col_base, shift_from, shift, nvalid;
    __device__ __forceinline__ void operator()(const f32x4 (&acc)[2][2][4][2], const pg8::Unit& u, int wr, int wc, int fr, int fq) const {
        asm volatile("" : "+v"(fr), "+v"(fq));
        const int row0 = u.pm * 256 + wr * 64 + fr, col0 = u.pn * 256 + wc * 32 + 8 * fq, cadd = col_base + (u.pn >= shift_from ? shift : 0);
#pragma unroll
        for (int ai = 0; ai < 2; ++ai)
#pragma unroll
            for (int m = 0; m < 4; ++m)
#pragma unroll
                for (int bj = 0; bj < 2; ++bj) {
                    const f32x4 v0 = acc[ai][bj][m][0], v1 = acc[ai][bj][m][1];
                    if (col0 + bj * 128 < nvalid)
                        *(uint4*)(O + (size_t)(row0 + ai * 128 + m * 16) * ld + cadd + col0 + bj * 128) = make_uint4(pk2(v0[0], v0[1]), pk2(v0[2], v0[3]), pk2(v1[0], v1[1]), pk2(v1[2], v1[3]));
                }
    }
};
struct EpiResid {
    static constexpr bool PERM = true, AFTER_DRAIN = false;
    const float* hin; float* out;
    __device__ __forceinline__ void operator()(const f32x4 (&acc)[2][2][4][2], const pg8::Unit& u, int wr, int wc, int fr, int fq) const {
        asm volatile("" : "+v"(fr), "+v"(fq));
        const int row0 = u.pm * 256 + wr * 64 + fr, col0 = u.pn * 256 + wc * 32 + 8 * fq;
#pragma unroll
        for (int ai = 0; ai < 2; ++ai)
#pragma unroll
            for (int m = 0; m < 4; ++m)
#pragma unroll
                for (int bj = 0; bj < 2; ++bj) {
                    const size_t o = (size_t)(row0 + ai * 128 + m * 16) * DM + col0 + bj * 128;
                    const float4 a = *(const float4*)(hin + o), b = *(const float4*)(hin + o + 4);
                    const f32x4 v0 = acc[ai][bj][m][0], v1 = acc[ai][bj][m][1];
                    *(float4*)(out + o) = make_float4(a.x + v0[0], a.y + v0[1], a.z + v0[2], a.w + v0[3]);
                    *(float4*)(out + o + 4) = make_float4(b.x + v1[0], b.y + v1[1], b.z + v1[2], b.w + v1[3]);
                }
    }
};
struct EpiFfn {
    static constexpr bool PERM = true, AFTER_DRAIN = false;
    u16* ACT;
    __device__ __forceinline__ void operator()(const f32x4 (&acc)[2][2][4][2], const pg8::Unit& u, int wr, int wc, int fr, int fq) const {
        asm volatile("" : "+v"(fr), "+v"(fq));
        const int row0 = u.pm * 256 + wr * 64 + fr, col0 = u.pn * 128 + wc * 32 + 8 * fq;
#pragma unroll
        for (int ai = 0; ai < 2; ++ai)
#pragma unroll
            for (int m = 0; m < 4; ++m) {
                float o[8];
#pragma unroll
                for (int n = 0; n < 2; ++n)
#pragma unroll
                    for (int e = 0; e < 4; ++e) o[n * 4 + e] = siluf_(acc[ai][0][m][n][e]) * acc[ai][1][m][n][e];
                *(uint4*)(ACT + (size_t)(row0 + ai * 128 + m * 16) * DFF + col0) = PACK8_BF(o);
            }
    }
};
struct EpiGlu {
    static constexpr bool PERM = true, AFTER_DRAIN = false;
    const u16* YG; const float* gb; u16* O;
    __device__ __forceinline__ void operator()(const f32x4 (&acc)[2][2][4][2], const pg8::Unit& u, int wr, int wc, int fr, int fq) const {
        asm volatile("" : "+v"(fr), "+v"(fq));
        const int row0 = u.pm * 256 + wr * 64 + fr, col0 = u.pn * 256 + wc * 32 + 8 * fq;
#pragma unroll
        for (int bj = 0; bj < 2; ++bj) {
            const int col = col0 + bj * 128;
            float bb[8];
#pragma unroll
            for (int e = 0; e < 8; ++e) bb[e] = gb[col + e];
#pragma unroll
            for (int ai = 0; ai < 2; ++ai)
#pragma unroll
                for (int m = 0; m < 4; ++m) {
                    const int row = row0 + ai * 128 + m * 16;
                    const uint4 yv = *(const uint4*)(YG + (size_t)row * 512 + col);
                    float y[8], o[8]; UNPACK8_BF(yv, y);
#pragma unroll
                    for (int n = 0; n < 2; ++n)
#pragma unroll
                        for (int e = 0; e < 4; ++e) o[n * 4 + e] = y[n * 4 + e] * sigmoidf_(acc[ai][bj][m][n][e] + bb[n * 4 + e]);
                    *(uint4*)(O + (size_t)row * DM + 512 + col) = PACK8_BF(o);
                }
        }
    }
};
struct EpiEven {
    static constexpr bool PERM = true, AFTER_DRAIN = false;
    u16* P; float* DT; const float* lbp; const float* dtb; int j;
    __device__ __forceinline__ void operator()(const f32x4 (&acc)[2][2][4][2], const pg8::Unit& u, int wr, int wc, int fr, int fq) const {
        asm volatile("" : "+v"(fr), "+v"(fq));
        const int pn = u.pn, row0 = u.pm * 256 + wr * 64 + fr;
        if (pn == 16) {
            if (wc == 0 && fq < 2) {
                float bias[8];
#pragma unroll
                for (int e = 0; e < 8; ++e) bias[e] = dtb[8 * fq + e];
#pragma unroll
                for (int ai = 0; ai < 2; ++ai)
#pragma unroll
                    for (int m = 0; m < 4; ++m) {
                        float o[8];
#pragma unroll
                        for (int n = 0; n < 2; ++n)
#pragma unroll
                            for (int e = 0; e < 4; ++e) o[n * 4 + e] = softplusf_(acc[ai][0][m][n][e] + bias[n * 4 + e]);
                        float* d = DT + (size_t)(row0 + ai * 128 + m * 16) * 16 + 8 * fq;
                        *(float4*)d = make_float4(o[0], o[1], o[2], o[3]); *(float4*)(d + 4) = make_float4(o[4], o[5], o[6], o[7]);
                    }
            }
            return;
        }
        const int region = pn >> 1;
#pragma unroll
        for (int bj = 0; bj < 2; ++bj) {
            const int col = pn * 256 + bj * 128 + wc * 32 + 8 * fq;
            float oml[8];
#pragma unroll
            for (int e = 0; e < 8; ++e) oml[e] = 1.f;
            if (region == 1 || region == 2) {
                const int c = col - region * 512;
#pragma unroll
                for (int e = 0; e < 8; ++e) oml[e] = (j == 0) ? 1.f : 1.f - sigmoidf_(lbp[512 + c + e] - lbp[c + e]);
            }
#pragma unroll
            for (int ai = 0; ai < 2; ++ai)
#pragma unroll
                for (int m = 0; m < 4; ++m) {
                    float x[8];
#pragma unroll
                    for (int n = 0; n < 2; ++n)
#pragma unroll
                        for (int e = 0; e < 4; ++e) x[n * 4 + e] = acc[ai][bj][m][n][e];
                    uint4 w;
                    if (region == 0) {
#pragma unroll
                        for (int e = 0; e < 8; ++e) x[e] = siluf_(x[e]) * 0.08838834764831845f;
                        w = PACK8_BF(x);
                    } else if (region == 1 || region == 2) {
#pragma unroll
                        for (int e = 0; e < 8; ++e) x[e] = oml[e] * sigmoidf_(-x[e]);
                        w = PACK8_H(x);
                    } else if (region == 4 || region == 5) {
#pragma unroll
                        for (int e = 0; e < 8; ++e) x[e] = siluf_(x[e]);
                        w = PACK8_BF(x);
                    } else {
                        w = PACK8_BF(x);
                    }
                    *(uint4*)(P + (size_t)(row0 + ai * 128 + m * 16) * EV_N + col) = w;
                }
        }
    }
};

__device__ __forceinline__ void convert_weight(const float* W, int K, int ld, int nvalid, int mode, u16* WT, int Nout, unsigned char* lds, int& item, int gsz) {
    float* tile = (float*)lds;
    const int tid = otid();
    const int nk = K / 64, nn = Nout / 128, total = nk * nn;
    for (; item < total; item += gsz) {
        const int tn = item / nk, tk = item % nk, n0 = tn * 128, k0 = tk * 64;
        int sc0 = n0; if (mode == 1) { const int t = n0 >> 8, b = (n0 >> 7) & 1; sc0 = b * DFF + 128 * t; }
        else if (mode == 2) sc0 = (n0 < 1536) ? n0 : n0 + 224;
        else if (mode == 3) sc0 = n0 + 1536;
        float v[16];
#pragma unroll
        for (int i = 0; i < 16; ++i) {
            const int kk = (tid >> 7) + 4 * i, nnn = tid & 127;
            v[i] = (n0 + nnn < nvalid) ? W[(size_t)(k0 + kk) * ld + sc0 + nnn] : 0.f;
        }
        __syncthreads();
#pragma unroll
        for (int i = 0; i < 16; ++i) tile[((tid >> 7) + 4 * i) * 129 + (tid & 127)] = v[i];
        __syncthreads();
        const int on = tid >> 2, kc = tid & 3;
        float o[16];
#pragma unroll
        for (int e = 0; e < 16; ++e) o[e] = tile[(kc * 16 + e) * 129 + on];
        *(uint4*)(WT + (size_t)(n0 + on) * K + k0 + kc * 16) = make_uint4(pk2(o[0], o[1]), pk2(o[2], o[3]), pk2(o[4], o[5]), pk2(o[6], o[7]));
        *(uint4*)(WT + (size_t)(n0 + on) * K + k0 + kc * 16 + 8) = make_uint4(pk2(o[8], o[9]), pk2(o[10], o[11]), pk2(o[12], o[13]), pk2(o[14], o[15]));
    }
    item -= total;
}

__device__ __forceinline__ void norm_rows_bf16(const float* h, const float* w, u16* o) {
    const int lane = otid() & 63, gw = obid() * 8 + (otid() >> 6), nw = gridDim.x * 8;
    float4 wv[4];
#pragma unroll
    for (int i = 0; i < 4; ++i) wv[i] = *(const float4*)(w + lane * 4 + 256 * i);
    for (int row0 = gw * 4; row0 < T_TOK; row0 += nw * 4) {
        float4 v[4][4]; float ss[4];
#pragma unroll
        for (int r = 0; r < 4; ++r)
#pragma unroll
            for (int i = 0; i < 4; ++i) v[r][i] = *(const float4*)(h + (size_t)(row0 + r) * DM + lane * 4 + 256 * i);
#pragma unroll
        for (int r = 0; r < 4; ++r) {
            float a = 0.f;
#pragma unroll
            for (int i = 0; i < 4; ++i) a += v[r][i].x * v[r][i].x + v[r][i].y * v[r][i].y + v[r][i].z * v[r][i].z + v[r][i].w * v[r][i].w;
            ss[r] = a;
        }
#pragma unroll
        for (int r = 0; r < 4; ++r) ss[r] = red64(ss[r]);
#pragma unroll
        for (int r = 0; r < 4; ++r) {
            const float rs = rsqrtf(ss[r] * (1.f / DM) + 1e-6f);
#pragma unroll
            for (int i = 0; i < 4; ++i)
                *(uint2*)(o + (size_t)(row0 + r) * DM + lane * 4 + 256 * i) = make_uint2(pk2(v[r][i].x * rs * wv[i].x, v[r][i].y * rs * wv[i].y), pk2(v[r][i].z * rs * wv[i].z, v[r][i].w * rs * wv[i].w));
        }
    }
}
__device__ __forceinline__ void norm_rows_f32_inplace(float* h, const float* w) {
    const int lane = otid() & 63, gw = obid() * 8 + (otid() >> 6), nw = gridDim.x * 8;
    float4 wv[4];
#pragma unroll
    for (int i = 0; i < 4; ++i) wv[i] = *(const float4*)(w + lane * 4 + 256 * i);
    for (int row = gw; row < T_TOK; row += nw) {
        float4 v[4]; float ss = 0.f;
#pragma unroll
        for (int i = 0; i < 4; ++i) { v[i] = *(const float4*)(h + (size_t)row * DM + lane * 4 + 256 * i); ss += v[i].x * v[i].x + v[i].y * v[i].y + v[i].z * v[i].z + v[i].w * v[i].w; }
        ss = red64(ss);
        const float r = rsqrtf(ss * (1.f / DM) + 1e-6f);
#pragma unroll
        for (int i = 0; i < 4; ++i)
            *(float4*)(h + (size_t)row * DM + lane * 4 + 256 * i) = make_float4(v[i].x * r * wv[i].x, v[i].y * r * wv[i].y, v[i].z * r * wv[i].z, v[i].w * r * wv[i].w);
    }
}

#define ST8F(dst, o) do { *(float4*)(dst) = make_float4(o[0], o[1], o[2], o[3]); *(float4*)((dst) + 4) = make_float4(o[4], o[5], o[6], o[7]); } while (0)
#define TIME_ROW(seg, s, dir, b) ((b) * SEQ + ((dir) ? (SEQ - 1 - ((seg) * LSEG + (s))) : ((seg) * LSEG + (s))))

template <int PASS>
__device__ __forceinline__ void hg_scan(const Params& p, unsigned char* lds) {
    const int tid = otid();
    float* Lk = (float*)lds;
    float* Lq = Lk + 32 * 144;
    float* Lv = Lq + 32 * 144;
    u16* Lo = (u16*)(Lv + 32 * 128);
    const u16* P = (const u16*)(WSP(p) + WS_P);
    float* LC = (float*)(WSP(p) + EV_ALC); float* DEC = (float*)(WSP(p) + EV_ADEC);
    const int v = tid >> 2, kg = tid & 3, lrow = tid >> 4, lch = (tid & 15) * 8;
    const int lko = lrow * 144 + (lch >> 5) * 36 + (lch & 31);
    for (int unit = obid(); unit < 256; unit += gridDim.x) {
        const int seg = unit & 15, h = (unit >> 4) & 3, b = (unit >> 6) & 1, dir = unit >> 7;
        u16* AO = (u16*)(WSP(p) + (dir ? EV_AOB : EV_AOF));
        float S[32];
#pragma unroll
        for (int i = 0; i < 32; ++i) S[i] = (PASS == 1) ? 0.f : LC[(size_t)unit * 16384 + (kg * 32 + i) * 128 + v];
        float Dk = 1.f;
        uint4 rk, rv, rq = make_uint4(0, 0, 0, 0);
        {
            const u16* base = P + (size_t)TIME_ROW(seg, lrow, dir, b) * EV_N + h * 128 + lch;
            rk = *(const uint4*)(base + 512 + dir * 512); rv = *(const uint4*)(base + 1536); if (PASS == 3) rq = *(const uint4*)(base);
        }
        for (int tile = 0; tile < LSEG / 32; ++tile) {
            __syncthreads();
            { float f[8]; UNPACK8_H(rk, f); ST8F(Lk + lko, f); UNPACK8_BF(rv, f); ST8F(Lv + lrow * 128 + lch, f); if (PASS == 3) { UNPACK8_BF(rq, f); ST8F(Lq + lko, f); } }
            __syncthreads();
            if (tile + 1 < LSEG / 32) {
                const u16* base = P + (size_t)TIME_ROW(seg, (tile + 1) * 32 + lrow, dir, b) * EV_N + h * 128 + lch;
                rk = *(const uint4*)(base + 512 + dir * 512); rv = *(const uint4*)(base + 1536); if (PASS == 3) rq = *(const uint4*)(base);
            }
            for (int s = 0; s < 32; ++s) {
                const float vs = Lv[s * 128 + v];
                float o = 0.f;
#pragma unroll
                for (int i4 = 0; i4 < 8; ++i4) {
                    const float4 kk = *(const float4*)(Lk + s * 144 + kg * 36 + i4 * 4);
                    S[i4 * 4 + 0] = fmaf(kk.x, vs - S[i4 * 4 + 0], S[i4 * 4 + 0]);
                    S[i4 * 4 + 1] = fmaf(kk.y, vs - S[i4 * 4 + 1], S[i4 * 4 + 1]);
                    S[i4 * 4 + 2] = fmaf(kk.z, vs - S[i4 * 4 + 2], S[i4 * 4 + 2]);
                    S[i4 * 4 + 3] = fmaf(kk.w, vs - S[i4 * 4 + 3], S[i4 * 4 + 3]);
                    if (PASS == 3) {
                        const float4 qq = *(const float4*)(Lq + s * 144 + kg * 36 + i4 * 4);
                        o = fmaf(S[i4 * 4 + 0], qq.x, o); o = fmaf(S[i4 * 4 + 1], qq.y, o); o = fmaf(S[i4 * 4 + 2], qq.z, o); o = fmaf(S[i4 * 4 + 3], qq.w, o);
                    }
                }
                if (PASS == 3) { o = red4(o); if (kg == 0) Lo[s * 128 + v] = (u16)f2bf(o); }
            }
            if (PASS == 1) { if (tid < 128) { for (int s = 0; s < 32; ++s) Dk *= 1.f - Lk[s * 144 + (tid >> 5) * 36 + (tid & 31)]; } }
            if (PASS == 3) {
                __syncthreads();
                const uint4 ov = *(const uint4*)(Lo + lrow * 128 + lch);
                *(uint4*)(AO + (size_t)TIME_ROW(seg, tile * 32 + lrow, dir, b) * 512 + h * 128 + lch) = ov;
            }
        }
        if (PASS == 1) {
#pragma unroll
            for (int i = 0; i < 32; ++i) LC[(size_t)unit * 16384 + (kg * 32 + i) * 128 + v] = S[i];
            if (tid < 128) DEC[unit * 128 + tid] = Dk;
        }
    }
    __syncthreads();
}

template <int PASS>
__device__ __forceinline__ void m2_scan(const Params& p, int j, unsigned char* lds) {
    const int tid = otid();
    float* Lx = (float*)lds;
    float* LB = Lx + 32 * 64;
    float* LCm = LB + 32 * 160;
    float* Ldt = LCm + 32 * 160;
    float* LdA = Ldt + 32;
    u16* Lo = (u16*)(LdA + 32);
    const u16* XB = (const u16*)(WSP(p) + EV_XBC);
    const float* DT = (const float*)(WSP(p) + EV_DT);
    float* LC = (float*)(WSP(p) + EV_BLC); float* DEC = (float*)(WSP(p) + EV_BDEC);
    const int pp = tid >> 3, ng = tid & 7;
    const int xrow = (tid & 255) >> 3, xch = (tid & 7) * 8;
    const int brow = tid >> 4, bch = (tid & 15) * 8;
    const int lbo = brow * 160 + (bch >> 4) * 20 + (bch & 15);
    for (int unit = obid(); unit < 512; unit += gridDim.x) {
        const int seg = unit & 15, hd = (unit >> 4) & 7, b = (unit >> 7) & 1, dir = unit >> 8, g = hd >> 2;
        u16* YO = (u16*)(WSP(p) + (dir ? EV_BYB : EV_BYF));
        const float a = -__expf(INP(p, I_M2ALOG)[(j * 2 + dir) * 8 + hd]);
        float hS[16];
#pragma unroll
        for (int i = 0; i < 16; ++i) hS[i] = (PASS == 1) ? 0.f : LC[(size_t)unit * 8192 + pp * 128 + ng * 16 + i];
        float dsum = 0.f;
        uint4 rx = make_uint4(0, 0, 0, 0), rb, rc = make_uint4(0, 0, 0, 0); float rdt = 0.f;
        {
            if (tid < 256) rx = *(const uint4*)(XB + (size_t)TIME_ROW(seg, xrow, dir, b) * 1024 + hd * 64 + xch);
            const u16* base = XB + (size_t)TIME_ROW(seg, brow, dir, b) * 1024 + 512 + g * 128 + bch;
            rb = *(const uint4*)base; if (PASS == 3) rc = *(const uint4*)(base + 256);
            if (tid < 32) rdt = DT[(size_t)TIME_ROW(seg, tid, dir, b) * 16 + dir * 8 + hd];
        }
        for (int tile = 0; tile < LSEG / 32; ++tile) {
            __syncthreads();
            { float f[8]; if (tid < 256) { UNPACK8_BF(rx, f); ST8F(Lx + xrow * 64 + xch, f); } UNPACK8_BF(rb, f); ST8F(LB + lbo, f); if (PASS == 3) { UNPACK8_BF(rc, f); ST8F(LCm + lbo, f); }
              if (tid < 32) { Ldt[tid] = rdt; LdA[tid] = __expf(rdt * a); } }
            __syncthreads();
            if (tile + 1 < LSEG / 32) {
                const int s0 = (tile + 1) * 32;
                if (tid < 256) rx = *(const uint4*)(XB + (size_t)TIME_ROW(seg, s0 + xrow, dir, b) * 1024 + hd * 64 + xch);
                const u16* base = XB + (size_t)TIME_ROW(seg, s0 + brow, dir, b) * 1024 + 512 + g * 128 + bch;
                rb = *(const uint4*)base; if (PASS == 3) rc = *(const uint4*)(base + 256);
                if (tid < 32) rdt = DT[(size_t)TIME_ROW(seg, s0 + tid, dir, b) * 16 + dir * 8 + hd];
            }
            for (int s = 0; s < 32; ++s) {
                const float dt = Ldt[s], dA = LdA[s], xdt = dt * Lx[s * 64 + pp];
                dsum += dt * a;
                float y = 0.f;
#pragma unroll
                for (int i4 = 0; i4 < 4; ++i4) {
                    const float4 bv = *(const float4*)(LB + s * 160 + ng * 20 + i4 * 4);
                    hS[i4 * 4 + 0] = fmaf(hS[i4 * 4 + 0], dA, xdt * bv.x);
                    hS[i4 * 4 + 1] = fmaf(hS[i4 * 4 + 1], dA, xdt * bv.y);
                    hS[i4 * 4 + 2] = fmaf(hS[i4 * 4 + 2], dA, xdt * bv.z);
                    hS[i4 * 4 + 3] = fmaf(hS[i4 * 4 + 3], dA, xdt * bv.w);
                    if (PASS == 3) {
                        const float4 cv = *(const float4*)(LCm + s * 160 + ng * 20 + i4 * 4);
                        y = fmaf(hS[i4 * 4 + 0], cv.x, y); y = fmaf(hS[i4 * 4 + 1], cv.y, y); y = fmaf(hS[i4 * 4 + 2], cv.z, y); y = fmaf(hS[i4 * 4 + 3], cv.w, y);
                    }
                }
                if (PASS == 3) { y = red8(y); if (ng == 0) Lo[s * 64 + pp] = (u16)f2bf(y); }
            }
            if (PASS == 3) {
                __syncthreads();
                if (tid < 256) {
                    const uint4 ov = *(const uint4*)(Lo + xrow * 64 + xch);
                    *(uint4*)(YO + (size_t)TIME_ROW(seg, tile * 32 + xrow, dir, b) * 512 + hd * 64 + xch) = ov;
                }
            }
        }
        if (PASS == 1) {
#pragma unroll
            for (int i = 0; i < 16; ++i) LC[(size_t)unit * 8192 + pp * 128 + ng * 16 + i] = hS[i];
            if (tid == 0) DEC[unit] = __expf(dsum);
        }
    }
    __syncthreads();
}


__device__ __forceinline__ void lbar() { asm volatile("s_waitcnt lgkmcnt(0)" ::: "memory"); __builtin_amdgcn_s_barrier(); asm volatile("" ::: "memory"); }
typedef short bf16x8_t __attribute__((ext_vector_type(8)));
__device__ __forceinline__ f32x4 mma16(bf16x8_t a, bf16x8_t b, f32x4 c) { return __builtin_amdgcn_mfma_f32_16x16x32_bf16(a, b, c, 0, 0, 0); }
__device__ __forceinline__ bf16x8_t ldfrag(const u16* base, int ld, int r0, int k0, int lane) { return *(const bf16x8_t*)(base + (r0 + (lane & 15)) * ld + k0 + 8 * (lane >> 4)); }

template <int PASS>
__device__ __forceinline__ void hg_mma(const Params& p, unsigned char* lds) {
    const int tid = otid(), lane = tid & 63, wave = tid >> 6, l15 = lane & 15, lq = lane >> 4;
    u16* Qs = (u16*)lds;
    u16* Kp = Qs + 32 * 136;
    u16* Kt = Kp + 32 * 136;
    u16* Vt = Kt + 128 * 40;
    u16* Pm = Vt + 128 * 40;
    u16* St = Pm + 32 * 40;
    u16* Ob = St + 128 * 136;
    float* Lb = (float*)(Ob + 32 * 128);
    float* Lpart = Lb + 32 * 128;
    float* Ldec = Lpart + 4 * 128;
    u16* Lk1h = (u16*)(Ldec + 128);
    u16* Lvh = Lk1h + 32 * 128;
    const u16* P = (const u16*)(WSP(p) + WS_P);
    float* LC = (float*)(WSP(p) + EV_ALC); float* DEC = (float*)(WSP(p) + EV_ADEC);
    const int lrow = tid >> 4, lch = (tid & 15) * 8;
    for (int unit = obid(); unit < 256; unit += gridDim.x) {
        const int seg = unit & 15, h = (unit >> 4) & 3, b = (unit >> 6) & 1, dir = unit >> 7;
        u16* AO = (u16*)(WSP(p) + (dir ? EV_AOB : EV_AOF));
        f32x4 S[8];
#pragma unroll
        for (int vt = 0; vt < 8; ++vt)
#pragma unroll
            for (int r = 0; r < 4; ++r) S[vt][r] = (PASS == 1) ? 0.f : LC[(size_t)unit * 16384 + (wave * 16 + lq * 4 + r) * 128 + vt * 16 + l15];
        __syncthreads();
        if (PASS == 3) {
#pragma unroll
            for (int vt = 0; vt < 8; ++vt) *(uint2*)(St + (vt * 16 + l15) * 136 + wave * 16 + lq * 4) = make_uint2(pk2(S[vt][0], S[vt][1]), pk2(S[vt][2], S[vt][3]));
        }
        float ltot = 0.f;
        uint4 rk, rv, rq = make_uint4(0, 0, 0, 0);
        {
            const u16* base = P + (size_t)TIME_ROW(seg, lrow, dir, b) * EV_N + h * 128 + lch;
            rk = *(const uint4*)(base + 512 + dir * 512); rv = *(const uint4*)(base + 1536); if (PASS == 3) rq = *(const uint4*)(base);
        }
        for (int chunk = 0; chunk < LSEG / 32; ++chunk) {
            float k1f[8], qf[8], vf[8];
            UNPACK8_H(rk, k1f); UNPACK8_BF(rv, vf); UNPACK8_BF(rq, qf);
            lbar();
            {
                float lg[8];
#pragma unroll
                for (int e = 0; e < 8; ++e) lg[e] = fmaxf(__logf(1.f - k1f[e]), -30.f);
                ST8F(Lb + lrow * 128 + lch, lg);
                *(uint4*)(Lk1h + lrow * 128 + lch) = rk; *(uint4*)(Lvh + lrow * 128 + lch) = rv;
            }
            if (chunk + 1 < LSEG / 32) {
                const u16* base = P + (size_t)TIME_ROW(seg, (chunk + 1) * 32 + lrow, dir, b) * EV_N + h * 128 + lch;
                rk = *(const uint4*)(base + 512 + dir * 512); rv = *(const uint4*)(base + 1536); if (PASS == 3) rq = *(const uint4*)(base);
            }
            lbar();
            {
                const int k = tid & 127, tg = tid >> 7;
                float c8[8]; float run = 0.f;
#pragma unroll
                for (int i = 0; i < 8; ++i) { run += Lb[(tg * 8 + i) * 128 + k]; c8[i] = run; }
                Lpart[tg * 128 + k] = run;
                lbar();
                float off = 0.f;
#pragma unroll
                for (int g2 = 0; g2 < 3; ++g2) off += (g2 < tg) ? Lpart[g2 * 128 + k] : 0.f;
#pragma unroll
                for (int i = 0; i < 8; ++i) Lb[(tg * 8 + i) * 128 + k] = c8[i] + off;
                if (tg == 3) { Ldec[k] = c8[7] + off; ltot += c8[7] + off; }
            }
            lbar();
            {
                float bb[8], bt[8], o1[8], o2[8];
                { const float4 x0 = *(const float4*)(Lb + lrow * 128 + lch), x1 = *(const float4*)(Lb + lrow * 128 + lch + 4); bb[0] = x0.x; bb[1] = x0.y; bb[2] = x0.z; bb[3] = x0.w; bb[4] = x1.x; bb[5] = x1.y; bb[6] = x1.z; bb[7] = x1.w; }
                { const float4 x0 = *(const float4*)(Ldec + lch), x1 = *(const float4*)(Ldec + lch + 4); bt[0] = x0.x; bt[1] = x0.y; bt[2] = x0.z; bt[3] = x0.w; bt[4] = x1.x; bt[5] = x1.y; bt[6] = x1.z; bt[7] = x1.w; }
                if (PASS == 3) {
#pragma unroll
                    for (int e = 0; e < 8; ++e) { o1[e] = qf[e] * __expf(bb[e]); o2[e] = k1f[e] * __expf(fminf(-bb[e], 80.f)); }
                    *(uint4*)(Qs + lrow * 136 + lch) = PACK8_BF(o1);
                    *(uint4*)(Kp + lrow * 136 + lch) = PACK8_BF(o2);
                }
            }
            {
                const int k = tid & 127, tq = tid >> 7; const float btk = Ldec[k];
                float o[8]; unsigned vb[8];
#pragma unroll
                for (int e = 0; e < 8; ++e) { const int t = tq * 8 + e; o[e] = h2f(Lk1h[t * 128 + k]) * __expf(btk - Lb[t * 128 + k]); vb[e] = Lvh[t * 128 + k]; }
                *(uint4*)(Kt + k * 40 + tq * 8) = PACK8_BF(o);
                *(uint4*)(Vt + k * 40 + tq * 8) = make_uint4(vb[0] | (vb[1] << 16), vb[2] | (vb[3] << 16), vb[4] | (vb[5] << 16), vb[6] | (vb[7] << 16));
            }
            lbar();
            f32x4 o0 = {0.f, 0.f, 0.f, 0.f}, o1v = {0.f, 0.f, 0.f, 0.f};
            if (PASS == 3) {
#pragma unroll
                for (int ks = 0; ks < 4; ++ks) {
                    const bf16x8_t bf = ldfrag(St, 136, wave * 16, ks * 32, lane);
                    o0 = mma16(ldfrag(Qs, 136, 0, ks * 32, lane), bf, o0);
                    o1v = mma16(ldfrag(Qs, 136, 16, ks * 32, lane), bf, o1v);
                }
                if (wave < 4) {
                    const int ti = wave >> 1, si = wave & 1;
                    f32x4 am = {0.f, 0.f, 0.f, 0.f};
#pragma unroll
                    for (int ks = 0; ks < 4; ++ks) am = mma16(ldfrag(Qs, 136, ti * 16, ks * 32, lane), ldfrag(Kp, 136, si * 16, ks * 32, lane), am);
#pragma unroll
                    for (int r = 0; r < 4; ++r) { const int t = ti * 16 + lq * 4 + r, s = si * 16 + l15; Pm[t * 40 + s] = (u16)f2bf(s <= t ? am[r] : 0.f); }
                }
            }
            lbar();
            if (PASS == 3) {
                const bf16x8_t bf = ldfrag(Vt, 40, wave * 16, 0, lane);
                o0 = mma16(ldfrag(Pm, 40, 0, 0, lane), bf, o0);
                o1v = mma16(ldfrag(Pm, 40, 16, 0, lane), bf, o1v);
#pragma unroll
                for (int r = 0; r < 4; ++r) { Ob[(lq * 4 + r) * 128 + wave * 16 + l15] = (u16)f2bf(o0[r]); Ob[(16 + lq * 4 + r) * 128 + wave * 16 + l15] = (u16)f2bf(o1v[r]); }
            }
            {
                float d4[4];
#pragma unroll
                for (int r = 0; r < 4; ++r) d4[r] = __expf(Ldec[wave * 16 + lq * 4 + r]);
                const bf16x8_t af = ldfrag(Kt, 40, wave * 16, 0, lane);
#pragma unroll
                for (int vt = 0; vt < 8; ++vt) {
#pragma unroll
                    for (int r = 0; r < 4; ++r) S[vt][r] *= d4[r];
                    S[vt] = mma16(af, ldfrag(Vt, 40, vt * 16, 0, lane), S[vt]);
                }
                if (PASS == 3) {
#pragma unroll
                    for (int vt = 0; vt < 8; ++vt) *(uint2*)(St + (vt * 16 + l15) * 136 + wave * 16 + lq * 4) = make_uint2(pk2(S[vt][0], S[vt][1]), pk2(S[vt][2], S[vt][3]));
                }
            }
            if (PASS == 3) {
                lbar();
                const uint4 ov = *(const uint4*)(Ob + lrow * 128 + lch);
                *(uint4*)(AO + (size_t)TIME_ROW(seg, chunk * 32 + lrow, dir, b) * 512 + h * 128 + lch) = ov;
            }
        }
        if (PASS == 1) {
#pragma unroll
            for (int vt = 0; vt < 8; ++vt)
#pragma unroll
                for (int r = 0; r < 4; ++r) LC[(size_t)unit * 16384 + (wave * 16 + lq * 4 + r) * 128 + vt * 16 + l15] = S[vt][r];
            if (tid >= 384) DEC[unit * 128 + (tid & 127)] = __expf(ltot);
        }
    }
    lbar();
}

template <int PASS>
__device__ __forceinline__ void m2_mma(const Params& p, int j, unsigned char* lds) {
    const int tid = otid(), lane = tid & 63, wave = tid >> 6, l15 = lane & 15, lq = lane >> 4;
    constexpr int UB = 61184;
#define M2_QS(uu)  ((u16*)(lds + (uu) * UB))
#define M2_KP(uu)  (M2_QS(uu) + 32 * 136)
#define M2_KT(uu)  (M2_KP(uu) + 32 * 136)
#define M2_VT(uu)  (M2_KT(uu) + 128 * 40)
#define M2_PM(uu)  (M2_VT(uu) + 64 * 40)
#define M2_ST(uu)  (M2_PM(uu) + 32 * 40)
#define M2_OB(uu)  (M2_ST(uu) + 64 * 136)
#define M2_LAC(uu) ((float*)(M2_OB(uu) + 32 * 64))
#define M2_LDT(uu) (M2_LAC(uu) + 32)
#define M2_LXH(uu) ((u16*)(M2_LDT(uu) + 32))
    const u16* XB = (const u16*)(WSP(p) + EV_XBC);
    const float* DT = (const float*)(WSP(p) + EV_DT);
    float* LC = (float*)(WSP(p) + EV_BLC); float* DEC = (float*)(WSP(p) + EV_BDEC);
    const int xrow = (tid & 255) >> 3, xch = (tid & 7) * 8, brow = tid >> 4, bch = (tid & 15) * 8;
    const int ti = wave >> 2, pi = wave & 3;
    for (int up = obid(); up < 256; up += gridDim.x) {
        const int unit0 = up * 2;
        const int hd = (unit0 >> 4) & 7, b = (unit0 >> 7) & 1, dir = unit0 >> 8, g = hd >> 2, seg0 = unit0 & 15;
        u16* YO = (u16*)(WSP(p) + (dir ? EV_BYB : EV_BYF));
        const float a = -__expf(INP(p, I_M2ALOG)[(j * 2 + dir) * 8 + hd]);
        f32x4 S[2][4];
        __syncthreads();
#pragma unroll
        for (int uu = 0; uu < 2; ++uu) {
#pragma unroll
            for (int pt = 0; pt < 4; ++pt)
#pragma unroll
                for (int r = 0; r < 4; ++r) S[uu][pt][r] = (PASS == 1) ? 0.f : LC[(size_t)(unit0 + uu) * 8192 + (wave * 16 + lq * 4 + r) * 64 + pt * 16 + l15];
            if (PASS == 3) {
#pragma unroll
                for (int pt = 0; pt < 4; ++pt) *(uint2*)(M2_ST(uu) + (pt * 16 + l15) * 136 + wave * 16 + lq * 4) = make_uint2(pk2(S[uu][pt][0], S[uu][pt][1]), pk2(S[uu][pt][2], S[uu][pt][3]));
            }
        }
        float dsum0 = 0.f, dsum1 = 0.f;
        uint4 rx0, rx1, rb0, rb1, rc0, rc1; float rdt0, rdt1;
#define M2_LOAD1(sg, s0, RX, RB, RC, RDT) do { RX = make_uint4(0, 0, 0, 0); RC = make_uint4(0, 0, 0, 0); RDT = 0.f; \
            if (tid < 256) RX = *(const uint4*)(XB + (size_t)TIME_ROW(sg, (s0) + xrow, dir, b) * 1024 + hd * 64 + xch); \
            { const u16* base = XB + (size_t)TIME_ROW(sg, (s0) + brow, dir, b) * 1024 + 512 + g * 128 + bch; \
              RB = *(const uint4*)base; if (PASS == 3) RC = *(const uint4*)(base + 256); } \
            if (tid < 64) RDT = DT[(size_t)TIME_ROW(sg, (s0) + (tid & 31), dir, b) * 16 + dir * 8 + hd]; } while (0)
#define M2_LOAD(s0) do { M2_LOAD1(seg0, s0, rx0, rb0, rc0, rdt0); M2_LOAD1(seg0 + 1, s0, rx1, rb1, rc1, rdt1); } while (0)
        M2_LOAD(0);
        for (int chunk = 0; chunk < LSEG / 32; ++chunk) {
            lbar();
#pragma unroll
            for (int uu = 0; uu < 2; ++uu) {
                if (tid < 64) {
                    float val = (uu ? rdt1 : rdt0) * a;
#pragma unroll
                    for (int off = 1; off < 32; off <<= 1) { const float t = __builtin_bit_cast(float, __builtin_amdgcn_ds_bpermute((lane - off) << 2, __builtin_bit_cast(int, val))); if ((lane & 31) >= off) val += t; }
                    if (tid < 32) { M2_LAC(uu)[tid] = val; M2_LDT(uu)[tid] = (uu ? rdt1 : rdt0); }
                }
                if (PASS == 3) *(uint4*)(M2_QS(uu) + brow * 136 + bch) = (uu ? rc1 : rc0);
                *(uint4*)(M2_KP(uu) + brow * 136 + bch) = (uu ? rb1 : rb0);
                if (tid < 256) *(uint4*)(M2_LXH(uu) + xrow * 64 + xch) = (uu ? rx1 : rx0);
            }
            if (chunk + 1 < LSEG / 32) M2_LOAD((chunk + 1) * 32);
            lbar();
#pragma unroll
            for (int uu = 0; uu < 2; ++uu) {
                const int n = tid & 127, tq = tid >> 7; const float acC = M2_LAC(uu)[31];
                float o[8];
#pragma unroll
                for (int e = 0; e < 8; ++e) { const int t = tq * 8 + e; o[e] = bf2f(M2_KP(uu)[t * 136 + n]) * __expf(acC - M2_LAC(uu)[t]); }
                *(uint4*)(M2_KT(uu) + n * 40 + tq * 8) = PACK8_BF(o);
                if (tid < 256) {
                    const int pp = tid & 63, tq2 = tid >> 6;
#pragma unroll
                    for (int e = 0; e < 8; ++e) { const int t = tq2 * 8 + e; o[e] = bf2f(M2_LXH(uu)[t * 64 + pp]) * M2_LDT(uu)[t]; }
                    *(uint4*)(M2_VT(uu) + pp * 40 + tq2 * 8) = PACK8_BF(o);
                }
            }
            lbar();
            f32x4 o[2];
#pragma unroll
            for (int uu = 0; uu < 2; ++uu) {
                o[uu] = (f32x4){0.f, 0.f, 0.f, 0.f};
                if (PASS == 3) {
#pragma unroll
                    for (int ks = 0; ks < 4; ++ks) o[uu] = mma16(ldfrag(M2_QS(uu), 136, ti * 16, ks * 32, lane), ldfrag(M2_ST(uu), 136, pi * 16, ks * 32, lane), o[uu]);
#pragma unroll
                    for (int r = 0; r < 4; ++r) o[uu][r] *= __expf(M2_LAC(uu)[ti * 16 + lq * 4 + r]);
                }
            }
            if (PASS == 3) {
                const int uu = wave >> 2, w4 = wave & 3, t2 = w4 >> 1, si = w4 & 1;
                f32x4 am = {0.f, 0.f, 0.f, 0.f};
#pragma unroll
                for (int ks = 0; ks < 4; ++ks) am = mma16(ldfrag(M2_QS(uu), 136, t2 * 16, ks * 32, lane), ldfrag(M2_KP(uu), 136, si * 16, ks * 32, lane), am);
#pragma unroll
                for (int r = 0; r < 4; ++r) { const int t = t2 * 16 + lq * 4 + r, s2 = si * 16 + l15; M2_PM(uu)[t * 40 + s2] = (u16)f2bf(s2 <= t ? am[r] * __expf(M2_LAC(uu)[t] - M2_LAC(uu)[s2]) : 0.f); }
            }
            lbar();
#pragma unroll
            for (int uu = 0; uu < 2; ++uu) {
                if (PASS == 3) {
                    o[uu] = mma16(ldfrag(M2_PM(uu), 40, ti * 16, 0, lane), ldfrag(M2_VT(uu), 40, pi * 16, 0, lane), o[uu]);
#pragma unroll
                    for (int r = 0; r < 4; ++r) M2_OB(uu)[(ti * 16 + lq * 4 + r) * 64 + pi * 16 + l15] = (u16)f2bf(o[uu][r]);
                }
                const float acC = M2_LAC(uu)[31], dec = __expf(acC);
                if (uu) dsum1 += acC; else dsum0 += acC;
                const bf16x8_t af = ldfrag(M2_KT(uu), 40, wave * 16, 0, lane);
#pragma unroll
                for (int pt = 0; pt < 4; ++pt) {
#pragma unroll
                    for (int r = 0; r < 4; ++r) S[uu][pt][r] *= dec;
                    S[uu][pt] = mma16(af, ldfrag(M2_VT(uu), 40, pt * 16, 0, lane), S[uu][pt]);
                }
                if (PASS == 3) {
#pragma unroll
                    for (int pt = 0; pt < 4; ++pt) *(uint2*)(M2_ST(uu) + (pt * 16 + l15) * 136 + wave * 16 + lq * 4) = make_uint2(pk2(S[uu][pt][0], S[uu][pt][1]), pk2(S[uu][pt][2], S[uu][pt][3]));
                }
            }
            if (PASS == 3) {
                lbar();
                {
                    const int uu = tid >> 8;
                    const uint4 ov = *(const uint4*)(M2_OB(uu) + xrow * 64 + xch);
                    *(uint4*)(YO + (size_t)TIME_ROW(seg0 + uu, chunk * 32 + xrow, dir, b) * 512 + hd * 64 + xch) = ov;
                }
            }
        }
#undef M2_LOAD
#undef M2_LOAD1
        if (PASS == 1) {
#pragma unroll
            for (int uu = 0; uu < 2; ++uu) {
#pragma unroll
                for (int pt = 0; pt < 4; ++pt)
#pragma unroll
                    for (int r = 0; r < 4; ++r) LC[(size_t)(unit0 + uu) * 8192 + (wave * 16 + lq * 4 + r) * 64 + pt * 16 + l15] = S[uu][pt][r];
                if (tid == 0) DEC[unit0 + uu] = __expf(uu ? dsum1 : dsum0);
            }
        }
    }
    __syncthreads();
}

__device__ __forceinline__ void even_carry(const Params& p) {
    const int gt = obid() * 512 + otid(), gs = gridDim.x * 512;
    float* LA = (float*)(WSP(p) + EV_ALC); const float* DA = (const float*)(WSP(p) + EV_ADEC);
    for (int e = gt; e < 16 * 16384; e += gs) {
        const int seq = e >> 14, kv = e & 16383, k = kv >> 7;
        float t[NSEG], d[NSEG];
#pragma unroll
        for (int s = 0; s < NSEG; ++s) { t[s] = LA[(size_t)(seq * 16 + s) * 16384 + kv]; d[s] = DA[(seq * 16 + s) * 128 + k]; }
        float carry = 0.f;
#pragma unroll
        for (int s = 0; s < NSEG; ++s) { const float nc = fmaf(d[s], carry, t[s]); t[s] = carry; carry = nc; }
#pragma unroll
        for (int s = 0; s < NSEG; ++s) LA[(size_t)(seq * 16 + s) * 16384 + kv] = t[s];
    }
    float* LB = (float*)(WSP(p) + EV_BLC); const float* DB = (const float*)(WSP(p) + EV_BDEC);
    for (int e = gt; e < 32 * 8192; e += gs) {
        const int seq = e >> 13, pn = e & 8191;
        float t[NSEG], d[NSEG];
#pragma unroll
        for (int s = 0; s < NSEG; ++s) { t[s] = LB[(size_t)(seq * 16 + s) * 8192 + pn]; d[s] = DB[seq * 16 + s]; }
        float carry = 0.f;
#pragma unroll
        for (int s = 0; s < NSEG; ++s) { const float nc = fmaf(d[s], carry, t[s]); t[s] = carry; carry = nc; }
#pragma unroll
        for (int s = 0; s < NSEG; ++s) LB[(size_t)(seq * 16 + s) * 8192 + pn] = t[s];
    }
}

__device__ __forceinline__ void even_conv(const Params& p, int j) {
    const int gt = obid() * 512 + otid(), gs = gridDim.x * 512;
    const u16* P = (const u16*)(WSP(p) + WS_P); u16* XB = (u16*)(WSP(p) + EV_XBC);
    const float* cw = INP(p, I_M2CW) + (size_t)j * 5 * 1024; const float* cb = INP(p, I_M2CB) + (size_t)j * 1024;
    for (int e = gt; e < (T_TOK / 16) * 128; e += gs) {
        const int ch = (e & 127) * 8, row0 = (e >> 7) * 16, tpos0 = row0 & (SEQ - 1);
        float w[5][8], bias[8];
#pragma unroll
        for (int jj = 0; jj < 5; ++jj) { const float4 a = *(const float4*)(cw + jj * 1024 + ch), b2 = *(const float4*)(cw + jj * 1024 + ch + 4); w[jj][0] = a.x; w[jj][1] = a.y; w[jj][2] = a.z; w[jj][3] = a.w; w[jj][4] = b2.x; w[jj][5] = b2.y; w[jj][6] = b2.z; w[jj][7] = b2.w; }
        { const float4 a = *(const float4*)(cb + ch), b2 = *(const float4*)(cb + ch + 4); bias[0] = a.x; bias[1] = a.y; bias[2] = a.z; bias[3] = a.w; bias[4] = b2.x; bias[5] = b2.y; bias[6] = b2.z; bias[7] = b2.w; }
        uint4 xr[20];
#pragma unroll
        for (int q = 0; q < 20; ++q) {
            const int tt = tpos0 + q - 2;
            xr[q] = make_uint4(0, 0, 0, 0);
            if (tt >= 0 && tt < SEQ) xr[q] = *(const uint4*)(P + (size_t)(row0 + q - 2) * EV_N + 3072 + ch);
        }
#pragma unroll
        for (int t = 0; t < 16; ++t) {
            float x0[8], x1[8], x2[8], x3[8], x4[8];
            UNPACK8_BF(xr[t], x0); UNPACK8_BF(xr[t + 1], x1); UNPACK8_BF(xr[t + 2], x2); UNPACK8_BF(xr[t + 3], x3); UNPACK8_BF(xr[t + 4], x4);
            float acc[8];
#pragma unroll
            for (int i = 0; i < 8; ++i) {
                float a = bias[i];
                a = fmaf(x0[i], w[0][i], a); a = fmaf(x1[i], w[1][i], a); a = fmaf(x2[i], w[2][i], a); a = fmaf(x3[i], w[3][i], a); a = fmaf(x4[i], w[4][i], a);
                acc[i] = siluf_(a);
            }
            *(uint4*)(XB + (size_t)(row0 + t) * 1024 + ch) = PACK8_BF(acc);
        }
    }
}

__device__ __forceinline__ void even_dt(const Params& p, int j, unsigned char* lds) {
    const int tid = otid(), lane = tid & 63, l15 = lane & 15, lq = lane >> 4, gw = obid() * 8 + (tid >> 6), nw = gridDim.x * 8;
    u16* Wt = (u16*)lds;
    const float* W = INP(p, I_EVIN) + (size_t)j * DM * 4112 + 4096;
    const u16* XA = (const u16*)(WSP(p) + WS_XA); float* DT = (float*)(WSP(p) + EV_DT);
    __syncthreads();
    {
        float tmp[32];
#pragma unroll
        for (int q = 0; q < 32; ++q) { const int idx = tid + 512 * q; tmp[q] = W[(size_t)(idx >> 4) * 4112 + (idx & 15)]; }
#pragma unroll
        for (int q = 0; q < 32; ++q) { const int idx = tid + 512 * q; Wt[(idx & 15) * 1032 + (idx >> 4)] = (u16)f2bf(tmp[q]); }
    }
    __syncthreads();
    const float bias = INP(p, I_M2DTB)[j * 16 + l15];
    for (int tile = gw; tile < T_TOK / 16; tile += nw) {
        const u16* arow = XA + (size_t)(tile * 16 + l15) * DM + 8 * lq;
        f32x4 acc = {0.f, 0.f, 0.f, 0.f};
#pragma unroll 8
        for (int ks = 0; ks < 32; ++ks) acc = mma16(*(const bf16x8_t*)(arow + ks * 32), ldfrag(Wt, 1032, 0, ks * 32, lane), acc);
#pragma unroll
        for (int r = 0; r < 4; ++r) DT[(size_t)(tile * 16 + lq * 4 + r) * 16 + l15] = softplusf_(acc[r] + bias);
    }
    __syncthreads();
}

__device__ __forceinline__ void even_post(const Params& p, int j) {
    const int lane = otid() & 63, gw = obid() * 8 + (otid() >> 6), nw = gridDim.x * 8;
    const u16* P = (const u16*)(WSP(p) + WS_P); const u16* XB = (const u16*)(WSP(p) + EV_XBC);
    const u16* AOF = (const u16*)(WSP(p) + EV_AOF); const u16* AOB = (const u16*)(WSP(p) + EV_AOB);
    const u16* BYF = (const u16*)(WSP(p) + EV_BYF); const u16* BYB = (const u16*)(WSP(p) + EV_BYB);
    u16* O = (u16*)(WSP(p) + WS_XA);
    const int c = lane * 8;
    float hnw[8], mnw[8];
#pragma unroll
    for (int i = 0; i < 8; ++i) { hnw[i] = INP(p, I_HGNW)[j * 128 + ((c + i) & 127)]; mnw[i] = INP(p, I_M2NW)[j * 512 + c + i]; }
    const float dsk = INP(p, I_M2D)[j * 8 + (lane >> 3)];
    for (int rowb = gw * 2; rowb < T_TOK; rowb += nw * 2) {
        uint4 q[2][7];
#pragma unroll
        for (int r = 0; r < 2; ++r) {
            const size_t row = rowb + r;
            q[r][0] = *(const uint4*)(AOF + row * 512 + c); q[r][1] = *(const uint4*)(AOB + row * 512 + c); q[r][2] = *(const uint4*)(P + row * EV_N + 2048 + c);
            q[r][3] = *(const uint4*)(BYF + row * 512 + c); q[r][4] = *(const uint4*)(BYB + row * 512 + c); q[r][5] = *(const uint4*)(XB + row * 1024 + c); q[r][6] = *(const uint4*)(P + row * EV_N + 2560 + c);
        }
#pragma unroll
        for (int r = 0; r < 2; ++r) {
            const size_t row = rowb + r;
            float a[8], t[8], o[8];
            UNPACK8_BF(q[r][0], a); UNPACK8_BF(q[r][1], t);
            float ss = 0.f;
#pragma unroll
            for (int i = 0; i < 8; ++i) { a[i] += t[i]; ss += a[i] * a[i]; }
            ss = red16(ss);
            float rs = rsqrtf(ss * (1.f / 128.f) + 1e-6f);
            UNPACK8_BF(q[r][2], t);
#pragma unroll
            for (int i = 0; i < 8; ++i) o[i] = a[i] * rs * hnw[i] * t[i];
            *(uint4*)(O + row * DM + c) = PACK8_BF(o);
            UNPACK8_BF(q[r][3], a); UNPACK8_BF(q[r][4], t);
#pragma unroll
            for (int i = 0; i < 8; ++i) a[i] += t[i];
            UNPACK8_BF(q[r][5], t);
#pragma unroll
            for (int i = 0; i < 8; ++i) a[i] = fmaf(t[i], dsk, a[i]);
            UNPACK8_BF(q[r][6], t);
            ss = 0.f;
#pragma unroll
            for (int i = 0; i < 8; ++i) { a[i] *= t[i]; ss += a[i] * a[i]; }
            ss = red32(ss);
            rs = rsqrtf(ss * (1.f / 256.f) + 1e-6f);
#pragma unroll
            for (int i = 0; i < 8; ++i) o[i] = a[i] * rs * mnw[i];
            *(uint4*)(O + row * DM + 512 + c) = PACK8_BF(o);
        }
    }
}

__device__ __forceinline__ void odd_shift(const Params& p, int j) {
    const int lane = otid() & 63, gw = obid() * 8 + (otid() >> 6), nw = gridDim.x * 8;
    const u16* P = (const u16*)(WSP(p) + WS_P);
    const float* mu0 = INP(p, I_MU) + (size_t)(j * 2 + 0) * RWIN; const float* mu1 = INP(p, I_MU) + (size_t)(j * 2 + 1) * RWIN;
    u16* R = (u16*)(WSP(p) + OD_R); u16* V = (u16*)(WSP(p) + OD_V); u16* KK = (u16*)(WSP(p) + OD_KK); u16* KP = (u16*)(WSP(p) + OD_KP);
    u16* XL = (u16*)(WSP(p) + OD_XL); u16* A1 = (u16*)(WSP(p) + OD_A1);
    float kkw[8];
#pragma unroll
    for (int e = 0; e < 8; ++e) kkw[e] = INP(p, I_KK)[j * 512 + lane * 8 + e];
    for (int row = gw; row < T_TOK; row += nw) {
        const int tpos = row & (SEQ - 1);
        unsigned zz = 0; asm volatile("" : "+v"(zz));
        const u16* pc = P + (size_t)row * OD_N;
        uint4 cv[4], pv[4], nv[4];
#pragma unroll
        for (int i = 0; i < 4; ++i) {
            const int o = lane + 64 * i;
            cv[i] = make_uint4(zz, zz, zz, zz); pv[i] = cv[i]; nv[i] = cv[i];
            if (o < 220) { cv[i] = *(const uint4*)(pc + o * 8); if (tpos > 0) pv[i] = *(const uint4*)(pc - OD_N + o * 8); if (tpos < SEQ - 1) nv[i] = *(const uint4*)(pc + OD_N + o * 8); }
        }
        const uint4 uv = *(const uint4*)(pc + RWIN + lane * 8);
#pragma unroll
        for (int i = 0; i < 4; ++i) {
            const int o = lane + 64 * i, col = o * 8;
            if (o < 220) {
                float c8[8], p8[8], n8[8], m0[8], m1[8], sh[8];
                UNPACK8_BF(cv[i], c8); UNPACK8_BF(pv[i], p8); UNPACK8_BF(nv[i], n8);
                { const float4 a = *(const float4*)(mu0 + col), b2 = *(const float4*)(mu0 + col + 4); m0[0] = a.x; m0[1] = a.y; m0[2] = a.z; m0[3] = a.w; m0[4] = b2.x; m0[5] = b2.y; m0[6] = b2.z; m0[7] = b2.w; }
                { const float4 a = *(const float4*)(mu1 + col), b2 = *(const float4*)(mu1 + col + 4); m1[0] = a.x; m1[1] = a.y; m1[2] = a.z; m1[3] = a.w; m1[4] = b2.x; m1[5] = b2.y; m1[6] = b2.z; m1[7] = b2.w; }
#pragma unroll
                for (int e = 0; e < 8; ++e) sh[e] = c8[e] + (p8[e] - c8[e]) * m0[e] + (n8[e] - c8[e]) * m1[e];
                if (i == 0) *(uint4*)(R + (size_t)row * 512 + col) = PACK8_BF(sh);
                else if (i == 1) {
                    *(uint4*)(KP + (size_t)row * 512 + col - 512) = PACK8_BF(sh);
                    float ss = 0.f;
#pragma unroll
                    for (int e = 0; e < 8; ++e) { sh[e] *= kkw[e]; ss += sh[e] * sh[e]; }
                    ss = red8(ss);
                    const float inv = 1.f / fmaxf(sqrtf(ss), 1e-12f);
#pragma unroll
                    for (int e = 0; e < 8; ++e) sh[e] *= inv;
                    *(uint4*)(KK + (size_t)row * 512 + col - 512) = PACK8_BF(sh);
                } else if (i == 2) *(uint4*)(V + (size_t)row * 512 + col - 1024) = PACK8_BF(sh);
                else {
                    const int cc = col - 1536;
#pragma unroll
                    for (int e = 0; e < 8; ++e) sh[e] = (cc < 64) ? tanhf_(sh[e]) : ((cc >= 128) ? sigmoidf_(sh[e]) : sh[e]);
                    *(uint4*)(XL + (size_t)row * 256 + cc) = PACK8_BF(sh);
                }
            } else if (o < 224) *(uint4*)(XL + (size_t)row * 256 + (o - 192) * 8) = make_uint4(zz, zz, zz, zz);
        }
        { const int c = lane * 8; *(uint4*)(A1 + ((size_t)(c >> 4) * 1024 + (row >> 13) * 512 + (tpos >> 4)) * 512 + (tpos & 15) * 16 + (c & 15)) = uv; }
    }
}
__device__ __forceinline__ void build_lora_weight(const Params& p, int j, int lbid, int lgsz) {
    u16* BT = (u16*)(WSP(p) + OD_BTL);
    const float* w2 = INP(p, I_W2) + (size_t)j * 2 * 32 * 512; const float* a2 = INP(p, I_A2) + (size_t)j * 2 * 32 * 512; const float* g2 = INP(p, I_G2) + (size_t)j * 96 * 512;
    for (int e = lbid * 512 + otid(); e < 2560 * 32; e += lgsz * 512) {
        const int n = e % 2560, ko = e / 2560, k0 = ko * 8, reg = n >> 9, c = n & 511;
        float o[8];
#pragma unroll
        for (int q = 0; q < 8; ++q) {
            const int k = k0 + q; float v = 0.f;
            if (reg < 4) { if (k >= reg * 32 && k < reg * 32 + 32) v = ((reg < 2) ? w2 : a2)[((reg & 1) * 32 + (k - reg * 32)) * 512 + c]; }
            else if (k >= 128 && k < 224) v = g2[(k - 128) * 512 + c];
            o[q] = v;
        }
        *(uint4*)(BT + (size_t)n * 256 + k0) = PACK8_BF(o);
    }
}
struct EpiLora {
    static constexpr bool PERM = true, AFTER_DRAIN = false;
    unsigned char* ws; const float* w0; const float* a0;
    __device__ __forceinline__ void operator()(const f32x4 (&acc)[2][2][4][2], const pg8::Unit& u, int wr, int wc, int fr, int fq) const {
        const int reg = u.pn >> 1, row0 = u.pm * 256 + wr * 64 + fr, c0 = (u.pn & 1) * 256 + wc * 32 + 8 * fq;
        if (reg < 2) {
            u16* dst = (u16*)(ws + (reg ? OD_WB1 : OD_WF1));
#pragma unroll
            for (int bj = 0; bj < 2; ++bj) {
                const int c = c0 + bj * 128;
                float bias[8];
#pragma unroll
                for (int e = 0; e < 8; ++e) bias[e] = w0[reg * 512 + c + e];
#pragma unroll
                for (int ai = 0; ai < 2; ++ai)
#pragma unroll
                    for (int m = 0; m < 4; ++m) {
                        float x[8];
#pragma unroll
                        for (int n = 0; n < 2; ++n)
#pragma unroll
                            for (int e = 0; e < 4; ++e) x[n * 4 + e] = 1.f - __expf(-0.6065306597f * sigmoidf_(acc[ai][bj][m][n][e] + bias[n * 4 + e]));
                        *(uint4*)(dst + (size_t)(row0 + ai * 128 + m * 16) * 512 + c) = PACK8_H(x);
                    }
            }
        } else if (reg < 4) {
            u16* dA = (u16*)(ws + (reg == 3 ? OD_AB : OD_AF));
#pragma unroll
            for (int bj = 0; bj < 2; ++bj) {
                const int c = c0 + bj * 128;
                float bias[8];
#pragma unroll
                for (int e = 0; e < 8; ++e) bias[e] = a0[(reg & 1) * 512 + c + e];
#pragma unroll
                for (int ai = 0; ai < 2; ++ai)
#pragma unroll
                    for (int m = 0; m < 4; ++m) {
                        float x[8];
#pragma unroll
                        for (int n = 0; n < 2; ++n)
#pragma unroll
                            for (int e = 0; e < 4; ++e) x[n * 4 + e] = sigmoidf_(acc[ai][bj][m][n][e] + bias[n * 4 + e]);
                        *(uint4*)(dA + (size_t)(row0 + ai * 128 + m * 16) * 512 + c) = PACK8_BF(x);
                    }
            }
        } else {
            u16* dst = (u16*)(ws + OD_G);
#pragma unroll
            for (int ai = 0; ai < 2; ++ai)
#pragma unroll
                for (int m = 0; m < 4; ++m)
#pragma unroll
                    for (int bj = 0; bj < 2; ++bj) {
                        const f32x4 v0 = acc[ai][bj][m][0], v1 = acc[ai][bj][m][1];
                        *(uint4*)(dst + (size_t)(row0 + ai * 128 + m * 16) * 512 + c0 + bj * 128) = make_uint4(pk2(v0[0], v0[1]), pk2(v0[2], v0[3]), pk2(v1[0], v1[1]), pk2(v1[2], v1[3]));
                    }
        }
    }
};

template <int PASS>
__device__ __forceinline__ void rw_scan(const Params& p, unsigned char* lds) {
    const int tid = otid();
    constexpr int NTH = (PASS == 1) ? 512 : 256;
    const int half = (PASS == 1) ? 0 : (tid >> 8), lt = tid & (NTH - 1);
    float* base = (float*)lds + half * (6 * 2048 + 1024);
    float* Lkk = base; float* Lw = base + 2048; float* Lb = base + 4096; float* Lk = base + 6144; float* Lv = base + 8192; float* Lr = base + 10240;
    u16* Lo = (u16*)(base + 12288);
    const int row = lt >> 2, cg = lt & 3;
    const int lrow = (lt & 255) >> 3, lch = (lt & 7) * 8, lsel = (PASS == 1) ? (tid >> 8) : 0;
    float* LCs = (float*)(WSP(p) + OD_CLC); float* PM = (float*)(WSP(p) + OD_CPM);
    const int nitems = (PASS == 1) ? 512 : 256;
    for (int item = obid(); item < nitems; item += gridDim.x) {
        const int unit = (PASS == 1) ? item : item * 2 + half;
        const int seg = unit & 15, hd = (unit >> 4) & 7, b = (unit >> 7) & 1, dir = unit >> 8;
        const u16* aKK = (const u16*)(WSP(p) + OD_KK); const u16* aA = (const u16*)(WSP(p) + (dir ? OD_AB : OD_AF)); const u16* aV = (const u16*)(WSP(p) + OD_V);
        const u16* aK = (const u16*)(WSP(p) + (dir ? OD_KB : OD_KF)); const u16* aW = (const u16*)(WSP(p) + (dir ? OD_WB1 : OD_WF1)); const u16* aR = (const u16*)(WSP(p) + OD_R);
        u16* YO = (u16*)(WSP(p) + (dir ? OD_CYB : OD_CYF));
        float st[16];
        if (PASS == 1) {
#pragma unroll
            for (int e = 0; e < 16; ++e) st[e] = (row >= 64 && (row - 64) == cg * 16 + e) ? 1.f : 0.f;
        } else {
#pragma unroll
            for (int e = 0; e < 16; ++e) st[e] = LCs[(size_t)unit * 4096 + row * 64 + cg * 16 + e];
        }
        uint4 r0, r1, r2, r3 = make_uint4(0, 0, 0, 0), r4 = make_uint4(0, 0, 0, 0), r5 = make_uint4(0, 0, 0, 0);
#define RW_LOAD(s0) do { const size_t go = (size_t)TIME_ROW(seg, (s0) + lrow, dir, b) * 512 + hd * 64 + lch; \
        if (PASS == 1) { if (lsel == 0) { r0 = *(const uint4*)(aKK + go); r1 = *(const uint4*)(aA + go); r2 = *(const uint4*)(aV + go); } \
                         else { r0 = *(const uint4*)(aK + go); r1 = *(const uint4*)(aW + go); r2 = make_uint4(0, 0, 0, 0); } } \
        else { r0 = *(const uint4*)(aKK + go); r1 = *(const uint4*)(aA + go); r2 = *(const uint4*)(aV + go); r3 = *(const uint4*)(aK + go); r4 = *(const uint4*)(aW + go); r5 = *(const uint4*)(aR + go); } } while (0)
        RW_LOAD(0);
        for (int tile = 0; tile < LSEG / 32; ++tile) {
            __syncthreads();
            {
                float f[8], g8[8]; const int lo = lrow * 64 + lch;
                if (PASS == 1) {
                    if (lsel == 0) { UNPACK8_BF(r0, f); ST8F(Lkk + lo, f); UNPACK8_BF(r1, g8);
#pragma unroll
                        for (int e = 0; e < 8; ++e) g8[e] *= f[e];
                        ST8F(Lb + lo, g8); UNPACK8_BF(r2, f); ST8F(Lv + lo, f); }
                    else { UNPACK8_BF(r0, f); ST8F(Lk + lo, f); UNPACK8_H(r1, f);
#pragma unroll
                        for (int e = 0; e < 8; ++e) f[e] = 1.f - f[e];
                        ST8F(Lw + lo, f); }
                } else {
                    UNPACK8_BF(r0, f); ST8F(Lkk + lo, f); UNPACK8_BF(r1, g8);
#pragma unroll
                    for (int e = 0; e < 8; ++e) g8[e] *= f[e];
                    ST8F(Lb + lo, g8); UNPACK8_BF(r2, f); ST8F(Lv + lo, f);
                    UNPACK8_BF(r3, f); ST8F(Lk + lo, f); UNPACK8_H(r4, f);
#pragma unroll
                    for (int e = 0; e < 8; ++e) f[e] = 1.f - f[e];
                    ST8F(Lw + lo, f); UNPACK8_BF(r5, f); ST8F(Lr + lo, f);
                }
            }
            __syncthreads();
            if (tile + 1 < LSEG / 32) RW_LOAD((tile + 1) * 32);
            for (int s = 0; s < 32; ++s) {
                const float vv = (PASS == 1 && row >= 64) ? 0.f : Lv[s * 64 + (row & 63)];
                float4 kk4[4];
                float sa = 0.f;
#pragma unroll
                for (int q = 0; q < 4; ++q) {
                    kk4[q] = *(const float4*)(Lkk + s * 64 + cg * 16 + q * 4);
                    sa = fmaf(st[q * 4 + 0], kk4[q].x, sa); sa = fmaf(st[q * 4 + 1], kk4[q].y, sa); sa = fmaf(st[q * 4 + 2], kk4[q].z, sa); sa = fmaf(st[q * 4 + 3], kk4[q].w, sa);
                }
                sa = -red4(sa);
                float y = 0.f;
#pragma unroll
                for (int q = 0; q < 4; ++q) {
                    const float4 w4 = *(const float4*)(Lw + s * 64 + cg * 16 + q * 4), b4 = *(const float4*)(Lb + s * 64 + cg * 16 + q * 4), k4 = *(const float4*)(Lk + s * 64 + cg * 16 + q * 4);
                    st[q * 4 + 0] = fmaf(st[q * 4 + 0], w4.x, fmaf(sa, b4.x, vv * k4.x));
                    st[q * 4 + 1] = fmaf(st[q * 4 + 1], w4.y, fmaf(sa, b4.y, vv * k4.y));
                    st[q * 4 + 2] = fmaf(st[q * 4 + 2], w4.z, fmaf(sa, b4.z, vv * k4.z));
                    st[q * 4 + 3] = fmaf(st[q * 4 + 3], w4.w, fmaf(sa, b4.w, vv * k4.w));
                    if (PASS == 3) {
                        const float4 r4v = *(const float4*)(Lr + s * 64 + cg * 16 + q * 4);
                        y = fmaf(st[q * 4 + 0], r4v.x, y); y = fmaf(st[q * 4 + 1], r4v.y, y); y = fmaf(st[q * 4 + 2], r4v.z, y); y = fmaf(st[q * 4 + 3], r4v.w, y);
                    }
                }
                if (PASS == 3) { y = red4(y); if (cg == 0) Lo[s * 64 + row] = (u16)f2bf(y); }
            }
            if (PASS == 3) {
                __syncthreads();
                const uint4 ov = *(const uint4*)(Lo + lrow * 64 + lch);
                *(uint4*)(YO + (size_t)TIME_ROW(seg, tile * 32 + lrow, dir, b) * 512 + hd * 64 + lch) = ov;
            }
        }
#undef RW_LOAD
        if (PASS == 1) {
            float* dst = (row < 64) ? (LCs + (size_t)unit * 4096 + row * 64 + cg * 16) : (PM + (size_t)unit * 4096 + (row - 64) * 64 + cg * 16);
#pragma unroll
            for (int e = 0; e < 16; ++e) dst[e] = st[e];
        }
    }
    __syncthreads();
}


template <int PASS>
__device__ __forceinline__ void rw_mma(const Params& p, int jl, unsigned char* lds) {
    constexpr int NRT = (PASS == 1) ? 2 : 1, NST = (PASS == 1) ? 4 : 2;
    const int tid = otid(), lane = tid & 63, wave = tid >> 6, l15 = lane & 15, lq = lane >> 4;
    u16* At = (u16*)lds;
    u16* Rt = At + 32 * 72;
    u16* Bn = Rt + 32 * 72;
    u16* Kn = Bn + 32 * 72;
    u16* BhT = Kn + 32 * 72;
    u16* KhT = BhT + 64 * 40;
    u16* VT = KhT + 64 * 40;
    u16* Sb = VT + 128 * 40;
    u16* RhsT = Sb + 128 * 72;
    u16* SAT = RhsT + 128 * 40;
    u16* Mx = SAT + 128 * 40;
    u16* Mak = Mx; u16* Mrb = Mx + 1280; u16* Mrk = Mx + 2560;
    u16* Yb = Mx + 9 * 1280;
    float* Lc = (float*)(Yb + 2048);
    float* Lp = Lc + 2048;
    float* Ltot = Lp + 512;
    u16* Lkkh = (u16*)(Ltot + 64); u16* Lah = Lkkh + 2048; u16* Lkdh = Lah + 2048; u16* Lvh2 = Lkdh + 2048;
    float* LCs = (float*)(WSP(p) + OD_CLC); float* PM = (float*)(WSP(p) + OD_CPM);
    u16* TIG = (u16*)(WSP(p) + OD_TINV);
    const int et = tid >> 4, ech = (tid & 15) * 4;
    const int svt = (PASS == 1) ? wave : (wave >> 1), kt0 = (PASS == 1) ? 0 : (wave & 1) * 2;
    for (int unit = obid(); unit < 512; unit += gridDim.x) {
        const int seg = unit & 15, hd = (unit >> 4) & 7, b = (unit >> 7) & 1, dir = unit >> 8;
        const u16* aKK = (const u16*)(WSP(p) + OD_KK); const u16* aA = (const u16*)(WSP(p) + (dir ? OD_AB : OD_AF)); const u16* aV = (const u16*)(WSP(p) + OD_V);
        const u16* aK = (const u16*)(WSP(p) + OD_KP); const u16* aW = (const u16*)(WSP(p) + (dir ? OD_WB1 : OD_WF1)); const u16* aR = (const u16*)(WSP(p) + OD_R);
        u16* YO = (u16*)(WSP(p) + (dir ? OD_CYB : OD_CYF));
        const float4 ka4 = *(const float4*)(INP(p, I_KA) + jl * 512 + hd * 64 + ech); const float kag = INP(p, I_KA)[jl * 512 + hd * 64 + (tid & 63)];
        f32x4 S[NST];
        __syncthreads();
#pragma unroll
        for (int q = 0; q < NST; ++q)
#pragma unroll
            for (int r = 0; r < 4; ++r) {
                const int v = svt * 16 + lq * 4 + r, k = (kt0 + q) * 16 + l15;
                S[q][r] = (PASS == 1) ? ((v >= 64 && v - 64 == k) ? 1.f : 0.f) : LCs[(size_t)unit * 4096 + v * 64 + k];
                Sb[v * 72 + k] = (u16)f2bf(S[q][r]);
            }
        if (PASS == 1) { for (int e = tid; e < 64 * 40; e += 512) VT[64 * 40 + e] = 0; }
        uint2 r0, r1, r2, r3, r4, r5 = make_uint2(0, 0); uint4 rti = make_uint4(0, 0, 0, 0);
#define RWM_LOAD(s0) do { const size_t go = (size_t)TIME_ROW(seg, (s0) + et, dir, b) * 512 + hd * 64 + ech; \
        r0 = *(const uint2*)(aKK + go); r1 = *(const uint2*)(aA + go); r2 = *(const uint2*)(aV + go); r3 = *(const uint2*)(aK + go); r4 = *(const uint2*)(aW + go); if (PASS == 3) { r5 = *(const uint2*)(aR + go); if (tid < 160) rti = *(const uint4*)(TIG + ((size_t)unit * 16 + ((s0) >> 5)) * 1280 + tid * 8); } } while (0)
        RWM_LOAD(0);
        for (int chunk = 0; chunk < LSEG / 32; ++chunk) {
            float kk[4], ai[4], vv[4], kd[4], w1[4], rr[4];
            kk[0] = bf2f(r0.x & 0xffffu); kk[1] = bf2f(r0.x >> 16); kk[2] = bf2f(r0.y & 0xffffu); kk[3] = bf2f(r0.y >> 16);
            ai[0] = bf2f(r1.x & 0xffffu); ai[1] = bf2f(r1.x >> 16); ai[2] = bf2f(r1.y & 0xffffu); ai[3] = bf2f(r1.y >> 16);
            vv[0] = bf2f(r2.x & 0xffffu); vv[1] = bf2f(r2.x >> 16); vv[2] = bf2f(r2.y & 0xffffu); vv[3] = bf2f(r2.y >> 16);
            kd[0] = bf2f(r3.x & 0xffffu); kd[1] = bf2f(r3.x >> 16); kd[2] = bf2f(r3.y & 0xffffu); kd[3] = bf2f(r3.y >> 16);
            kd[0] *= 1.f + (ai[0] - 1.f) * ka4.x; kd[1] *= 1.f + (ai[1] - 1.f) * ka4.y; kd[2] *= 1.f + (ai[2] - 1.f) * ka4.z; kd[3] *= 1.f + (ai[3] - 1.f) * ka4.w;
            w1[0] = h2f(r4.x & 0xffffu); w1[1] = h2f(r4.x >> 16); w1[2] = h2f(r4.y & 0xffffu); w1[3] = h2f(r4.y >> 16);
            rr[0] = bf2f(r5.x & 0xffffu); rr[1] = bf2f(r5.x >> 16); rr[2] = bf2f(r5.y & 0xffffu); rr[3] = bf2f(r5.y >> 16);
            lbar();
            *(float4*)(Lc + et * 64 + ech) = make_float4(__logf(1.f - w1[0]), __logf(1.f - w1[1]), __logf(1.f - w1[2]), __logf(1.f - w1[3]));
            if (PASS == 3 && tid < 160) *(uint4*)(Mx + 3 * 1280 + tid * 8) = rti;
            *(uint2*)(Lkkh + et * 64 + ech) = r0; *(uint2*)(Lah + et * 64 + ech) = r1; *(uint2*)(Lvh2 + et * 64 + ech) = r2; *(uint2*)(Lkdh + et * 64 + ech) = r3;
            if (chunk + 1 < LSEG / 32) RWM_LOAD((chunk + 1) * 32);
            lbar();
            {
                const int k = tid & 63, tg = tid >> 6;
                float c4[4]; float run = 0.f;
#pragma unroll
                for (int i = 0; i < 4; ++i) { run += Lc[(tg * 4 + i) * 64 + k]; c4[i] = run; }
                Lp[tg * 64 + k] = run;
                lbar();
                float off = 0.f;
#pragma unroll
                for (int g2 = 0; g2 < 7; ++g2) off += (g2 < tg) ? Lp[g2 * 64 + k] : 0.f;
#pragma unroll
                for (int i = 0; i < 4; ++i) Lc[(tg * 4 + i) * 64 + k] = c4[i] + off;
                if (tg == 7) Ltot[k] = c4[3] + off;
            }
            lbar();
            {
                const float4 cu = *(const float4*)(Lc + et * 64 + ech);
                float4 cx = make_float4(0.f, 0.f, 0.f, 0.f); if (et > 0) cx = *(const float4*)(Lc + (et - 1) * 64 + ech);
                const float4 tt = *(const float4*)(Ltot + ech);
                const float cum[4] = {cu.x, cu.y, cu.z, cu.w}, cmx[4] = {cx.x, cx.y, cx.z, cx.w}, tot[4] = {tt.x, tt.y, tt.z, tt.w};
                float oa[4], orr[4], ob[4], ok[4];
#pragma unroll
                for (int e = 0; e < 4; ++e) {
                    const float bq = kk[e] * ai[e], einv = __expf(-cum[e]);
                    oa[e] = -kk[e] * __expf(cmx[e]); orr[e] = rr[e] * __expf(cum[e]); ob[e] = bq * einv; ok[e] = kd[e] * einv;
                }
                *(uint2*)(At + et * 72 + ech) = make_uint2(pk2(oa[0], oa[1]), pk2(oa[2], oa[3]));
                *(uint2*)(Bn + et * 72 + ech) = make_uint2(pk2(ob[0], ob[1]), pk2(ob[2], ob[3]));
                *(uint2*)(Kn + et * 72 + ech) = make_uint2(pk2(ok[0], ok[1]), pk2(ok[2], ok[3]));
                if (PASS == 3) *(uint2*)(Rt + et * 72 + ech) = make_uint2(pk2(orr[0], orr[1]), pk2(orr[2], orr[3]));
            }
            {
                const int k = tid & 63, tq = (tid >> 6) & 3, which = tid >> 8; const float tk = Ltot[k];
                float o[8]; unsigned vb[8];
#pragma unroll
                for (int e = 0; e < 8; ++e) {
                    const int t = tq * 8 + e; const float etot = __expf(tk - Lc[t * 64 + k]);
                    const float av = bf2f(Lah[t * 64 + k]);
                    o[e] = (which ? bf2f(Lkdh[t * 64 + k]) * (1.f + (av - 1.f) * kag) : bf2f(Lkkh[t * 64 + k]) * av) * etot; vb[e] = Lvh2[t * 64 + k];
                }
                *(uint4*)((which ? KhT : BhT) + k * 40 + tq * 8) = PACK8_BF(o);
                if (which == 0) *(uint4*)(VT + k * 40 + tq * 8) = make_uint4(vb[0] | (vb[1] << 16), vb[2] | (vb[3] << 16), vb[4] | (vb[5] << 16), vb[6] | (vb[7] << 16));
            }
            lbar();
            u16* Xc = Mx + 3 * 1280; u16* Xn = Mx + 4 * 1280; u16* Nc = Mx + 5 * 1280; u16* NcT = Mx + 6 * 1280; u16* Nn = Mx + 7 * 1280; u16* NnT = Mx + 8 * 1280;
            {
                const int mat = wave >> 1, ti = wave & 1;
                if ((PASS == 3 && mat > 0) || (PASS == 1 && mat < 2)) {
                    const u16* Aop = (mat < 2) ? At : Rt; const u16* Bop = (mat & 1) ? Kn : Bn;
                    const bf16x8_t a0 = ldfrag(Aop, 72, ti * 16, 0, lane), a1 = ldfrag(Aop, 72, ti * 16, 32, lane);
#pragma unroll
                    for (int si = 0; si < 2; ++si) {
                        f32x4 am = {0.f, 0.f, 0.f, 0.f};
                        am = mma16(a0, ldfrag(Bop, 72, si * 16, 0, lane), am); am = mma16(a1, ldfrag(Bop, 72, si * 16, 32, lane), am);
                        const int s = si * 16 + l15;
                        float mv[4];
#pragma unroll
                        for (int r = 0; r < 4; ++r) { const int t = ti * 16 + lq * 4 + r; mv[r] = ((mat < 2) ? (s < t) : (s <= t)) ? am[r] : 0.f; }
                        u16* dst = (mat == 0) ? Nc : (mat == 1) ? Mak : (mat == 2) ? Mrb : Mrk;
#pragma unroll
                        for (int r = 0; r < 4; ++r) dst[(ti * 16 + lq * 4 + r) * 40 + s] = (u16)f2bf(mv[r]);
                        if (mat == 0) {
                            *(uint2*)(NcT + s * 40 + ti * 16 + lq * 4) = make_uint2(pk2(mv[0], mv[1]), pk2(mv[2], mv[3]));
#pragma unroll
                            for (int r = 0; r < 4; ++r) { const int t = ti * 16 + lq * 4 + r; Xc[t * 40 + s] = (u16)f2bf(mv[r] + (t == s ? 1.f : 0.f)); }
                        }
                    }
                }
            }
            lbar();
            f32x4 yv[NRT];
            {
#pragma unroll
                for (int q = 0; q < NRT; ++q) {
                    const int tt = (PASS == 1) ? q : (wave >> 2), vt = (PASS == 1) ? wave : (wave & 3);
                    const bf16x8_t s0 = ldfrag(Sb, 72, vt * 16, 0, lane), s1 = ldfrag(Sb, 72, vt * 16, 32, lane);
                    f32x4 rh = {0.f, 0.f, 0.f, 0.f};
                    rh = mma16(ldfrag(At, 72, tt * 16, 0, lane), s0, rh); rh = mma16(ldfrag(At, 72, tt * 16, 32, lane), s1, rh);
                    rh = mma16(ldfrag(Mak, 40, tt * 16, 0, lane), ldfrag(VT, 40, vt * 16, 0, lane), rh);
                    *(uint2*)(RhsT + (vt * 16 + l15) * 40 + tt * 16 + lq * 4) = make_uint2(pk2(rh[0], rh[1]), pk2(rh[2], rh[3]));
                    yv[q] = (f32x4){0.f, 0.f, 0.f, 0.f};
                    if (PASS == 3) { yv[q] = mma16(ldfrag(Rt, 72, tt * 16, 0, lane), s0, yv[q]); yv[q] = mma16(ldfrag(Rt, 72, tt * 16, 32, lane), s1, yv[q]); }
                }
            }
            if (PASS == 1) {
#pragma unroll
            for (int rnd = 0; rnd < 5; ++rnd) {
                if (wave < 4) {
                    if (rnd > 0) {
                        const int ti = wave >> 1, si = wave & 1;
                        f32x4 x;
#pragma unroll
                        for (int r = 0; r < 4; ++r) x[r] = bf2f(Xc[(ti * 16 + lq * 4 + r) * 40 + si * 16 + l15]);
                        x = mma16(ldfrag(Xc, 40, ti * 16, 0, lane), ldfrag(NcT, 40, si * 16, 0, lane), x);
#pragma unroll
                        for (int r = 0; r < 4; ++r) Xn[(ti * 16 + lq * 4 + r) * 40 + si * 16 + l15] = (u16)f2bf(x[r]);
                    }
                } else if (rnd < 4) {
                    const int ti = (wave - 4) >> 1, si = wave & 1;
                    f32x4 n2 = {0.f, 0.f, 0.f, 0.f};
                    n2 = mma16(ldfrag(Nc, 40, ti * 16, 0, lane), ldfrag(NcT, 40, si * 16, 0, lane), n2);
#pragma unroll
                    for (int r = 0; r < 4; ++r) Nn[(ti * 16 + lq * 4 + r) * 40 + si * 16 + l15] = (u16)f2bf(n2[r]);
                    *(uint2*)(NnT + (si * 16 + l15) * 40 + ti * 16 + lq * 4) = make_uint2(pk2(n2[0], n2[1]), pk2(n2[2], n2[3]));
                }
                lbar();
                if (rnd > 0) { u16* t0 = Xc; Xc = Xn; Xn = t0; }
                if (rnd < 4) { u16* t1 = Nc; Nc = Nn; Nn = t1; u16* t2 = NcT; NcT = NnT; NnT = t2; }
            }
            if (tid < 160) *(uint4*)(TIG + ((size_t)unit * 16 + chunk) * 1280 + tid * 8) = *(const uint4*)(Xc + tid * 8);
            } else lbar();
            {
#pragma unroll
                for (int q = 0; q < NRT; ++q) {
                    const int tt = (PASS == 1) ? q : (wave >> 2), vt = (PASS == 1) ? wave : (wave & 3);
                    f32x4 sa = {0.f, 0.f, 0.f, 0.f};
                    sa = mma16(ldfrag(Xc, 40, tt * 16, 0, lane), ldfrag(RhsT, 40, vt * 16, 0, lane), sa);
                    *(uint2*)(SAT + (vt * 16 + l15) * 40 + tt * 16 + lq * 4) = make_uint2(pk2(sa[0], sa[1]), pk2(sa[2], sa[3]));
                }
            }
            lbar();
            if (PASS == 3) {
                const int tt = wave >> 2, vt = wave & 3;
                yv[0] = mma16(ldfrag(Mrb, 40, tt * 16, 0, lane), ldfrag(SAT, 40, vt * 16, 0, lane), yv[0]);
                yv[0] = mma16(ldfrag(Mrk, 40, tt * 16, 0, lane), ldfrag(VT, 40, vt * 16, 0, lane), yv[0]);
#pragma unroll
                for (int r = 0; r < 4; ++r) Yb[(tt * 16 + lq * 4 + r) * 64 + vt * 16 + l15] = (u16)f2bf(yv[0][r]);
            }
            {
                const bf16x8_t sa = ldfrag(SAT, 40, svt * 16, 0, lane), va = ldfrag(VT, 40, svt * 16, 0, lane);
#pragma unroll
                for (int q = 0; q < NST; ++q) {
                    const int kt = kt0 + q;
                    const float dk = __expf(Ltot[kt * 16 + l15]);
#pragma unroll
                    for (int r = 0; r < 4; ++r) S[q][r] *= dk;
                    S[q] = mma16(sa, ldfrag(BhT, 40, kt * 16, 0, lane), S[q]);
                    S[q] = mma16(va, ldfrag(KhT, 40, kt * 16, 0, lane), S[q]);
#pragma unroll
                    for (int r = 0; r < 4; ++r) Sb[(svt * 16 + lq * 4 + r) * 72 + kt * 16 + l15] = (u16)f2bf(S[q][r]);
                }
            }
            if (PASS == 3) {
                lbar();
                const uint2 ov = *(const uint2*)(Yb + et * 64 + ech);
                *(uint2*)(YO + (size_t)TIME_ROW(seg, chunk * 32 + et, dir, b) * 512 + hd * 64 + ech) = ov;
            }
        }
#undef RWM_LOAD
        if (PASS == 1) {
#pragma unroll
            for (int q = 0; q < NST; ++q)
#pragma unroll
                for (int r = 0; r < 4; ++r) {
                    const int v = svt * 16 + lq * 4 + r, k = (kt0 + q) * 16 + l15;
                    if (v < 64) LCs[(size_t)unit * 4096 + v * 64 + k] = S[q][r]; else PM[(size_t)unit * 4096 + (v - 64) * 64 + k] = S[q][r];
                }
        }
    }
    lbar();
}

__device__ __forceinline__ void s5_lambar(const Params& p, int j, int dir, int g, int lane, float& lr, float& li, float& are, float& aim) {
    are = INP(p, I_SARE)[(j * 32 + g) * 64 + lane]; aim = INP(p, I_SAIM)[(j * 32 + g) * 64 + lane];
    const float dl = __expf(INP(p, I_SLS)[(j * 2 + dir) * 32 + g]);
    const float mag = __expf(are * dl), ang = aim * dl;
    const float n = rintf(ang * 0.15915494309189535f);
    float r = fmaf(-n, 6.28318548202514648f, ang); r = fmaf(n, 1.74845553e-07f, r);
    lr = mag * __cosf(r); li = mag * __sinf(r);
}

__device__ __forceinline__ void s5_weights(const Params& p, int j, unsigned char* lds) {
    const int tid = otid();
    float* pw = (float*)lds;
    float* cf = pw + 2 * 17 * 64 * 2;
    float* bb = cf + 2 * 16 * 64 * 2;
    float* Kt = bb + 2 * 64 * 16 * 2;
    u16* Bt1 = (u16*)(WSP(p) + OD_BT1); u16* Bt0 = (u16*)(WSP(p) + OD_BT0);
    for (int item = obid(); item < 256; item += gridDim.x) {
        const int g = item >> 3, slice = item & 7;
        __syncthreads();
        if (tid < 128) {
            const int dir = tid >> 6, pp = tid & 63;
            float lr, li, are, aim; s5_lambar(p, j, dir, g, pp, lr, li, are, aim);
            float xr = 1.f, xi = 0.f;
#pragma nounroll
            for (int d = 0; d <= 16; ++d) { pw[((dir * 17 + d) * 64 + pp) * 2] = xr; pw[((dir * 17 + d) * 64 + pp) * 2 + 1] = xi; const float nr = xr * lr - xi * li, ni = xr * li + xi * lr; xr = nr; xi = ni; }
            const float den = are * are + aim * aim, nr = lr - 1.f;
            const float cr = (nr * are + li * aim) / den, ci = (li * are - nr * aim) / den;
            const float* br = INP(p, I_SBRE) + ((size_t)(j * 32 + g) * 64 + pp) * 16; const float* bi = INP(p, I_SBIM) + ((size_t)(j * 32 + g) * 64 + pp) * 16;
#pragma unroll 4
            for (int q = 0; q < 16; ++q) { bb[((dir * 64 + pp) * 16 + q) * 2] = cr * br[q] - ci * bi[q]; bb[((dir * 64 + pp) * 16 + q) * 2 + 1] = cr * bi[q] + ci * br[q]; }
        }
        for (int e = tid; e < 2048; e += 512) {
            const int dir = e >> 10, i = (e >> 6) & 15, pp = e & 63;
            const size_t so = ((size_t)((j * 2 + dir) * 32 + g) * 16 + i) * 64 + pp;
            cf[e * 2] = INP(p, I_SCRE)[so]; cf[e * 2 + 1] = INP(p, I_SCIM)[so];
        }
        __syncthreads();
        {
            const int dir = tid >> 8, d = (tid >> 4) & 15, i = tid & 15;
            float acc[16];
#pragma unroll
            for (int q = 0; q < 16; ++q) acc[q] = 0.f;
#pragma unroll 2
            for (int pp = 0; pp < 64; ++pp) {
                const float2 cc = *(const float2*)(cf + ((dir * 16 + i) * 64 + pp) * 2), ww = *(const float2*)(pw + ((dir * 17 + d) * 64 + pp) * 2);
                const float zr = cc.x * ww.x - cc.y * ww.y, zi = cc.x * ww.y + cc.y * ww.x;
                const float* bp = bb + (dir * 64 + pp) * 32;
#pragma unroll
                for (int q = 0; q < 8; ++q) { const float4 b4 = *(const float4*)(bp + q * 4); acc[q * 2] = fmaf(zr, b4.x, fmaf(-zi, b4.y, acc[q * 2])); acc[q * 2 + 1] = fmaf(zr, b4.z, fmaf(-zi, b4.w, acc[q * 2 + 1])); }
            }
#pragma unroll
            for (int q = 0; q < 4; ++q) *(float4*)(Kt + tid * 16 + q * 4) = make_float4(acc[q * 4], acc[q * 4 + 1], acc[q * 4 + 2], acc[q * 4 + 3]);
        }
        __syncthreads();
        {
            const int n = slice * 32 + (tid >> 4), tl = n >> 4, i = n & 15, k0 = (tid & 15) * 32;
            const float dsk = INP(p, I_SD)[j * 512 + g * 16 + i];
#pragma nounroll
            for (int q = 0; q < 4; ++q) {
                float o[8];
#pragma unroll
                for (int e = 0; e < 8; ++e) {
                    const int k = k0 + q * 8 + e; float val;
                    if (k < 256) {
                        const int sl = k >> 4, jj = k & 15;
                        val = 0.f;
                        if (sl <= tl) val += Kt[((0 * 16 + (tl - sl)) * 16 + i) * 16 + jj];
                        if (sl >= tl) val += Kt[((1 * 16 + (sl - tl)) * 16 + i) * 16 + jj];
                        if (sl == tl && i == jj) val += dsk;
                    } else {
                        const int dir = (k >= 384) ? 1 : 0, kk = k - 256 - dir * 128, pp = kk >> 1, im = kk & 1, d = dir ? (16 - tl) : (tl + 1);
                        const float c_r = cf[((dir * 16 + i) * 64 + pp) * 2], c_i = cf[((dir * 16 + i) * 64 + pp) * 2 + 1];
                        const float w_r = pw[((dir * 17 + d) * 64 + pp) * 2], w_i = pw[((dir * 17 + d) * 64 + pp) * 2 + 1];
                        val = im ? -(c_r * w_i + c_i * w_r) : (c_r * w_r - c_i * w_i);
                    }
                    o[e] = val;
                }
                *(uint4*)(Bt1 + ((size_t)g * 256 + n) * 512 + k0 + q * 8) = PACK8_BF(o);
            }
        }
        {
            const int n = slice * 32 + (tid >> 4), dir = n >> 7, nn = n & 127, pp = nn >> 1, im = nn & 1, k0 = (tid & 15) * 16;
#pragma nounroll
            for (int q = 0; q < 2; ++q) {
                float o[8];
#pragma unroll
                for (int e = 0; e < 8; ++e) {
                    const int k = k0 + q * 8 + e, sl = k >> 4, jj = k & 15, d = dir ? sl : (15 - sl);
                    const float w_r = pw[((dir * 17 + d) * 64 + pp) * 2], w_i = pw[((dir * 17 + d) * 64 + pp) * 2 + 1];
                    const float b_r = bb[((dir * 64 + pp) * 16 + jj) * 2], b_i = bb[((dir * 64 + pp) * 16 + jj) * 2 + 1];
                    o[e] = im ? (w_r * b_i + w_i * b_r) : (w_r * b_r - w_i * b_i);
                }
                *(uint4*)(Bt0 + ((size_t)g * 256 + n) * 256 + k0 + q * 8) = PACK8_BF(o);
            }
        }
    }
    __syncthreads();
}

struct S5Order {
    int G, c;
    __device__ __forceinline__ bool next(int i, pg8::Unit& u) const { const int L = i * G + c; if (L >= 128) return false; u.pm = L; u.pn = L >> 2; return true; }
    __device__ __forceinline__ void a_ready(const pg8::Unit&) const {}
    __device__ __forceinline__ void done(const pg8::Unit&) const {}
};
struct EpiXloc {
    static constexpr bool PERM = true, AFTER_DRAIN = false;
    float* X;
    __device__ __forceinline__ void operator()(const f32x4 (&acc)[2][2][4][2], const pg8::Unit& u, int wr, int wc, int fr, int fq) const {
        asm volatile("" : "+v"(fr), "+v"(fq));
        const int row0 = u.pm * 256 + wr * 64 + fr, col0 = wc * 32 + 8 * fq;
#pragma unroll
        for (int ai = 0; ai < 2; ++ai)
#pragma unroll
            for (int m = 0; m < 4; ++m)
#pragma unroll
                for (int bj = 0; bj < 2; ++bj) {
                    float* d = X + (size_t)(row0 + ai * 128 + m * 16) * 256 + col0 + bj * 128;
                    const f32x4 v0 = acc[ai][bj][m][0], v1 = acc[ai][bj][m][1];
                    *(float4*)d = make_float4(v0[0], v0[1], v0[2], v0[3]); *(float4*)(d + 4) = make_float4(v1[0], v1[1], v1[2], v1[3]);
                }
    }
};
struct EpiS5Out {
    static constexpr bool PERM = true, AFTER_DRAIN = false;
    u16* YG;
    __device__ __forceinline__ void operator()(const f32x4 (&acc)[2][2][4][2], const pg8::Unit& u, int wr, int wc, int fr, int fq) const {
        asm volatile("" : "+v"(fr), "+v"(fq));
        const int row0 = u.pm * 256 + wr * 64 + fr, col0 = wc * 32 + 8 * fq;
#pragma unroll
        for (int ai = 0; ai < 2; ++ai)
#pragma unroll
            for (int m = 0; m < 4; ++m) {
                const int row = row0 + ai * 128 + m * 16, g = row >> 10, rig = row & 1023, b = rig >> 9, cc = rig & 511;
#pragma unroll
                for (int bj = 0; bj < 2; ++bj) {
                    const int col = col0 + bj * 128, tl = col >> 4, i0 = col & 15;
                    float o[8];
#pragma unroll
                    for (int n = 0; n < 2; ++n)
#pragma unroll
                        for (int e = 0; e < 4; ++e) { const float x = acc[ai][bj][m][n][e]; o[n * 4 + e] = 0.5f * x * (1.f + tanhf_(0.7978845608028654f * (x + 0.044715f * x * x * x))); }
                    *(uint4*)(YG + ((size_t)b * SEQ + cc * 16 + tl) * 512 + g * 16 + i0) = PACK8_BF(o);
                }
            }
    }
};

__device__ __forceinline__ void s5_chunk_scan(const Params& p, int j, unsigned char* lds) {
    const int tid = otid(), blk = tid >> 5;
    float* ends = (float*)lds;
    const float* X = (const float*)(WSP(p) + OD_XLOC); u16* A1 = (u16*)(WSP(p) + OD_A1);
    for (int item = obid(); item < 256; item += gridDim.x) {
        const int pp = (tid & 31) + 32 * (item & 1), dir = (item >> 1) & 1, b = (item >> 2) & 1, g = item >> 3;
        float lr, li, are, aim; s5_lambar(p, j, dir, g, pp, lr, li, are, aim);
#pragma unroll
        for (int q = 0; q < 4; ++q) { const float nr = lr * lr - li * li, ni = 2.f * lr * li; lr = nr; li = ni; }
        float Lr = lr, Li = li;
#pragma unroll
        for (int q = 0; q < 5; ++q) { const float nr = Lr * Lr - Li * Li, ni = 2.f * Lr * Li; Lr = nr; Li = ni; }
        const size_t row0 = (size_t)g * 1024 + b * 512;
        const int xc = dir * 128 + 2 * pp;
        float xr = 0.f, xi = 0.f;
#pragma nounroll
        for (int cb = 0; cb < 32; cb += 8) {
            float2 v[8];
#pragma unroll
            for (int q = 0; q < 8; ++q) { const int c = dir ? (blk * 32 + 31 - cb - q) : (blk * 32 + cb + q); v[q] = *(const float2*)(X + (row0 + c) * 256 + xc); }
#pragma unroll
            for (int q = 0; q < 8; ++q) { const float nr = fmaf(lr, xr, fmaf(-li, xi, v[q].x)), ni = fmaf(lr, xi, fmaf(li, xr, v[q].y)); xr = nr; xi = ni; }
        }
        __syncthreads();
        ends[(blk * 64 + pp) * 2] = xr; ends[(blk * 64 + pp) * 2 + 1] = xi;
        __syncthreads();
        xr = 0.f; xi = 0.f;
        if (dir == 0) { for (int q = 0; q < blk; ++q) { const float er = ends[(q * 64 + pp) * 2], ei = ends[(q * 64 + pp) * 2 + 1]; const float nr = fmaf(Lr, xr, fmaf(-Li, xi, er)), ni = fmaf(Lr, xi, fmaf(Li, xr, ei)); xr = nr; xi = ni; } }
        else { for (int q = 15; q > blk; --q) { const float er = ends[(q * 64 + pp) * 2], ei = ends[(q * 64 + pp) * 2 + 1]; const float nr = fmaf(Lr, xr, fmaf(-Li, xi, er)), ni = fmaf(Lr, xi, fmaf(Li, xr, ei)); xr = nr; xi = ni; } }
#pragma nounroll
        for (int cb = 0; cb < 32; cb += 8) {
            float2 v[8];
#pragma unroll
            for (int q = 0; q < 8; ++q) { const int c = dir ? (blk * 32 + 31 - cb - q) : (blk * 32 + cb + q); v[q] = *(const float2*)(X + (row0 + c) * 256 + xc); }
#pragma unroll
            for (int q = 0; q < 8; ++q) {
                const int c = dir ? (blk * 32 + 31 - cb - q) : (blk * 32 + cb + q);
                *(unsigned*)(A1 + (row0 + c) * 512 + 256 + xc) = pk2(xr, xi);
                const float nr = fmaf(lr, xr, fmaf(-li, xi, v[q].x)), ni = fmaf(lr, xi, fmaf(li, xr, v[q].y)); xr = nr; xi = ni;
            }
        }
    }
    __syncthreads();
}

__device__ __forceinline__ void odd_carry(const Params& p, int j, unsigned char* lds) {
    const int tid = otid();
    float* Lpm = (float*)lds;
    float* Lcur = Lpm + 4096;
    float* LCs = (float*)(WSP(p) + OD_CLC); const float* PM = (const float*)(WSP(p) + OD_CPM);
    int cstart = obid() - 128; if (cstart < 0) cstart += gridDim.x;
    for (int item = cstart; item < 128; item += gridDim.x) {
        const int seq = item >> 2, lr = tid >> 5, row = (item & 3) * 16 + lr, c0 = (tid & 31) * 2;
        float cu0 = 0.f, cu1 = 0.f;
        float4 pa = *(const float4*)(PM + (size_t)(seq * 16) * 4096 + tid * 8), pb = *(const float4*)(PM + (size_t)(seq * 16) * 4096 + tid * 8 + 4);
        for (int s = 0; s < NSEG; ++s) {
            const int unit = seq * 16 + s;
            __syncthreads();
            *(float4*)(Lpm + tid * 8) = pa; *(float4*)(Lpm + tid * 8 + 4) = pb;
            Lcur[lr * 65 + c0] = cu0; Lcur[lr * 65 + c0 + 1] = cu1;
            float* lp = LCs + (size_t)unit * 4096 + row * 64 + c0;
            const float2 tmp = *(const float2*)lp;
            *(float2*)lp = make_float2(cu0, cu1);
            __syncthreads();
            if (s + 1 < NSEG) { pa = *(const float4*)(PM + (size_t)(unit + 1) * 4096 + tid * 8); pb = *(const float4*)(PM + (size_t)(unit + 1) * 4096 + tid * 8 + 4); }
            float a0 = 0.f, a1 = 0.f;
#pragma unroll 8
            for (int i = 0; i < 64; ++i) { const float a = Lcur[lr * 65 + i]; const float2 pm = *(const float2*)(Lpm + i * 64 + c0); a0 = fmaf(a, pm.x, a0); a1 = fmaf(a, pm.y, a1); }
            cu0 = a0 + tmp.x; cu1 = a1 + tmp.y;
        }
    }
    __syncthreads();
}

__device__ __forceinline__ void odd_post(const Params& p, int j) {
    const int lane = otid() & 63, gw = obid() * 8 + (otid() >> 6), nw = gridDim.x * 8;
    const u16* CYF = (const u16*)(WSP(p) + OD_CYF); const u16* CYB = (const u16*)(WSP(p) + OD_CYB);
    const u16* R = (const u16*)(WSP(p) + OD_R); const u16* V = (const u16*)(WSP(p) + OD_V); const u16* G = (const u16*)(WSP(p) + OD_G);
    const u16* AF = (const u16*)(WSP(p) + OD_AF); const u16* AB = (const u16*)(WSP(p) + OD_AB); const u16* KPa = (const u16*)(WSP(p) + OD_KP);
    u16* O = (u16*)(WSP(p) + WS_XA);
    const int c = lane * 8;
    float lnw[8], lnb[8], rk[8], kav[8];
#pragma unroll
    for (int i = 0; i < 8; ++i) { lnw[i] = INP(p, I_LNW)[j * 512 + c + i]; lnb[i] = INP(p, I_LNB)[j * 512 + c + i]; rk[i] = INP(p, I_RK)[j * 512 + c + i]; kav[i] = INP(p, I_KA)[j * 512 + c + i]; }
    for (int rowb = gw * 2; rowb < T_TOK; rowb += nw * 2) {
        uint4 q[2][8];
#pragma unroll
        for (int r = 0; r < 2; ++r) {
            const size_t o = (size_t)(rowb + r) * 512 + c;
            q[r][0] = *(const uint4*)(CYF + o); q[r][1] = *(const uint4*)(CYB + o); q[r][2] = *(const uint4*)(AF + o); q[r][3] = *(const uint4*)(AB + o);
            q[r][4] = *(const uint4*)(R + o); q[r][5] = *(const uint4*)(KPa + o); q[r][6] = *(const uint4*)(V + o); q[r][7] = *(const uint4*)(G + o);
        }
#pragma unroll
        for (int r = 0; r < 2; ++r) {
            const size_t row = rowb + r;
            float y[8], t[8], t2[8], out[8];
            UNPACK8_BF(q[r][0], y); UNPACK8_BF(q[r][1], t);
            float sm = 0.f;
#pragma unroll
            for (int i = 0; i < 8; ++i) { y[i] += t[i]; sm += y[i]; }
            const float mean = red8(sm) * (1.f / 64.f);
            float sv = 0.f;
#pragma unroll
            for (int i = 0; i < 8; ++i) { y[i] -= mean; sv += y[i] * y[i]; }
            const float rstd = rsqrtf(red8(sv) * (1.f / 64.f) + 64e-5f);
            UNPACK8_BF(q[r][2], t); UNPACK8_BF(q[r][3], t2);
            float rr[8], kp8[8]; UNPACK8_BF(q[r][4], rr); UNPACK8_BF(q[r][5], kp8);
            float bs = 0.f;
#pragma unroll
            for (int i = 0; i < 8; ++i) bs = fmaf(rr[i] * kp8[i] * (2.f + (t[i] + t2[i] - 2.f) * kav[i]), rk[i], bs);
            bs = red8(bs);
            UNPACK8_BF(q[r][6], t); UNPACK8_BF(q[r][7], t2);
#pragma unroll
            for (int i = 0; i < 8; ++i) out[i] = (fmaf(y[i] * rstd, lnw[i], lnb[i]) + bs * t[i]) * t2[i];
            *(uint4*)(O + row * DM + c) = PACK8_BF(out);
        }
    }
}

template <class Epi, bool ALIGN = true>
__device__ __forceinline__ void run_gemm(unsigned char* lds, const u16* A, const u16* Bt, int N, int K, const Epi& E) {
    int Kr = K; asm volatile("" : "+s"(Kr));
    pg8::Gemm g{A, Bt, T_TOK, N, Kr, Kr, Kr}; pg8::StaticOrder S; S.init(T_TOK, N, (int)gridDim.x, obid());
    pg8::gemm_phase<Epi, pg8::StaticOrder, ALIGN, true>((PG8_LAS unsigned char*)lds, g, S, E);
}

__device__ __forceinline__ void convert_mixer(const Params& p, int lyr, unsigned char* lds, int& item, int lgsz, int lbid) {
    const int jj = lyr >> 1; const bool ev = (lyr & 1) == 0; unsigned char* ws = WSP(p);
    if (ev) convert_weight(INP(p, I_EVIN) + (size_t)jj * DM * 4112, DM, 4112, 4112, 0, (u16*)(ws + WS_WIN), EV_N, lds, item, lgsz);
    else { convert_weight(INP(p, I_ODIN) + (size_t)jj * DM * 2272, DM, 2272, 2048, 2, (u16*)(ws + WS_WIN), 2048, lds, item, lgsz);
           convert_weight(INP(p, I_ODIN) + (size_t)jj * DM * 2272, DM, 2272, 224, 3, (u16*)(ws + WS_WIN + 5 * MiB), 256, lds, item, lgsz); }
    convert_weight((ev ? INP(p, I_EVOUT) : INP(p, I_ODOUT)) + (size_t)jj * DM * DM, DM, DM, DM, 0, (u16*)(ws + WS_WOUT), DM, lds, item, lgsz);
    if (!ev) { convert_weight(INP(p, I_GLUW) + (size_t)jj * 512 * 512, 512, 512, 512, 0, (u16*)(ws + WS_WGLU), 512, lds, item, lgsz); build_lora_weight(p, jj, lbid, lgsz); }
}

__device__ __forceinline__ void run_phase(const Params& p, int layer, int ph, unsigned char* lds, const XcdBarrier& xbar) {
    const int j = layer >> 1; const bool even = (layer & 1) == 0;
    unsigned char* ws = WSP(p);
    u16* XA = (u16*)(ws + WS_XA);
    const float* hin = (layer == 0) ? INP(p, I_X) : OUTP(p);
    switch (ph) {
    case 0: if (PH_MASK & 1) {
        int item = obid(); const int gsz = gridDim.x;
        if (layer == 0 || gsz != 256) convert_mixer(p, layer, lds, item, gsz, obid());
        if (even || gsz != 256) {
        convert_weight(INP(p, I_FFI) + (size_t)layer * DM * 2 * DFF, DM, 2 * DFF, 2 * DFF, 1, (u16*)(ws + WS_WFI), 2 * DFF, lds, item, gsz);
        convert_weight(INP(p, I_FFO) + (size_t)layer * DFF * DM, DFF, DM, DM, 0, (u16*)(ws + WS_WFO), DM, lds, item, gsz);
        }
        norm_rows_bf16(hin, INP(p, I_NMIX) + (size_t)layer * DM, XA);
    } break;
    case 1: if (PH_MASK & 2) {
        if (even) { EpiEven E{(u16*)(ws + WS_P), (float*)(ws + EV_DT), INP(p, I_HGLB), INP(p, I_M2DTB) + j * 16, j}; run_gemm(lds, XA, (const u16*)(ws + WS_WIN), 4096, DM, E); }
        else { EpiPlain E{(u16*)(ws + WS_P), OD_N, 0, 6, 224, 1 << 30}; run_gemm(lds, XA, (const u16*)(ws + WS_WIN), 2048, DM, E);
               EpiPlain E2{(u16*)(ws + WS_P), OD_N, 1536, 1 << 30, 0, 224}; run_gemm(lds, XA, (const u16*)(ws + WS_WIN + 5 * MiB), 256, DM, E2); }
    } break;
    case 2: if (!(PH_MASK & 4)) break; if (even) { even_conv(p, j); even_dt(p, j, lds); } else { odd_shift(p, j); xcd_barrier(xbar);
            EpiLora E{ws, INP(p, I_W0) + j * 1024, INP(p, I_A0) + j * 1024}; run_gemm<EpiLora, false>(lds, (const u16*)(ws + OD_XL), (const u16*)(ws + OD_BTL), 2560, 256, E); } break;
    case 3: if (!(PH_MASK & 8)) break; if (even) { hg_mma<1>(p, lds); m2_mma<1>(p, j, lds); } else { rw_mma<1>(p, j, lds); s5_weights(p, j, lds); } break;
    case 4: if (!(PH_MASK & 16)) break; if (even) even_carry(p); else {
            int Kr = 256; asm volatile("" : "+s"(Kr)); pg8::Gemm g{(const u16*)(ws + OD_A1), (const u16*)(ws + OD_BT0), 32768, 256, Kr, 512, 256}; S5Order S{(int)gridDim.x, obid()}; EpiXloc E{(float*)(ws + OD_XLOC)};
            pg8::gemm_phase<EpiXloc, S5Order, false, true>((PG8_LAS unsigned char*)lds, g, S, E); odd_carry(p, j, lds); } break;
    case 5: if (!(PH_MASK & 32)) break; if (even) { hg_mma<3>(p, lds); m2_mma<3>(p, j, lds); } else { rw_mma<3>(p, j, lds); s5_chunk_scan(p, j, lds); } break;
    case 6: if (!(PH_MASK & 64)) break; if (even) even_post(p, j); else { odd_post(p, j); __syncthreads();
            pg8::Gemm g{(const u16*)(ws + OD_A1), (const u16*)(ws + OD_BT1), 32768, 256, 512, 512, 512}; S5Order S{(int)gridDim.x, obid()}; EpiS5Out E{(u16*)(ws + OD_YG)};
            pg8::gemm_phase<EpiS5Out, S5Order, false, true>((PG8_LAS unsigned char*)lds, g, S, E); } break;
    case 7: if ((PH_MASK & 128) && !even) { EpiGlu E{(const u16*)(ws + OD_YG), INP(p, I_GLUB) + j * 512, XA}; run_gemm(lds, (const u16*)(ws + OD_YG), (const u16*)(ws + WS_WGLU), 512, 512, E);
        if (gridDim.x == 256 && obid() >= 128) {
            int item = obid() - 128;
            convert_weight(INP(p, I_FFI) + (size_t)layer * DM * 2 * DFF, DM, 2 * DFF, 2 * DFF, 1, (u16*)(ws + WS_WFI), 2 * DFF, lds, item, 128);
            convert_weight(INP(p, I_FFO) + (size_t)layer * DFF * DM, DFF, DM, DM, 0, (u16*)(ws + WS_WFO), DM, lds, item, 128);
        } } break;
    case 8: if (PH_MASK & 256) { EpiResid E{hin, OUTP(p)}; run_gemm(lds, XA, (const u16*)(ws + WS_WOUT), DM, DM, E); } break;
    case 9: if (PH_MASK & 512) norm_rows_bf16(OUTP(p), INP(p, I_NFFN) + (size_t)layer * DM, XA); break;
    case 10: if (PH_MASK & 1024) { EpiFfn E{(u16*)(ws + WS_ACT)}; run_gemm(lds, XA, (const u16*)(ws + WS_WFI), 2 * DFF, DM, E);
        if (layer < 3 && gridDim.x == 256 && obid() >= 128) { int item = obid() - 128; convert_mixer(p, layer + 1, lds, item, 128, obid() - 128); } } break;
    case 11: if (PH_MASK & 2048) { EpiResid E{OUTP(p), OUTP(p)}; run_gemm(lds, (const u16*)(ws + WS_ACT), (const u16*)(ws + WS_WFO), DM, DFF, E); } break;
    default: break;
    }
}

__global__ void __launch_bounds__(512, 2) fwd_kernel(Params p) {
    extern __shared__ __attribute__((aligned(16))) unsigned char lds[];
    volatile LAS unsigned* xst = (volatile LAS unsigned*)(lds + LDS_BYTES - 64);
    if (otid() < 2) xst[otid()] = 0u;
    __syncthreads();
    const XcdBarrier xbar = xcd_barrier_post((unsigned*)(p.ws + WS_BAR), xst);
#ifdef REP_LO
    int rep = 0;
#endif
    for (int gp = p.lo; gp < p.hi; ++gp) {
        const int layer = gp / 12, ph = gp % 12;
        if (gp == 48) { norm_rows_f32_inplace(OUTP(p), INP(p, I_NFIN)); break; }
        if (ph == 7 && (layer & 1) == 0) continue;
        run_phase(p, layer, ph, lds, xbar);
        if (gp + 1 < p.hi) xcd_barrier(xbar);
#ifdef REP_LO
        if (ph == REP_HI) { if (rep == 0) { rep = 1; gp -= (REP_HI - REP_LO + 1); } else rep = 0; }
#endif
    }
}

extern "C" void kernel_launch(void* const* d_in, const int* in_sizes, int n_in, void* d_out, int out_size, void* d_ws, size_t ws_size, hipStream_t stream) {
    static int grid = 0;
    if (grid == 0) {
        if (n_in != 39 || out_size != T_TOK * DM || ws_size < WS_NEED) { fprintf(stderr, "kernel_launch: unexpected problem (n_in %d out %d ws %zu)\n", n_in, out_size, ws_size); grid = -1; return; }
        int dev = 0, cus = 0, per_cu = 0;
        hipGetDevice(&dev); hipDeviceGetAttribute(&cus, hipDeviceAttributeMultiprocessorCount, dev);
        if (hipFuncSetAttribute((const void*)fwd_kernel, hipFuncAttributeMaxDynamicSharedMemorySize, LDS_BYTES) != hipSuccess) { fprintf(stderr, "kernel_launch: hipFuncSetAttribute failed\n"); grid = -1; return; }
        if (hipOccupancyMaxActiveBlocksPerMultiprocessor(&per_cu, (const void*)fwd_kernel, 512, LDS_BYTES) != hipSuccess || per_cu < 1) { fprintf(stderr, "kernel_launch: occupancy query gave %d\n", per_cu); per_cu = 1; }
        (void)hipGetLastError();
        grid = cus * 1;
        fprintf(stderr, "kernel_launch: grid %d (cus %d, per_cu %d)\n", grid, cus, per_cu);
    }
    if (grid < 0) return;
    if (hipMemsetAsync((unsigned char*)d_ws + WS_BAR, 0, XCD_BAR_WORDS * 4, stream) != hipSuccess) { fprintf(stderr, "kernel_launch: memset failed\n"); return; }
    Params p{};
    for (int i = 0; i < 39; ++i) p.in[i] = (const float*)d_in[i];
    p.out = (float*)d_out; p.ws = (unsigned char*)d_ws;
#if ONE_LAUNCH
    p.lo = 0; p.hi = 49;
    void* args[] = {&p};
    hipError_t e = hipLaunchCooperativeKernel((const void*)fwd_kernel, dim3(grid), dim3(512), args, LDS_BYTES, stream);
    if (e != hipSuccess) fprintf(stderr, "cooperative launch failed: %s (grid %d)\n", hipGetErrorString(e), grid);
#else
    for (int gp = 0; gp < 49; ++gp) {
        if (gp != 48 && (gp % 12) == 7 && ((gp / 12) & 1) == 0) continue;
        p.lo = gp; p.hi = gp + 1;
        hipLaunchKernelGGL(fwd_kernel, dim3(grid), dim3(512), LDS_BYTES, stream, p);
    }
#endif
}
```

```cpp
#include <hip/hip_runtime.h>
#include <hip/hip_cooperative_groups.h>
#include <cstdio>
#include <cstdint>
namespace cg = cooperative_groups;
#ifndef ONE_LAUNCH
#define ONE_LAUNCH 1
#endif
__device__ __forceinline__ int otid() { int t = threadIdx.x; asm volatile("" : "+v"(t)); return t; }
__device__ __forceinline__ int obid() { int b = blockIdx.x; asm volatile("" : "+s"(b)); return b; }
namespace pg8 {
#define PG8_LAS __attribute__((address_space(3)))
typedef unsigned short bf16_t;
typedef short bf16x8 __attribute__((ext_vector_type(8)));
typedef float f32x4 __attribute__((ext_vector_type(4)));
typedef unsigned u32x4 __attribute__((ext_vector_type(4)));
constexpr int BM = 256, BK = 64, HALF = 128, HTB = HALF * BK * 2  , STAGE_BYTES = 8 * HTB, NXCD = 8, WGM = 8;

__host__ __device__ __forceinline__ int lds_byte(int r, int c) { const int st = (r >> 4) * 2 + (c >> 5), rr = r & 15, cc = c & 31, ob = rr * 64 + cc * 2; return st * 1024 + (ob ^ (((ob >> 9) & 1) << 5)); }
__host__ __device__ __forceinline__ void stage_rc(int b, int& R, int& C) { const int st = b / 1024, sb = b % 1024, swz = sb ^ (((sb >> 9) & 1) << 5); R = (st >> 1) * 16 + swz / 64; C = (st & 1) * 32 + (swz % 64) / 2; }
__host__ __device__ __forceinline__ int perm32(int rho) { const int n = rho >> 4, i = rho & 15; return 8 * (i >> 2) + 4 * n + (i & 3); }

struct Unit { int pm, pn; };
struct Gemm { const bf16_t* A; const bf16_t* Bt; int M, N, K, lda, ldb; };

struct StaticOrder {
    int nM, nN, nwg, G, c;
    __host__ __device__ void init(int M, int N, int G_, int c_) { nM = M / BM; nN = N / BM; nwg = nM * nN; G = G_; c = c_; }
    __host__ __device__ bool next(int i, Unit& u) const {
        const long L = (long)i * G + c; if (L >= nwg) return false;
        int wgid = (int)L; { const int q = nwg / NXCD, r = nwg % NXCD, xcd = wgid % NXCD, off = wgid / NXCD; wgid = (xcd < r ? xcd * (q + 1) : r * (q + 1) + (xcd - r) * q) + off; }
        const int nig = WGM * nN, gid = wgid / nig, fm = gid * WGM, gsz = (nM - fm) < WGM ? (nM - fm) : WGM;
        u.pm = fm + ((wgid % nig) % gsz); u.pn = (wgid % nig) / gsz; return true;
    }
    __device__ __forceinline__ void a_ready(const Unit&) const {}
    __device__ __forceinline__ void done(const Unit&) const {}
};
template <class Epi, class Sched, bool ALIGN_EPI = false, bool SP2 = false>
__device__ __forceinline__ void gemm_phase(PG8_LAS unsigned char* lds, const Gemm g, const Sched& S, const Epi& E) {
    const int tid = otid(), wid = __builtin_amdgcn_readfirstlane(tid >> 6), lane = tid & 63, wr = wid >> 2, wc = wid & 3, fr = lane & 15, fq = lane >> 4;
    const int K = g.K, nt = K / BK;
    unsigned voffA[2], voffB[2];
#pragma unroll
    for (int i = 0; i < 2; ++i) { int R, C; stage_rc(tid * 16 + i * 8192, R, C); const int Rb = Epi::PERM ? ((R & ~31) + perm32(R & 31)) : R;
        voffA[i] = (unsigned)(R * g.lda + C) * 2u; voffB[i] = (unsigned)(Rb * g.ldb + C) * 2u; }
    const size_t kstep = (size_t)(BK * 2);
    const size_t hstepA = (size_t)HALF * g.lda * 2, hstepB = (size_t)HALF * g.ldb * 2;
    const size_t tstepA = 2 * hstepA, tstepB = 2 * hstepB;
    const unsigned ldsw = (unsigned)wid * 1024u;
    const int aoff = lds_byte(wr * 64 + fr, fq * 8), boff = lds_byte(wc * 32 + fr, fq * 8);
#define PG8_SA(b, h) (((b) * 2 + (h)) * HTB)
#define PG8_SB(b, h) ((4 + (b) * 2 + (h)) * HTB)
#define PG8_STAGE(bufoff, gbase, voff) do { _Pragma("unroll") for (int _i = 0; _i < 2; ++_i) \
        __builtin_amdgcn_global_load_lds((const unsigned*)((const char*)(gbase) + (voff)[_i]), (PG8_LAS unsigned*)(lds + (bufoff) + ldsw + _i * 8192), 16, 0, 0); } while (0)
#define PG8_LDA(dst, b, h) do { _Pragma("unroll") for (int m = 0; m < 4; ++m) _Pragma("unroll") for (int k = 0; k < 2; ++k) dst[m][k] = *(const PG8_LAS bf16x8*)(lds + PG8_SA(b, h) + aoff + m * 2048 + k * 1024); } while (0)
#define PG8_LDB(dst, b, h) do { _Pragma("unroll") for (int n = 0; n < 2; ++n) _Pragma("unroll") for (int k = 0; k < 2; ++k) dst[n][k] = *(const PG8_LAS bf16x8*)(lds + PG8_SB(b, h) + boff + n * 2048 + k * 1024); } while (0)
#define PG8_MMA(ai, bj, At, Bt) do { __builtin_amdgcn_s_setprio(1); _Pragma("unroll") for (int m = 0; m < 4; ++m) _Pragma("unroll") for (int n = 0; n < 2; ++n) _Pragma("unroll") for (int k = 0; k < 2; ++k) \
        acc[ai][bj][m][n] = __builtin_amdgcn_mfma_f32_16x16x32_bf16(Bt[n][k], At[m][k], acc[ai][bj][m][n], 0, 0, 0); __builtin_amdgcn_s_setprio(0); } while (0)
#define PG8_WAIT_V(n) asm volatile("s_waitcnt vmcnt(" #n ")" ::: "memory")
#define PG8_WAIT_L(n) asm volatile("s_waitcnt lgkmcnt(" #n ")" ::: "memory")
#define PG8_BAR __builtin_amdgcn_s_barrier()
#define PG8_SCHED __builtin_amdgcn_sched_barrier(0)
    Unit cur, nxt; int ui = 0;
    if (!S.next(0, cur)) return;
    f32x4 acc[2][2][4][2];
#pragma unroll
    for (int a = 0; a < 2; ++a)
#pragma unroll
        for (int b = 0; b < 2; ++b)
#pragma unroll
            for (int m = 0; m < 4; ++m)
#pragma unroll
                for (int n = 0; n < 2; ++n) acc[a][b][m][n] = (f32x4){0.f, 0.f, 0.f, 0.f};
    bf16x8 At[4][2], B0[2][2], B1[2][2];
    const char* cA = (const char*)g.A + (size_t)cur.pm * tstepA; const char* cB = (const char*)g.Bt + (size_t)cur.pn * tstepB;
    S.a_ready(cur);
    if constexpr (SP2) {
        PG8_STAGE(PG8_SB(0, 0), cB, voffB); PG8_STAGE(PG8_SB(0, 1), cB + hstepB, voffB); PG8_STAGE(PG8_SA(0, 0), cA, voffA); PG8_STAGE(PG8_SA(0, 1), cA + hstepA, voffA);
        if (wr == 1) PG8_BAR;
        PG8_WAIT_V(2); PG8_BAR;
        PG8_STAGE(PG8_SB(1, 0), cB + kstep, voffB); PG8_STAGE(PG8_SA(1, 0), cA + kstep, voffA); PG8_STAGE(PG8_SB(1, 1), cB + hstepB + kstep, voffB);
        PG8_WAIT_V(6); PG8_BAR;
    } else {
        PG8_STAGE(PG8_SB(0, 0), cB, voffB); PG8_STAGE(PG8_SA(0, 0), cA, voffA); PG8_STAGE(PG8_SB(0, 1), cB + hstepB, voffB); PG8_STAGE(PG8_SA(0, 1), cA + hstepA, voffA);
        if (wr == 1) PG8_BAR;
        PG8_WAIT_V(4); PG8_BAR;
        PG8_STAGE(PG8_SB(1, 0), cB + kstep, voffB); PG8_STAGE(PG8_SA(1, 0), cA + kstep, voffA); PG8_STAGE(PG8_SB(1, 1), cB + hstepB + kstep, voffB);
        PG8_WAIT_V(6); PG8_BAR;
    }
    for (;;) {
        const bool has_next = S.next(ui + 1, nxt);
        const char* nA = has_next ? (const char*)g.A + (size_t)nxt.pm * tstepA : cA; const char* nB = has_next ? (const char*)g.Bt + (size_t)nxt.pn * tstepB : cB;
        for (int t = 0; t < nt; t += 2) {
            const bool last = (t == nt - 2);
            const char* a1 = cA + (size_t)(t + 1) * kstep;
            const char* a2 = last ? nA : cA + (size_t)(t + 2) * kstep; const char* b2 = last ? nB : cB + (size_t)(t + 2) * kstep;
            const char* a3 = a2 + kstep; const char* b3 = b2 + kstep;
            if (last && has_next) S.a_ready(nxt);
            if constexpr (SP2) {
            PG8_LDB(B0, 0, 0); PG8_LDB(B1, 0, 1); PG8_SCHED; PG8_LDA(At, 0, 0); PG8_STAGE(PG8_SA(1, 1), a1 + hstepA, voffA);
            PG8_WAIT_V(8); PG8_WAIT_L(0); PG8_BAR; PG8_MMA(0, 0, At, B0); PG8_MMA(0, 1, At, B1); PG8_BAR; PG8_SCHED;
            PG8_LDA(At, 0, 1); PG8_STAGE(PG8_SB(0, 0), b2, voffB); PG8_STAGE(PG8_SB(0, 1), b2 + hstepB, voffB); PG8_STAGE(PG8_SA(0, 0), a2, voffA);
            PG8_WAIT_V(8); PG8_WAIT_L(0); PG8_BAR; PG8_MMA(1, 0, At, B0); PG8_MMA(1, 1, At, B1); PG8_BAR; PG8_SCHED;
            PG8_LDB(B0, 1, 0); PG8_LDB(B1, 1, 1); PG8_SCHED; PG8_LDA(At, 1, 0); PG8_STAGE(PG8_SA(0, 1), a2 + hstepA, voffA);
            PG8_WAIT_V(8); PG8_WAIT_L(0); PG8_BAR; PG8_MMA(0, 0, At, B0); PG8_MMA(0, 1, At, B1); PG8_BAR; PG8_SCHED;
            PG8_LDA(At, 1, 1); PG8_STAGE(PG8_SB(1, 0), b3, voffB); PG8_STAGE(PG8_SB(1, 1), b3 + hstepB, voffB); PG8_STAGE(PG8_SA(1, 0), a3, voffA);
            PG8_WAIT_V(8); PG8_WAIT_L(0); PG8_BAR; PG8_MMA(1, 0, At, B0); PG8_MMA(1, 1, At, B1); PG8_BAR; PG8_SCHED;
            } else {
            PG8_LDB(B0, 0, 0); PG8_SCHED; PG8_LDA(At, 0, 0); PG8_STAGE(PG8_SA(1, 1), a1 + hstepA, voffA);
            PG8_WAIT_L(8); PG8_BAR; PG8_WAIT_L(0); PG8_MMA(0, 0, At, B0); PG8_BAR; PG8_SCHED;
            PG8_LDB(B1, 0, 1); PG8_STAGE(PG8_SB(0, 0), b2, voffB);
            PG8_BAR; PG8_WAIT_L(0); PG8_MMA(0, 1, At, B1); PG8_BAR;
            PG8_LDA(At, 0, 1); PG8_STAGE(PG8_SA(0, 0), a2, voffA);
            PG8_BAR; PG8_WAIT_L(0); PG8_MMA(1, 0, At, B0); PG8_BAR; PG8_SCHED;
            PG8_STAGE(PG8_SB(0, 1), b2 + hstepB, voffB);
            PG8_WAIT_V(6); PG8_BAR; PG8_MMA(1, 1, At, B1); PG8_BAR;
            PG8_LDB(B0, 1, 0); PG8_SCHED; PG8_LDA(At, 1, 0); PG8_STAGE(PG8_SA(0, 1), a2 + hstepA, voffA);
            PG8_WAIT_L(8); PG8_BAR; PG8_WAIT_L(0); PG8_MMA(0, 0, At, B0); PG8_BAR; PG8_SCHED;
            PG8_LDB(B1, 1, 1); PG8_STAGE(PG8_SB(1, 0), b3, voffB);
            PG8_BAR; PG8_WAIT_L(0); PG8_MMA(0, 1, At, B1); PG8_BAR;
            PG8_LDA(At, 1, 1); PG8_STAGE(PG8_SA(1, 0), a3, voffA);
            PG8_BAR; PG8_WAIT_L(0); PG8_MMA(1, 0, At, B0); PG8_BAR; PG8_SCHED;
            PG8_STAGE(PG8_SB(1, 1), b3 + hstepB, voffB);
            PG8_WAIT_V(6); PG8_BAR; PG8_MMA(1, 1, At, B1); PG8_BAR;
            }
        }
        if constexpr (ALIGN_EPI) { if (wr == 0) PG8_BAR; }
        if constexpr (!Epi::AFTER_DRAIN) { E(acc, cur, wr, wc, fr, fq); S.done(cur); }
        if (!has_next) break;
#pragma unroll
        for (int a = 0; a < 2; ++a)
#pragma unroll
            for (int b = 0; b < 2; ++b)
#pragma unroll
                for (int m = 0; m < 4; ++m)
#pragma unroll
                    for (int n = 0; n < 2; ++n) acc[a][b][m][n] = (f32x4){0.f, 0.f, 0.f, 0.f};
        cur = nxt; cA = nA; cB = nB; ++ui;
        if constexpr (ALIGN_EPI) { if (wr == 1) PG8_BAR; }
    }
    PG8_WAIT_V(0);
    if constexpr (!ALIGN_EPI) { if (wr == 0) PG8_BAR; }
    PG8_BAR;
    if constexpr (Epi::AFTER_DRAIN) { E.fused(acc, cur, wr, wc, fr, fq, lds, wid, lane); S.done(cur); }
#undef PG8_SA
#undef PG8_SB
#undef PG8_STAGE
#undef PG8_LDA
#undef PG8_LDB
#undef PG8_MMA
#undef PG8_WAIT_V
#undef PG8_WAIT_L
#undef PG8_BAR
#undef PG8_SCHED
}
}

typedef unsigned short u16;
using pg8::f32x4;
constexpr int T_TOK = 16384, SEQ = 8192, DM = 1024, DFF = 2816;
constexpr int EV_N = 4352, OD_N = 2304, RWIN = 1760;
constexpr int NSEG = 16, LSEG = 512;
constexpr int LDS_BYTES = 144 * 1024;
#ifndef PH_MASK
#define PH_MASK 0xFFF
#endif
constexpr size_t MiB = 1048576;
constexpr size_t WS_WIN = 0, WS_WOUT = 9 * MiB, WS_WFI = 11 * MiB, WS_WFO = 22 * MiB, WS_WGLU = 28 * MiB;
constexpr size_t WS_XA = 30 * MiB, WS_R0 = 62 * MiB;
constexpr size_t WS_P = WS_R0, WS_ACT = WS_R0;
constexpr size_t EV_XBC = WS_R0 + 136 * MiB, EV_DT = EV_XBC + 32 * MiB, EV_AOF = EV_DT + 1 * MiB, EV_AOB = EV_AOF + 16 * MiB,
                 EV_BYF = EV_AOB + 16 * MiB, EV_BYB = EV_BYF + 16 * MiB, EV_ALC = EV_BYB + 16 * MiB, EV_BLC = EV_ALC + 16 * MiB,
                 EV_ADEC = EV_BLC + 16 * MiB, EV_BDEC = EV_ADEC + 1 * MiB;
constexpr size_t OD_CYF = WS_R0, OD_CYB = WS_R0 + 16 * MiB;
constexpr size_t OD_PREP = WS_R0 + 72 * MiB;
constexpr size_t OD_R = OD_PREP, OD_V = OD_PREP + 16 * MiB, OD_KK = OD_PREP + 32 * MiB, OD_G = OD_PREP + 48 * MiB, OD_KF = OD_PREP + 64 * MiB,
                 OD_KB = OD_PREP + 80 * MiB, OD_AF = OD_PREP + 96 * MiB, OD_AB = OD_PREP + 112 * MiB, OD_WF1 = OD_PREP + 128 * MiB, OD_WB1 = OD_PREP + 144 * MiB;
constexpr size_t OD_A1 = OD_PREP + 160 * MiB, OD_CLC = OD_A1 + 32 * MiB, OD_CPM = OD_CLC + 8 * MiB;
constexpr size_t OD_XLOC = WS_XA, OD_BT1 = WS_R0 + 32 * MiB, OD_BT0 = WS_R0 + 40 * MiB;
constexpr size_t OD_TINV = WS_R0 + 44 * MiB;
constexpr size_t OD_KP = OD_KF, OD_XL = WS_XA + 16 * MiB, OD_BTL = OD_CPM + 8 * MiB;
constexpr size_t OD_YG = OD_WF1;
constexpr size_t WS_NEED = 344 * MiB;

struct Params { const float* in[39]; float* out; unsigned char* ws; int lo, hi; };
enum { I_X = 0, I_NMIX, I_NFFN, I_NFIN, I_FFI, I_FFO, I_EVIN, I_EVOUT, I_HGLB, I_HGNW, I_M2CW, I_M2CB, I_M2DTB, I_M2ALOG, I_M2D, I_M2NW,
       I_ODIN, I_ODOUT, I_MU, I_W0, I_W2, I_A0, I_A2, I_G2, I_KK, I_KA, I_RK, I_LNW, I_LNB, I_SARE, I_SAIM, I_SBRE, I_SBIM, I_SCRE, I_SCIM, I_SD, I_SLS, I_GLUW, I_GLUB };


__device__ __forceinline__ const float* inp_(const Params& p, int i) { asm volatile("" : "+s"(i)); return p.in[i]; }
__device__ __forceinline__ unsigned char* wsp_(const Params& p) { size_t z = 0; asm volatile("" : "+s"(z)); return p.ws + z; }
__device__ __forceinline__ float* outp_(const Params& p) { size_t z = 0; asm volatile("" : "+s"(z)); return p.out + z; }
#define INP(p, i) inp_(p, i)
#define WSP(p) wsp_(p)
#define OUTP(p) outp_(p)


constexpr size_t WS_BAR = 29 * MiB;
#define LAS __attribute__((address_space(3)))
#define XB_TMO      128
#define XB_XCNT(j)  (256  + 64 * (j))
#define XB_XSUB(j)  (1280 + 64 * (j))
#define XB_XGEN(j)  (2304 + 64 * (j))
#define XB_TOP      3328
#define XB_TOPGEN   3392
#define XCD_BAR_WORDS 3456
#define XB_SPIN_CAP (1u << 18)

__device__ __forceinline__ unsigned xb_ld(unsigned* p)              { return __hip_atomic_load(p, __ATOMIC_RELAXED, __HIP_MEMORY_SCOPE_AGENT); }
__device__ __forceinline__ unsigned xb_add(unsigned* p, unsigned v) { return __hip_atomic_fetch_add(p, v, __ATOMIC_RELAXED, __HIP_MEMORY_SCOPE_AGENT); }
__device__ __forceinline__ unsigned xb_xcc_id() { return (unsigned)__builtin_amdgcn_s_getreg((3 << 11) | 20) & 0xFu; }
#define XB_SPIN(cond, bar) do { unsigned _sp = 0; while (cond) { __builtin_amdgcn_s_sleep(1); \
    if ((++_sp & 255u) == 0u) { if (xb_ld(&(bar)[XB_TMO])) break; if (_sp > XB_SPIN_CAP) { atomicAdd(&(bar)[XB_TMO], 1u); break; } } } } while (0)

struct XcdBarrier {
    unsigned* bar; unsigned x;
    volatile LAS unsigned* st;
};

__device__ __forceinline__ XcdBarrier xcd_barrier_post(unsigned* bar, volatile LAS unsigned* st) {
    XcdBarrier b; b.bar = bar; b.x = xb_xcc_id(); b.st = st;
    if (otid() == 0) (void)xb_add(&bar[XB_XCNT(b.x)], 1u);
    return b;
}
__device__ __forceinline__ void xcd_barrier_complete(unsigned* bar, unsigned x, unsigned& nloc, unsigned& nx) {
    const unsigned G = gridDim.x * gridDim.y * gridDim.z;
    unsigned sum, cnt, mine, sp = 0u;
    for (;;) {
        sum = 0u; cnt = 0u; mine = 0u;
#pragma unroll
        for (unsigned j = 0; j < 16; ++j) { const unsigned c = xb_ld(&bar[XB_XCNT(j)]); sum += c; cnt += (c > 0u) ? 1u : 0u; mine = (j == x) ? c : mine; }
        if (sum == G) break;
        __builtin_amdgcn_s_sleep(1);
        if ((++sp & 255u) == 0u) { if (xb_ld(&bar[XB_TMO])) break; if (sp > XB_SPIN_CAP) { atomicAdd(&bar[XB_TMO], 1u); break; } }
    }
    nloc = mine > 0u ? mine : 1u; nx = cnt > 0u ? cnt : 1u;
}

__device__ __forceinline__ void xcd_barrier(const XcdBarrier& b) {
    asm volatile("s_waitcnt vmcnt(0)" ::: "memory");
    __syncthreads();
    if (otid() == 0) {
        unsigned* bar = b.bar;
        __builtin_amdgcn_s_waitcnt(0);
        unsigned nloc = b.st[0], nx = b.st[1];
        if (nloc == 0u) { xcd_barrier_complete(bar, b.x, nloc, nx); b.st[0] = nloc; b.st[1] = nx; }
        const unsigned old = xb_add(&bar[XB_XSUB(b.x)], 1u);
        const unsigned gen = old / nloc;
        if (old + 1u == (gen + 1u) * nloc) {
            __builtin_amdgcn_fence(__ATOMIC_RELEASE, "agent");
            asm volatile("s_waitcnt vmcnt(0)" ::: "memory");
            const unsigned og = xb_add(&bar[XB_TOP], 1u);
            const unsigned tg = og / nx;
            if (og + 1u == (tg + 1u) * nx) xb_add(&bar[XB_TOPGEN], 1u);
            else XB_SPIN(xb_ld(&bar[XB_TOPGEN]) == tg, bar);
            __builtin_amdgcn_fence(__ATOMIC_ACQUIRE, "agent");
            xb_add(&bar[XB_XGEN(b.x)], 1u);
            asm volatile("s_waitcnt vmcnt(0)" ::: "memory");
        } else {
            XB_SPIN(xb_ld(&bar[XB_XGEN(b.x)]) == gen, bar);
            __builtin_amdgcn_fence(__ATOMIC_ACQUIRE, "agent");
            asm volatile("s_waitcnt vmcnt(0)" ::: "memory");
        }
    }
    __syncthreads();
}

__device__ __forceinline__ float bf2f(unsigned b) { return __builtin_bit_cast(float, b << 16); }
typedef float f32x2_t __attribute__((ext_vector_type(2)));
typedef __bf16 bf16x2_t __attribute__((ext_vector_type(2)));
__device__ __forceinline__ unsigned pk2(float lo, float hi) { const f32x2_t v = {lo, hi}; const bf16x2_t b = __builtin_convertvector(v, bf16x2_t); return __builtin_bit_cast(unsigned, b); }
__device__ __forceinline__ unsigned f2bf(float f) { return pk2(f, f) & 0xffffu; }
__device__ __forceinline__ float h2f(unsigned h) { return (float)__builtin_bit_cast(_Float16, (u16)h); }
__device__ __forceinline__ unsigned f2h(float f) { return (unsigned)__builtin_bit_cast(u16, (_Float16)f); }
__device__ __forceinline__ unsigned pk2h(float lo, float hi) { return f2h(lo) | (f2h(hi) << 16); }
#define UNPACK8_BF(v, o) do { o[0] = bf2f((v).x & 0xffffu); o[1] = __builtin_bit_cast(float, (v).x & 0xffff0000u); o[2] = bf2f((v).y & 0xffffu); o[3] = __builtin_bit_cast(float, (v).y & 0xffff0000u); \
    o[4] = bf2f((v).z & 0xffffu); o[5] = __builtin_bit_cast(float, (v).z & 0xffff0000u); o[6] = bf2f((v).w & 0xffffu); o[7] = __builtin_bit_cast(float, (v).w & 0xffff0000u); } while (0)
#define UNPACK8_H(v, o) do { o[0] = h2f((v).x & 0xffffu); o[1] = h2f((v).x >> 16); o[2] = h2f((v).y & 0xffffu); o[3] = h2f((v).y >> 16); \
    o[4] = h2f((v).z & 0xffffu); o[5] = h2f((v).z >> 16); o[6] = h2f((v).w & 0xffffu); o[7] = h2f((v).w >> 16); } while (0)
#define PACK8_BF(o) make_uint4(pk2(o[0], o[1]), pk2(o[2], o[3]), pk2(o[4], o[5]), pk2(o[6], o[7]))
#define PACK8_H(o) make_uint4(pk2h(o[0], o[1]), pk2h(o[2], o[3]), pk2h(o[4], o[5]), pk2h(o[6], o[7]))
__device__ __forceinline__ float sigmoidf_(float x) { return __builtin_amdgcn_rcpf(1.f + __expf(-x)); }
__device__ __forceinline__ float siluf_(float x) { return x * __builtin_amdgcn_rcpf(1.f + __expf(-x)); }
__device__ __forceinline__ float tanhf_(float x) { x = fminf(fmaxf(x, -15.f), 15.f); const float t = __expf(2.f * x); return (t - 1.f) * __builtin_amdgcn_rcpf(t + 1.f); }
__device__ __forceinline__ float softplusf_(float x) { return fmaxf(x, 0.f) + log1pf(__expf(-fabsf(x))); }
__device__ __forceinline__ float dppf(float x, const int ctrl_sel) {
    const int v = __builtin_bit_cast(int, x); int r;
    if (ctrl_sel == 0) r = __builtin_amdgcn_update_dpp(0, v, 0xB1, 0xF, 0xF, true);
    else if (ctrl_sel == 1) r = __builtin_amdgcn_update_dpp(0, v, 0x4E, 0xF, 0xF, true);
    else if (ctrl_sel == 2) r = __builtin_amdgcn_update_dpp(0, v, 0x141, 0xF, 0xF, true);
    else r = __builtin_amdgcn_update_dpp(0, v, 0x140, 0xF, 0xF, true);
    return __builtin_bit_cast(float, r);
}
__device__ __forceinline__ float red4(float x) { x += dppf(x, 0); x += dppf(x, 1); return x; }
__device__ __forceinline__ float red8(float x) { x = red4(x); x += dppf(x, 2); return x; }
__device__ __forceinline__ float red16(float x) { x = red8(x); x += dppf(x, 3); return x; }
__device__ __forceinline__ float lane_xor(float x, int m) { return __builtin_bit_cast(float, __builtin_amdgcn_ds_bpermute((((otid() & 63) ^ m) << 2), __builtin_bit_cast(int, x))); }
__device__ __forceinline__ float red32(float x) { x = red16(x); x += lane_xor(x, 16); return x; }
__device__ __forceinline__ float red64(float x) { x = red32(x); x += lane_xor(x, 32); return x; }

struct EpiPlain {
    static constexpr bool PERM = true, AFTER_DRAIN = false;
    u16* O; int ld, col_base, shift_from, shift, nvalid;
    __device__ __forceinline__ void operator()(const f32x4 (&acc)[2][2][4][2], const pg8::Unit& u, int wr, int wc, int fr, int fq) const {
        asm volatile("" : "+v"(fr), "+v"(fq));
        const int row0 = u.pm * 256 + wr * 64 + fr, col0 = u.pn * 256 + wc * 32 + 8 * fq, cadd = col_base + (u.pn >= shift_from ? shift : 0);
#pragma unroll
        for (int ai = 0; ai < 2; ++ai)
#pragma unroll
            for (int m = 0; m < 4; ++m)
#pragma unroll
                for (int bj = 0; bj < 2; ++bj) {
                    const f32x4 v0 = acc[ai][bj][m][0], v1 = acc[ai][bj][m][1];
                    if (col0 + bj * 128 < nvalid)
                        *(uint4*)(O + (size_t)(row0 + ai * 128 + m * 16) * ld + cadd + col0 + bj * 128) = make_uint4(pk2(v0[0], v0[1]), pk2(v0[2], v0[3]), pk2(v1[0], v1[1]), pk2(v1[2], v1[3]));
                }
    }
};
struct EpiResid {
    static constexpr bool PERM = true, AFTER_DRAIN = false;
    const float* hin; float* out;
    __device__ __forceinline__ void operator()(const f32x4 (&acc)[2][2][4][2], const pg8::Unit& u, int wr, int wc, int fr, int fq) const {
        asm volatile("" : "+v"(fr), "+v"(fq));
        const int row0 = u.pm * 256 + wr * 64 + fr, col0 = u.pn * 256 + wc * 32 + 8 * fq;
#pragma unroll
        for (int ai = 0; ai < 2; ++ai)
#pragma unroll
            for (int m = 0; m < 4; ++m)
#pragma unroll
                for (int bj = 0; bj < 2; ++bj) {
                    const size_t o = (size_t)(row0 + ai * 128 + m * 16) * DM + col0 + bj * 128;
                    const float4 a = *(const float4*)(hin + o), b = *(const float4*)(hin + o + 4);
                    const f32x4 v0 = acc[ai][bj][m][0], v1 = acc[ai][bj][m][1];
                    *(float4*)(out + o) = make_float4(a.x + v0[0], a.y + v0[1], a.z + v0[2], a.w + v0[3]);
                    *(float4*)(out + o + 4) = make_float4(b.x + v1[0], b.y + v1[1], b.z + v1[2], b.w + v1[3]);
                }
    }
};
struct EpiFfn {
    static constexpr bool PERM = true, AFTER_DRAIN = false;
    u16* ACT;
    __device__ __forceinline__ void operator()(const f32x4 (&acc)[2][2][4][2], const pg8::Unit& u, int wr, int wc, int fr, int fq) const {
        asm volatile("" : "+v"(fr), "+v"(fq));
        const int row0 = u.pm * 256 + wr * 64 + fr, col0 = u.pn * 128 + wc * 32 + 8 * fq;
#pragma unroll
        for (int ai = 0; ai < 2; ++ai)
#pragma unroll
            for (int m = 0; m < 4; ++m) {
                float o[8];
#pragma unroll
                for (int n = 0; n < 2; ++n)
#pragma unroll
                    for (int e = 0; e < 4; ++e) o[n * 4 + e] = siluf_(acc[ai][0][m][n][e]) * acc[ai][1][m][n][e];
                *(uint4*)(ACT + (size_t)(row0 + ai * 128 + m * 16) * DFF + col0) = PACK8_BF(o);
            }
    }
};
struct EpiGlu {
    static constexpr bool PERM = true, AFTER_DRAIN = false;
    const u16* YG; const float* gb; u16* O;
    __device__ __forceinline__ void operator()(const f32x4 (&acc)[2][2][4][2], const pg8::Unit& u, int wr, int wc, int fr, int fq) const {
        asm volatile("" : "+v"(fr), "+v"(fq));
        const int row0 = u.pm * 256 + wr * 64 + fr, col0 = u.pn * 256 + wc * 32 + 8 * fq;
#pragma unroll
        for (int bj = 0; bj < 2; ++bj) {
            const int col = col0 + bj * 128;
            float bb[8];
#pragma unroll
            for (int e = 0; e < 8; ++e) bb[e] = gb[col + e];
#pragma unroll
            for (int ai = 0; ai < 2; ++ai)
#pragma unroll
                for (int m = 0; m < 4; ++m) {
                    const int row = row0 + ai * 128 + m * 16;
                    const uint4 yv = *(const uint4*)(YG + (size_t)row * 512 + col);
                    float y[8], o[8]; UNPACK8_BF(yv, y);
#pragma unroll
                    for (int n = 0; n < 2; ++n)
#pragma unroll
                        for (int e = 0; e < 4; ++e) o[n * 4 + e] = y[n * 4 + e] * sigmoidf_(acc[ai][bj][m][n][e] + bb[n * 4 + e]);
                    *(uint4*)(O + (size_t)row * DM + 512 + col) = PACK8_BF(o);
                }
        }
    }
};
struct EpiEven {
    static constexpr bool PERM = true, AFTER_DRAIN = false;
    u16* P; float* DT; const float* lbp; const float* dtb; int j;
    __device__ __forceinline__ void operator()(const f32x4 (&acc)[2][2][4][2], const pg8::Unit& u, int wr, int wc, int fr, int fq) const {
        asm volatile("" : "+v"(fr), "+v"(fq));
        const int pn = u.pn, row0 = u.pm * 256 + wr * 64 + fr;
        if (pn == 16) {
            if (wc == 0 && fq < 2) {
                float bias[8];
#pragma unroll
                for (int e = 0; e < 8; ++e) bias[e] = dtb[8 * fq + e];
#pragma unroll
                for (int ai = 0; ai < 2; ++ai)
#pragma unroll
                    for (int m = 0; m < 4; ++m) {
                        float o[8];
#pragma unroll
                        for (int n = 0; n < 2; ++n)
#pragma unroll
                            for (int e = 0; e < 4; ++e) o[n * 4 + e] = softplusf_(acc[ai][0][m][n][e] + bias[n * 4 + e]);
                        float* d = DT + (size_t)(row0 + ai * 128 + m * 16) * 16 + 8 * fq;
                        *(float4*)d = make_float4(o[0], o[1], o[2], o[3]); *(float4*)(d + 4) = make_float4(o[4], o[5], o[6], o[7]);
                    }
            }
            return;
        }
        const int region = pn >> 1;
#pragma unroll
        for (int bj = 0; bj < 2; ++bj) {
            const int col = pn * 256 + bj * 128 + wc * 32 + 8 * fq;
            float oml[8];
#pragma unroll
            for (int e = 0; e < 8; ++e) oml[e] = 1.f;
            if (region == 1 || region == 2) {
                const int c = col - region * 512;
#pragma unroll
                for (int e = 0; e < 8; ++e) oml[e] = (j == 0) ? 1.f : 1.f - sigmoidf_(lbp[512 + c + e] - lbp[c + e]);
            }
#pragma unroll
            for (int ai = 0; ai < 2; ++ai)
#pragma unroll
                for (int m = 0; m < 4; ++m) {
                    float x[8];
#pragma unroll
                    for (int n = 0; n < 2; ++n)
#pragma unroll
                        for (int e = 0; e < 4; ++e) x[n * 4 + e] = acc[ai][bj][m][n][e];
                    uint4 w;
                    if (region == 0) {
#pragma unroll
                        for (int e = 0; e < 8; ++e) x[e] = siluf_(x[e]) * 0.08838834764831845f;
                        w = PACK8_BF(x);
                    } else if (region == 1 || region == 2) {
#pragma unroll
                        for (int e = 0; e < 8; ++e) x[e] = oml[e] * sigmoidf_(-x[e]);
                        w = PACK8_H(x);
                    } else if (region == 4 || region == 5) {
#pragma unroll
                        for (int e = 0; e < 8; ++e) x[e] = siluf_(x[e]);
                        w = PACK8_BF(x);
                    } else {
                        w = PACK8_BF(x);
                    }
                    *(uint4*)(P + (size_t)(row0 + ai * 128 + m * 16) * EV_N + col) = w;
                }
        }
    }
};

__device__ __forceinline__ void convert_weight(const float* W, int K, int ld, int nvalid, int mode, u16* WT, int Nout, unsigned char* lds, int& item, int gsz) {
    float* tile = (float*)lds;
    const int tid = otid();
    const int nk = K / 64, nn = Nout / 128, total = nk * nn;
    for (; item < total; item += gsz) {
        const int tn = item / nk, tk = item % nk, n0 = tn * 128, k0 = tk * 64;
        int sc0 = n0; if (mode == 1) { const int t = n0 >> 8, b = (n0 >> 7) & 1; sc0 = b * DFF + 128 * t; }
        else if (mode == 2) sc0 = (n0 < 1536) ? n0 : n0 + 224;
        else if (mode == 3) sc0 = n0 + 1536;
        float v[16];
#pragma unroll
        for (int i = 0; i < 16; ++i) {
            const int kk = (tid >> 7) + 4 * i, nnn = tid & 127;
            v[i] = (n0 + nnn < nvalid) ? W[(size_t)(k0 + kk) * ld + sc0 + nnn] : 0.f;
        }
        __syncthreads();
#pragma unroll
        for (int i = 0; i < 16; ++i) tile[((tid >> 7) + 4 * i) * 129 + (tid & 127)] = v[i];
        __syncthreads();
        const int on = tid >> 2, kc = tid & 3;
        float o[16];
#pragma unroll
        for (int e = 0; e < 16; ++e) o[e] = tile[(kc * 16 + e) * 129 + on];
        *(uint4*)(WT + (size_t)(n0 + on) * K + k0 + kc * 16) = make_uint4(pk2(o[0], o[1]), pk2(o[2], o[3]), pk2(o[4], o[5]), pk2(o[6], o[7]));
        *(uint4*)(WT + (size_t)(n0 + on) * K + k0 + kc * 16 + 8) = make_uint4(pk2(o[8], o[9]), pk2(o[10], o[11]), pk2(o[12], o[13]), pk2(o[14], o[15]));
    }
    item -= total;
}

__device__ __forceinline__ void norm_rows_bf16(const float* h, const float* w, u16* o) {
    const int lane = otid() & 63, gw = obid() * 8 + (otid() >> 6), nw = gridDim.x * 8;
    float4 wv[4];
#pragma unroll
    for (int i = 0; i < 4; ++i) wv[i] = *(const float4*)(w + lane * 4 + 256 * i);
    for (int row0 = gw * 4; row0 < T_TOK; row0 += nw * 4) {
        float4 v[4][4]; float ss[4];
#pragma unroll
        for (int r = 0; r < 4; ++r)
#pragma unroll
            for (int i = 0; i < 4; ++i) v[r][i] = *(const float4*)(h + (size_t)(row0 + r) * DM + lane * 4 + 256 * i);
#pragma unroll
        for (int r = 0; r < 4; ++r) {
            float a = 0.f;
#pragma unroll
            for (int i = 0; i < 4; ++i) a += v[r][i].x * v[r][i].x + v[r][i].y * v[r][i].y + v[r][i].z * v[r][i].z + v[r][i].w * v[r][i].w;
            ss[r] = a;
        }
#pragma unroll
        for (int r = 0; r < 4; ++r) ss[r] = red64(ss[r]);
#pragma unroll
        for (int r = 0; r < 4; ++r) {
            const float rs = rsqrtf(ss[r] * (1.f / DM) + 1e-6f);
#pragma unroll
            for (int i = 0; i < 4; ++i)
                *(uint2*)(o + (size_t)(row0 + r) * DM + lane * 4 + 256 * i) = make_uint2(pk2(v[r][i].x * rs * wv[i].x, v[r][i].y * rs * wv[i].y), pk2(v[r][i].z * rs * wv[i].z, v[r][i].w * rs * wv[i].w));
        }
    }
}
__device__ __forceinline__ void norm_rows_f32_inplace(float* h, const float* w) {
    const int lane = otid() & 63, gw = obid() * 8 + (otid() >> 6), nw = gridDim.x * 8;
    float4 wv[4];
#pragma unroll
    for (int i = 0; i < 4; ++i) wv[i] = *(const float4*)(w + lane * 4 + 256 * i);
    for (int row = gw; row < T_TOK; row += nw) {
        float4 v[4]; float ss = 0.f;
#pragma unroll
        for (int i = 0; i < 4; ++i) { v[i] = *(const float4*)(h + (size_t)row * DM + lane * 4 + 256 * i); ss += v[i].x * v[i].x + v[i].y * v[i].y + v[i].z * v[i].z + v[i].w * v[i].w; }
        ss = red64(ss);
        const float r = rsqrtf(ss * (1.f / DM) + 1e-6f);
#pragma unroll
        for (int i = 0; i < 4; ++i)
            *(float4*)(h + (size_t)row * DM + lane * 4 + 256 * i) = make_float4(v[i].x * r * wv[i].x, v[i].y * r * wv[i].y, v[i].z * r * wv[i].z, v[i].w * r * wv[i].w);
    }
}

#define ST8F(dst, o) do { *(float4*)(dst) = make_float4(o[0], o[1], o[2], o[3]); *(float4*)((dst) + 4) = make_float4(o[4], o[5], o[6], o[7]); } while (0)
#define TIME_ROW(seg, s, dir, b) ((b) * SEQ + ((dir) ? (SEQ - 1 - ((seg) * LSEG + (s))) : ((seg) * LSEG + (s))))

template <int PASS>
__device__ __forceinline__ void hg_scan(const Params& p, unsigned char* lds) {
    const int tid = otid();
    float* Lk = (float*)lds;
    float* Lq = Lk + 32 * 144;
    float* Lv = Lq + 32 * 144;
    u16* Lo = (u16*)(Lv + 32 * 128);
    const u16* P = (const u16*)(WSP(p) + WS_P);
    float* LC = (float*)(WSP(p) + EV_ALC); float* DEC = (float*)(WSP(p) + EV_ADEC);
    const int v = tid >> 2, kg = tid & 3, lrow = tid >> 4, lch = (tid & 15) * 8;
    const int lko = lrow * 144 + (lch >> 5) * 36 + (lch & 31);
    for (int unit = obid(); unit < 256; unit += gridDim.x) {
        const int seg = unit & 15, h = (unit >> 4) & 3, b = (unit >> 6) & 1, dir = unit >> 7;
        u16* AO = (u16*)(WSP(p) + (dir ? EV_AOB : EV_AOF));
        float S[32];
#pragma unroll
        for (int i = 0; i < 32; ++i) S[i] = (PASS == 1) ? 0.f : LC[(size_t)unit * 16384 + (kg * 32 + i) * 128 + v];
        float Dk = 1.f;
        uint4 rk, rv, rq = make_uint4(0, 0, 0, 0);
        {
            const u16* base = P + (size_t)TIME_ROW(seg, lrow, dir, b) * EV_N + h * 128 + lch;
            rk = *(const uint4*)(base + 512 + dir * 512); rv = *(const uint4*)(base + 1536); if (PASS == 3) rq = *(const uint4*)(base);
        }
        for (int tile = 0; tile < LSEG / 32; ++tile) {
            __syncthreads();
            { float f[8]; UNPACK8_H(rk, f); ST8F(Lk + lko, f); UNPACK8_BF(rv, f); ST8F(Lv + lrow * 128 + lch, f); if (PASS == 3) { UNPACK8_BF(rq, f); ST8F(Lq + lko, f); } }
            __syncthreads();
            if (tile + 1 < LSEG / 32) {
                const u16* base = P + (size_t)TIME_ROW(seg, (tile + 1) * 32 + lrow, dir, b) * EV_N + h * 128 + lch;
                rk = *(const uint4*)(base + 512 + dir * 512); rv = *(const uint4*)(base + 1536); if (PASS == 3) rq = *(const uint4*)(base);
            }
            for (int s = 0; s < 32; ++s) {
                const float vs = Lv[s * 128 + v];
                float o = 0.f;
#pragma unroll
                for (int i4 = 0; i4 < 8; ++i4) {
                    const float4 kk = *(const float4*)(Lk + s * 144 + kg * 36 + i4 * 4);
                    S[i4 * 4 + 0] = fmaf(kk.x, vs - S[i4 * 4 + 0], S[i4 * 4 + 0]);
                    S[i4 * 4 + 1] = fmaf(kk.y, vs - S[i4 * 4 + 1], S[i4 * 4 + 1]);
                    S[i4 * 4 + 2] = fmaf(kk.z, vs - S[i4 * 4 + 2], S[i4 * 4 + 2]);
                    S[i4 * 4 + 3] = fmaf(kk.w, vs - S[i4 * 4 + 3], S[i4 * 4 + 3]);
                    if (PASS == 3) {
                        const float4 qq = *(const float4*)(Lq + s * 144 + kg * 36 + i4 * 4);
                        o = fmaf(S[i4 * 4 + 0], qq.x, o); o = fmaf(S[i4 * 4 + 1], qq.y, o); o = fmaf(S[i4 * 4 + 2], qq.z, o); o = fmaf(S[i4 * 4 + 3], qq.w, o);
                    }
                }
                if (PASS == 3) { o = red4(o); if (kg == 0) Lo[s * 128 + v] = (u16)f2bf(o); }
            }
            if (PASS == 1) { if (tid < 128) { for (int s = 0; s < 32; ++s) Dk *= 1.f - Lk[s * 144 + (tid >> 5) * 36 + (tid & 31)]; } }
            if (PASS == 3) {
                __syncthreads();
                const uint4 ov = *(const uint4*)(Lo + lrow * 128 + lch);
                *(uint4*)(AO + (size_t)TIME_ROW(seg, tile * 32 + lrow, dir, b) * 512 + h * 128 + lch) = ov;
            }
        }
        if (PASS == 1) {
#pragma unroll
            for (int i = 0; i < 32; ++i) LC[(size_t)unit * 16384 + (kg * 32 + i) * 128 + v] = S[i];
            if (tid < 128) DEC[unit * 128 + tid] = Dk;
        }
    }
    __syncthreads();
}

template <int PASS>
__device__ __forceinline__ void m2_scan(const Params& p, int j, unsigned char* lds) {
    const int tid = otid();
    float* Lx = (float*)lds;
    float* LB = Lx + 32 * 64;
    float* LCm = LB + 32 * 160;
    float* Ldt = LCm + 32 * 160;
    float* LdA = Ldt + 32;
    u16* Lo = (u16*)(LdA + 32);
    const u16* XB = (const u16*)(WSP(p) + EV_XBC);
    const float* DT = (const float*)(WSP(p) + EV_DT);
    float* LC = (float*)(WSP(p) + EV_BLC); float* DEC = (float*)(WSP(p) + EV_BDEC);
    const int pp = tid >> 3, ng = tid & 7;
    const int xrow = (tid & 255) >> 3, xch = (tid & 7) * 8;
    const int brow = tid >> 4, bch = (tid & 15) * 8;
    const int lbo = brow * 160 + (bch >> 4) * 20 + (bch & 15);
    for (int unit = obid(); unit < 512; unit += gridDim.x) {
        const int seg = unit & 15, hd = (unit >> 4) & 7, b = (unit >> 7) & 1, dir = unit >> 8, g = hd >> 2;
        u16* YO = (u16*)(WSP(p) + (dir ? EV_BYB : EV_BYF));
        const float a = -__expf(INP(p, I_M2ALOG)[(j * 2 + dir) * 8 + hd]);
        float hS[16];
#pragma unroll
        for (int i = 0; i < 16; ++i) hS[i] = (PASS == 1) ? 0.f : LC[(size_t)unit * 8192 + pp * 128 + ng * 16 + i];
        float dsum = 0.f;
        uint4 rx = make_uint4(0, 0, 0, 0), rb, rc = make_uint4(0, 0, 0, 0); float rdt = 0.f;
        {
            if (tid < 256) rx = *(const uint4*)(XB + (size_t)TIME_ROW(seg, xrow, dir, b) * 1024 + hd * 64 + xch);
            const u16* base = XB + (size_t)TIME_ROW(seg, brow, dir, b) * 1024 + 512 + g * 128 + bch;
            rb = *(const uint4*)base; if (PASS == 3) rc = *(const uint4*)(base + 256);
            if (tid < 32) rdt = DT[(size_t)TIME_ROW(seg, tid, dir, b) * 16 + dir * 8 + hd];
        }
        for (int tile = 0; tile < LSEG / 32; ++tile) {
            __syncthreads();
            { float f[8]; if (tid < 256) { UNPACK8_BF(rx, f); ST8F(Lx + xrow * 64 + xch, f); } UNPACK8_BF(rb, f); ST8F(LB + lbo, f); if (PASS == 3) { UNPACK8_BF(rc, f); ST8F(LCm + lbo, f); }
              if (tid < 32) { Ldt[tid] = rdt; LdA[tid] = __expf(rdt * a); } }
            __syncthreads();
            if (tile + 1 < LSEG / 32) {
                const int s0 = (tile + 1) * 32;
                if (tid < 256) rx = *(const uint4*)(XB + (size_t)TIME_ROW(seg, s0 + xrow, dir, b) * 1024 + hd * 64 + xch);
                const u16* base = XB + (size_t)TIME_ROW(seg, s0 + brow, dir, b) * 1024 + 512 + g * 128 + bch;
                rb = *(const uint4*)base; if (PASS == 3) rc = *(const uint4*)(base + 256);
                if (tid < 32) rdt = DT[(size_t)TIME_ROW(seg, s0 + tid, dir, b) * 16 + dir * 8 + hd];
            }
            for (int s = 0; s < 32; ++s) {
                const float dt = Ldt[s], dA = LdA[s], xdt = dt * Lx[s * 64 + pp];
                dsum += dt * a;
                float y = 0.f;
#pragma unroll
                for (int i4 = 0; i4 < 4; ++i4) {
                    const float4 bv = *(const float4*)(LB + s * 160 + ng * 20 + i4 * 4);
                    hS[i4 * 4 + 0] = fmaf(hS[i4 * 4 + 0], dA, xdt * bv.x);
                    hS[i4 * 4 + 1] = fmaf(hS[i4 * 4 + 1], dA, xdt * bv.y);
                    hS[i4 * 4 + 2] = fmaf(hS[i4 * 4 + 2], dA, xdt * bv.z);
                    hS[i4 * 4 + 3] = fmaf(hS[i4 * 4 + 3], dA, xdt * bv.w);
                    if (PASS == 3) {
                        const float4 cv = *(const float4*)(LCm + s * 160 + ng * 20 + i4 * 4);
                        y = fmaf(hS[i4 * 4 + 0], cv.x, y); y = fmaf(hS[i4 * 4 + 1], cv.y, y); y = fmaf(hS[i4 * 4 + 2], cv.z, y); y = fmaf(hS[i4 * 4 + 3], cv.w, y);
                    }
                }
                if (PASS == 3) { y = red8(y); if (ng == 0) Lo[s * 64 + pp] = (u16)f2bf(y); }
            }
            if (PASS == 3) {
                __syncthreads();
                if (tid < 256) {
                    const uint4 ov = *(const uint4*)(Lo + xrow * 64 + xch);
                    *(uint4*)(YO + (size_t)TIME_ROW(seg, tile * 32 + xrow, dir, b) * 512 + hd * 64 + xch) = ov;
                }
            }
        }
        if (PASS == 1) {
#pragma unroll
            for (int i = 0; i < 16; ++i) LC[(size_t)unit * 8192 + pp * 128 + ng * 16 + i] = hS[i];
            if (tid == 0) DEC[unit] = __expf(dsum);
        }
    }
    __syncthreads();
}


__device__ __forceinline__ void lbar() { asm volatile("s_waitcnt lgkmcnt(0)" ::: "memory"); __builtin_amdgcn_s_barrier(); asm volatile("" ::: "memory"); }
typedef short bf16x8_t __attribute__((ext_vector_type(8)));
__device__ __forceinline__ f32x4 mma16(bf16x8_t a, bf16x8_t b, f32x4 c) { return __builtin_amdgcn_mfma_f32_16x16x32_bf16(a, b, c, 0, 0, 0); }
__device__ __forceinline__ bf16x8_t ldfrag(const u16* base, int ld, int r0, int k0, int lane) { return *(const bf16x8_t*)(base + (r0 + (lane & 15)) * ld + k0 + 8 * (lane >> 4)); }

template <int PASS>
__device__ __forceinline__ void hg_mma(const Params& p, unsigned char* lds) {
    const int tid = otid(), lane = tid & 63, wave = tid >> 6, l15 = lane & 15, lq = lane >> 4;
    u16* Qs = (u16*)lds;
    u16* Kp = Qs + 32 * 136;
    u16* Kt = Kp + 32 * 136;
    u16* Vt = Kt + 128 * 40;
    u16* Pm = Vt + 128 * 40;
    u16* St = Pm + 32 * 40;
    u16* Ob = St + 128 * 136;
    float* Lb = (float*)(Ob + 32 * 128);
    float* Lpart = Lb + 32 * 128;
    float* Ldec = Lpart + 4 * 128;
    u16* Lk1h = (u16*)(Ldec + 128);
    u16* Lvh = Lk1h + 32 * 128;
    const u16* P = (const u16*)(WSP(p) + WS_P);
    float* LC = (float*)(WSP(p) + EV_ALC); float* DEC = (float*)(WSP(p) + EV_ADEC);
    const int lrow = tid >> 4, lch = (tid & 15) * 8;
    for (int unit = obid(); unit < 256; unit += gridDim.x) {
        const int seg = unit & 15, h = (unit >> 4) & 3, b = (unit >> 6) & 1, dir = unit >> 7;
        u16* AO = (u16*)(WSP(p) + (dir ? EV_AOB : EV_AOF));
        f32x4 S[8];
#pragma unroll
        for (int vt = 0; vt < 8; ++vt)
#pragma unroll
            for (int r = 0; r < 4; ++r) S[vt][r] = (PASS == 1) ? 0.f : LC[(size_t)unit * 16384 + (wave * 16 + lq * 4 + r) * 128 + vt * 16 + l15];
        __syncthreads();
        if (PASS == 3) {
#pragma unroll
            for (int vt = 0; vt < 8; ++vt) *(uint2*)(St + (vt * 16 + l15) * 136 + wave * 16 + lq * 4) = make_uint2(pk2(S[vt][0], S[vt][1]), pk2(S[vt][2], S[vt][3]));
        }
        float ltot = 0.f;
        uint4 rk, rv, rq = make_uint4(0, 0, 0, 0);
        {
            const u16* base = P + (size_t)TIME_ROW(seg, lrow, dir, b) * EV_N + h * 128 + lch;
            rk = *(const uint4*)(base + 512 + dir * 512); rv = *(const uint4*)(base + 1536); if (PASS == 3) rq = *(const uint4*)(base);
        }
        for (int chunk = 0; chunk < LSEG / 32; ++chunk) {
            float k1f[8], qf[8], vf[8];
            UNPACK8_H(rk, k1f); UNPACK8_BF(rv, vf); UNPACK8_BF(rq, qf);
            lbar();
            {
                float lg[8];
#pragma unroll
                for (int e = 0; e < 8; ++e) lg[e] = fmaxf(__logf(1.f - k1f[e]), -30.f);
                ST8F(Lb + lrow * 128 + lch, lg);
                *(uint4*)(Lk1h + lrow * 128 + lch) = rk; *(uint4*)(Lvh + lrow * 128 + lch) = rv;
            }
            if (chunk + 1 < LSEG / 32) {
                const u16* base = P + (size_t)TIME_ROW(seg, (chunk + 1) * 32 + lrow, dir, b) * EV_N + h * 128 + lch;
                rk = *(const uint4*)(base + 512 + dir * 512); rv = *(const uint4*)(base + 1536); if (PASS == 3) rq = *(const uint4*)(base);
            }
            lbar();
            {
                const int k = tid & 127, tg = tid >> 7;
                float c8[8]; float run = 0.f;
#pragma unroll
                for (int i = 0; i < 8; ++i) { run += Lb[(tg * 8 + i) * 128 + k]; c8[i] = run; }
                Lpart[tg * 128 + k] = run;
                lbar();
                float off = 0.f;
#pragma unroll
                for (int g2 = 0; g2 < 3; ++g2) off += (g2 < tg) ? Lpart[g2 * 128 + k] : 0.f;
#pragma unroll
                for (int i = 0; i < 8; ++i) Lb[(tg * 8 + i) * 128 + k] = c8[i] + off;
                if (tg == 3) { Ldec[k] = c8[7] + off; ltot += c8[7] + off; }
            }
            lbar();
            {
                float bb[8], bt[8], o1[8], o2[8];
                { const float4 x0 = *(const float4*)(Lb + lrow * 128 + lch), x1 = *(const float4*)(Lb + lrow * 128 + lch + 4); bb[0] = x0.x; bb[1] = x0.y; bb[2] = x0.z; bb[3] = x0.w; bb[4] = x1.x; bb[5] = x1.y; bb[6] = x1.z; bb[7] = x1.w; }
                { const float4 x0 = *(const float4*)(Ldec + lch), x1 = *(const float4*)(Ldec + lch + 4); bt[0] = x0.x; bt[1] = x0.y; bt[2] = x0.z; bt[3] = x0.w; bt[4] = x1.x; bt[5] = x1.y; bt[6] = x1.z; bt[7] = x1.w; }
                if (PASS == 3) {
#pragma unroll
                    for (int e = 0; e < 8; ++e) { o1[e] = qf[e] * __expf(bb[e]); o2[e] = k1f[e] * __expf(fminf(-bb[e], 80.f)); }
                    *(uint4*)(Qs + lrow * 136 + lch) = PACK8_BF(o1);
                    *(uint4*)(Kp + lrow * 136 + lch) = PACK8_BF(o2);
                }
            }
            {
                const int k = tid & 127, tq = tid >> 7; const float btk = Ldec[k];
                float o[8]; unsigned vb[8];
#pragma unroll
                for (int e = 0; e < 8; ++e) { const int t = tq * 8 + e; o[e] = h2f(Lk1h[t * 128 + k]) * __expf(btk - Lb[t * 128 + k]); vb[e] = Lvh[t * 128 + k]; }
                *(uint4*)(Kt + k * 40 + tq * 8) = PACK8_BF(o);
                *(uint4*)(Vt + k * 40 + tq * 8) = make_uint4(vb[0] | (vb[1] << 16), vb[2] | (vb[3] << 16), vb[4] | (vb[5] << 16), vb[6] | (vb[7] << 16));
            }
            lbar();
            f32x4 o0 = {0.f, 0.f, 0.f, 0.f}, o1v = {0.f, 0.f, 0.f, 0.f};
            if (PASS == 3) {
#pragma unroll
                for (int ks = 0; ks < 4; ++ks) {
                    const bf16x8_t bf = ldfrag(St, 136, wave * 16, ks * 32, lane);
                    o0 = mma16(ldfrag(Qs, 136, 0, ks * 32, lane), bf, o0);
                    o1v = mma16(ldfrag(Qs, 136, 16, ks * 32, lane), bf, o1v);
                }
                if (wave < 4) {
                    const int ti = wave >> 1, si = wave & 1;
                    f32x4 am = {0.f, 0.f, 0.f, 0.f};
#pragma unroll
                    for (int ks = 0; ks < 4; ++ks) am = mma16(ldfrag(Qs, 136, ti * 16, ks * 32, lane), ldfrag(Kp, 136, si * 16, ks * 32, lane), am);
#pragma unroll
                    for (int r = 0; r < 4; ++r) { const int t = ti * 16 + lq * 4 + r, s = si * 16 + l15; Pm[t * 40 + s] = (u16)f2bf(s <= t ? am[r] : 0.f); }
                }
            }
            lbar();
            if (PASS == 3) {
                const bf16x8_t bf = ldfrag(Vt, 40, wave * 16, 0, lane);
                o0 = mma16(ldfrag(Pm, 40, 0, 0, lane), bf, o0);
                o1v = mma16(ldfrag(Pm, 40, 16, 0, lane), bf, o1v);
#pragma unroll
                for (int r = 0; r < 4; ++r) { Ob[(lq * 4 + r) * 128 + wave * 16 + l15] = (u16)f2bf(o0[r]); Ob[(16 + lq * 4 + r) * 128 + wave * 16 + l15] = (u16)f2bf(o1v[r]); }
            }
            {
                float d4[4];
#pragma unroll
                for (int r = 0; r < 4; ++r) d4[r] = __expf(Ldec[wave * 16 + lq * 4 + r]);
                const bf16x8_t af = ldfrag(Kt, 40, wave * 16, 0, lane);
#pragma unroll
                for (int vt = 0; vt < 8; ++vt) {
#pragma unroll
                    for (int r = 0; r < 4; ++r) S[vt][r] *= d4[r];
                    S[vt] = mma16(af, ldfrag(Vt, 40, vt * 16, 0, lane), S[vt]);
                }
                if (PASS == 3) {
#pragma unroll
                    for (int vt = 0; vt < 8; ++vt) *(uint2*)(St + (vt * 16 + l15) * 136 + wave * 16 + lq * 4) = make_uint2(pk2(S[vt][0], S[vt][1]), pk2(S[vt][2], S[vt][3]));
                }
            }
            if (PASS == 3) {
                lbar();
                const uint4 ov = *(const uint4*)(Ob + lrow * 128 + lch);
                *(uint4*)(AO + (size_t)TIME_ROW(seg, chunk * 32 + lrow, dir, b) * 512 + h * 128 + lch) = ov;
            }
        }
        if (PASS == 1) {
#pragma unroll
            for (int vt = 0; vt < 8; ++vt)
#pragma unroll
                for (int r = 0; r < 4; ++r) LC[(size_t)unit * 16384 + (wave * 16 + lq * 4 + r) * 128 + vt * 16 + l15] = S[vt][r];
            if (tid >= 384) DEC[unit * 128 + (tid & 127)] = __expf(ltot);
        }
    }
    lbar();
}

template <int PASS>
__device__ __forceinline__ void m2_mma(const Params& p, int j, unsigned char* lds) {
    const int tid = otid(), lane = tid & 63, wave = tid >> 6, l15 = lane & 15, lq = lane >> 4;
    constexpr int UB = 61184;
#define M2_QS(uu)  ((u16*)(lds + (uu) * UB))
#define M2_KP(uu)  (M2_QS(uu) + 32 * 136)
#define M2_KT(uu)  (M2_KP(uu) + 32 * 136)
#define M2_VT(uu)  (M2_KT(uu) + 128 * 40)
#define M2_PM(uu)  (M2_VT(uu) + 64 * 40)
#define M2_ST(uu)  (M2_PM(uu) + 32 * 40)
#define M2_OB(uu)  (M2_ST(uu) + 64 * 136)
#define M2_LAC(uu) ((float*)(M2_OB(uu) + 32 * 64))
#define M2_LDT(uu) (M2_LAC(uu) + 32)
#define M2_LXH(uu) ((u16*)(M2_LDT(uu) + 32))
    const u16* XB = (const u16*)(WSP(p) + EV_XBC);
    const float* DT = (const float*)(WSP(p) + EV_DT);
    float* LC = (float*)(WSP(p) + EV_BLC); float* DEC = (float*)(WSP(p) + EV_BDEC);
    const int xrow = (tid & 255) >> 3, xch = (tid & 7) * 8, brow = tid >> 4, bch = (tid & 15) * 8;
    const int ti = wave >> 2, pi = wave & 3;
    for (int up = obid(); up < 256; up += gridDim.x) {
        const int unit0 = up * 2;
        const int hd = (unit0 >> 4) & 7, b = (unit0 >> 7) & 1, dir = unit0 >> 8, g = hd >> 2, seg0 = unit0 & 15;
        u16* YO = (u16*)(WSP(p) + (dir ? EV_BYB : EV_BYF));
        const float a = -__expf(INP(p, I_M2ALOG)[(j * 2 + dir) * 8 + hd]);
        f32x4 S[2][4];
        __syncthreads();
#pragma unroll
        for (int uu = 0; uu < 2; ++uu) {
#pragma unroll
            for (int pt = 0; pt < 4; ++pt)
#pragma unroll
                for (int r = 0; r < 4; ++r) S[uu][pt][r] = (PASS == 1) ? 0.f : LC[(size_t)(unit0 + uu) * 8192 + (wave * 16 + lq * 4 + r) * 64 + pt * 16 + l15];
            if (PASS == 3) {
#pragma unroll
                for (int pt = 0; pt < 4; ++pt) *(uint2*)(M2_ST(uu) + (pt * 16 + l15) * 136 + wave * 16 + lq * 4) = make_uint2(pk2(S[uu][pt][0], S[uu][pt][1]), pk2(S[uu][pt][2], S[uu][pt][3]));
            }
        }
        float dsum0 = 0.f, dsum1 = 0.f;
        uint4 rx0, rx1, rb0, rb1, rc0, rc1; float rdt0, rdt1;
#define M2_LOAD1(sg, s0, RX, RB, RC, RDT) do { RX = make_uint4(0, 0, 0, 0); RC = make_uint4(0, 0, 0, 0); RDT = 0.f; \
            if (tid < 256) RX = *(const uint4*)(XB + (size_t)TIME_ROW(sg, (s0) + xrow, dir, b) * 1024 + hd * 64 + xch); \
            { const u16* base = XB + (size_t)TIME_ROW(sg, (s0) + brow, dir, b) * 1024 + 512 + g * 128 + bch; \
              RB = *(const uint4*)base; if (PASS == 3) RC = *(const uint4*)(base + 256); } \
            if (tid < 64) RDT = DT[(size_t)TIME_ROW(sg, (s0) + (tid & 31), dir, b) * 16 + dir * 8 + hd]; } while (0)
#define M2_LOAD(s0) do { M2_LOAD1(seg0, s0, rx0, rb0, rc0, rdt0); M2_LOAD1(seg0 + 1, s0, rx1, rb1, rc1, rdt1); } while (0)
        M2_LOAD(0);
        for (int chunk = 0; chunk < LSEG / 32; ++chunk) {
            lbar();
#pragma unroll
            for (int uu = 0; uu < 2; ++uu) {
                if (tid < 64) {
                    float val = (uu ? rdt1 : rdt0) * a;
#pragma unroll
                    for (int off = 1; off < 32; off <<= 1) { const float t = __builtin_bit_cast(float, __builtin_amdgcn_ds_bpermute((lane - off) << 2, __builtin_bit_cast(int, val))); if ((lane & 31) >= off) val += t; }
                    if (tid < 32) { M2_LAC(uu)[tid] = val; M2_LDT(uu)[tid] = (uu ? rdt1 : rdt0); }
                }
                if (PASS == 3) *(uint4*)(M2_QS(uu) + brow * 136 + bch) = (uu ? rc1 : rc0);
                *(uint4*)(M2_KP(uu) + brow * 136 + bch) = (uu ? rb1 : rb0);
                if (tid < 256) *(uint4*)(M2_LXH(uu) + xrow * 64 + xch) = (uu ? rx1 : rx0);
            }
            if (chunk + 1 < LSEG / 32) M2_LOAD((chunk + 1) * 32);
            lbar();
#pragma unroll
            for (int uu = 0; uu < 2; ++uu) {
                const int n = tid & 127, tq = tid >> 7; const float acC = M2_LAC(uu)[31];
                float o[8];
#pragma unroll
                for (int e = 0; e < 8; ++e) { const int t = tq * 8 + e; o[e] = bf2f(M2_KP(uu)[t * 136 + n]) * __expf(acC - M2_LAC(uu)[t]); }
                *(uint4*)(M2_KT(uu) + n * 40 + tq * 8) = PACK8_BF(o);
                if (tid < 256) {
                    const int pp = tid & 63, tq2 = tid >> 6;
#pragma unroll
                    for (int e = 0; e < 8; ++e) { const int t = tq2 * 8 + e; o[e] = bf2f(M2_LXH(uu)[t * 64 + pp]) * M2_LDT(uu)[t]; }
                    *(uint4*)(M2_VT(uu) + pp * 40 + tq2 * 8) = PACK8_BF(o);
                }
            }
            lbar();
            f32x4 o[2];
#pragma unroll
            for (int uu = 0; uu < 2; ++uu) {
                o[uu] = (f32x4){0.f, 0.f, 0.f, 0.f};
                if (PASS == 3) {
#pragma unroll
                    for (int ks = 0; ks < 4; ++ks) o[uu] = mma16(ldfrag(M2_QS(uu), 136, ti * 16, ks * 32, lane), ldfrag(M2_ST(uu), 136, pi * 16, ks * 32, lane), o[uu]);
#pragma unroll
                    for (int r = 0; r < 4; ++r) o[uu][r] *= __expf(M2_LAC(uu)[ti * 16 + lq * 4 + r]);
                }
            }
            if (PASS == 3) {
                const int uu = wave >> 2, w4 = wave & 3, t2 = w4 >> 1, si = w4 & 1;
                f32x4 am = {0.f, 0.f, 0.f, 0.f};
#pragma unroll
                for (int ks = 0; ks < 4; ++ks) am = mma16(ldfrag(M2_QS(uu), 136, t2 * 16, ks * 32, lane), ldfrag(M2_KP(uu), 136, si * 16, ks * 32, lane), am);
#pragma unroll
                for (int r = 0; r < 4; ++r) { const int t = t2 * 16 + lq * 4 + r, s2 = si * 16 + l15; M2_PM(uu)[t * 40 + s2] = (u16)f2bf(s2 <= t ? am[r] * __expf(M2_LAC(uu)[t] - M2_LAC(uu)[s2]) : 0.f); }
            }
            lbar();
#pragma unroll
            for (int uu = 0; uu < 2; ++uu) {
                if (PASS == 3) {
                    o[uu] = mma16(ldfrag(M2_PM(uu), 40, ti * 16, 0, lane), ldfrag(M2_VT(uu), 40, pi * 16, 0, lane), o[uu]);
#pragma unroll
                    for (int r = 0; r < 4; ++r) M2_OB(uu)[(ti * 16 + lq * 4 + r) * 64 + pi * 16 + l15] = (u16)f2bf(o[uu][r]);
                }
                const float acC = M2_LAC(uu)[31], dec = __expf(acC);
                if (uu) dsum1 += acC; else dsum0 += acC;
                const bf16x8_t af = ldfrag(M2_KT(uu), 40, wave * 16, 0, lane);
#pragma unroll
                for (int pt = 0; pt < 4; ++pt) {
#pragma unroll
                    for (int r = 0; r < 4; ++r) S[uu][pt][r] *= dec;
                    S[uu][pt] = mma16(af, ldfrag(M2_VT(uu), 40, pt * 16, 0, lane), S[uu][pt]);
                }
                if (PASS == 3) {
#pragma unroll
                    for (int pt = 0; pt < 4; ++pt) *(uint2*)(M2_ST(uu) + (pt * 16 + l15) * 136 + wave * 16 + lq * 4) = make_uint2(pk2(S[uu][pt][0], S[uu][pt][1]), pk2(S[uu][pt][2], S[uu][pt][3]));
                }
            }
            if (PASS == 3) {
                lbar();
                {
                    const int uu = tid >> 8;
                    const uint4 ov = *(const uint4*)(M2_OB(uu) + xrow * 64 + xch);
                    *(uint4*)(YO + (size_t)TIME_ROW(seg0 + uu, chunk * 32 + xrow, dir, b) * 512 + hd * 64 + xch) = ov;
                }
            }
        }
#undef M2_LOAD
#undef M2_LOAD1
        if (PASS == 1) {
#pragma unroll
            for (int uu = 0; uu < 2; ++uu) {
#pragma unroll
                for (int pt = 0; pt < 4; ++pt)
#pragma unroll
                    for (int r = 0; r < 4; ++r) LC[(size_t)(unit0 + uu) * 8192 + (wave * 16 + lq * 4 + r) * 64 + pt * 16 + l15] = S[uu][pt][r];
                if (tid == 0) DEC[unit0 + uu] = __expf(uu ? dsum1 : dsum0);
            }
        }
    }
    __syncthreads();
}

__device__ __forceinline__ void even_carry(const Params& p) {
    const int gt = obid() * 512 + otid(), gs = gridDim.x * 512;
    float* LA = (float*)(WSP(p) + EV_ALC); const float* DA = (const float*)(WSP(p) + EV_ADEC);
    for (int e = gt; e < 16 * 16384; e += gs) {
        const int seq = e >> 14, kv = e & 16383, k = kv >> 7;
        float t[NSEG], d[NSEG];
#pragma unroll
        for (int s = 0; s < NSEG; ++s) { t[s] = LA[(size_t)(seq * 16 + s) * 16384 + kv]; d[s] = DA[(seq * 16 + s) * 128 + k]; }
        float carry = 0.f;
#pragma unroll
        for (int s = 0; s < NSEG; ++s) { const float nc = fmaf(d[s], carry, t[s]); t[s] = carry; carry = nc; }
#pragma unroll
        for (int s = 0; s < NSEG; ++s) LA[(size_t)(seq * 16 + s) * 16384 + kv] = t[s];
    }
    float* LB = (float*)(WSP(p) + EV_BLC); const float* DB = (const float*)(WSP(p) + EV_BDEC);
    for (int e = gt; e < 32 * 8192; e += gs) {
        const int seq = e >> 13, pn = e & 8191;
        float t[NSEG], d[NSEG];
#pragma unroll
        for (int s = 0; s < NSEG; ++s) { t[s] = LB[(size_t)(seq * 16 + s) * 8192 + pn]; d[s] = DB[seq * 16 + s]; }
        float carry = 0.f;
#pragma unroll
        for (int s = 0; s < NSEG; ++s) { const float nc = fmaf(d[s], carry, t[s]); t[s] = carry; carry = nc; }
#pragma unroll
        for (int s = 0; s < NSEG; ++s) LB[(size_t)(seq * 16 + s) * 8192 + pn] = t[s];
    }
}

__device__ __forceinline__ void even_conv(const Params& p, int j) {
    const int gt = obid() * 512 + otid(), gs = gridDim.x * 512;
    const u16* P = (const u16*)(WSP(p) + WS_P); u16* XB = (u16*)(WSP(p) + EV_XBC);
    const float* cw = INP(p, I_M2CW) + (size_t)j * 5 * 1024; const float* cb = INP(p, I_M2CB) + (size_t)j * 1024;
    for (int e = gt; e < (T_TOK / 16) * 128; e += gs) {
        const int ch = (e & 127) * 8, row0 = (e >> 7) * 16, tpos0 = row0 & (SEQ - 1);
        float w[5][8], bias[8];
#pragma unroll
        for (int jj = 0; jj < 5; ++jj) { const float4 a = *(const float4*)(cw + jj * 1024 + ch), b2 = *(const float4*)(cw + jj * 1024 + ch + 4); w[jj][0] = a.x; w[jj][1] = a.y; w[jj][2] = a.z; w[jj][3] = a.w; w[jj][4] = b2.x; w[jj][5] = b2.y; w[jj][6] = b2.z; w[jj][7] = b2.w; }
        { const float4 a = *(const float4*)(cb + ch), b2 = *(const float4*)(cb + ch + 4); bias[0] = a.x; bias[1] = a.y; bias[2] = a.z; bias[3] = a.w; bias[4] = b2.x; bias[5] = b2.y; bias[6] = b2.z; bias[7] = b2.w; }
        uint4 xr[20];
#pragma unroll
        for (int q = 0; q < 20; ++q) {
            const int tt = tpos0 + q - 2;
            xr[q] = make_uint4(0, 0, 0, 0);
            if (tt >= 0 && tt < SEQ) xr[q] = *(const uint4*)(P + (size_t)(row0 + q - 2) * EV_N + 3072 + ch);
        }
#pragma unroll
        for (int t = 0; t < 16; ++t) {
            float x0[8], x1[8], x2[8], x3[8], x4[8];
            UNPACK8_BF(xr[t], x0); UNPACK8_BF(xr[t + 1], x1); UNPACK8_BF(xr[t + 2], x2); UNPACK8_BF(xr[t + 3], x3); UNPACK8_BF(xr[t + 4], x4);
            float acc[8];
#pragma unroll
            for (int i = 0; i < 8; ++i) {
                float a = bias[i];
                a = fmaf(x0[i], w[0][i], a); a = fmaf(x1[i], w[1][i], a); a = fmaf(x2[i], w[2][i], a); a = fmaf(x3[i], w[3][i], a); a = fmaf(x4[i], w[4][i], a);
                acc[i] = siluf_(a);
            }
            *(uint4*)(XB + (size_t)(row0 + t) * 1024 + ch) = PACK8_BF(acc);
        }
    }
}

__device__ __forceinline__ void even_dt(const Params& p, int j, unsigned char* lds) {
    const int tid = otid(), lane = tid & 63, l15 = lane & 15, lq = lane >> 4, gw = obid() * 8 + (tid >> 6), nw = gridDim.x * 8;
    u16* Wt = (u16*)lds;
    const float* W = INP(p, I_EVIN) + (size_t)j * DM * 4112 + 4096;
    const u16* XA = (const u16*)(WSP(p) + WS_XA); float* DT = (float*)(WSP(p) + EV_DT);
    __syncthreads();
    {
        float tmp[32];
#pragma unroll
        for (int q = 0; q < 32; ++q) { const int idx = tid + 512 * q; tmp[q] = W[(size_t)(idx >> 4) * 4112 + (idx & 15)]; }
#pragma unroll
        for (int q = 0; q < 32; ++q) { const int idx = tid + 512 * q; Wt[(idx & 15) * 1032 + (idx >> 4)] = (u16)f2bf(tmp[q]); }
    }
    __syncthreads();
    const float bias = INP(p, I_M2DTB)[j * 16 + l15];
    for (int tile = gw; tile < T_TOK / 16; tile += nw) {
        const u16* arow = XA + (size_t)(tile * 16 + l15) * DM + 8 * lq;
        f32x4 acc = {0.f, 0.f, 0.f, 0.f};
#pragma unroll 8
        for (int ks = 0; ks < 32; ++ks) acc = mma16(*(const bf16x8_t*)(arow + ks * 32), ldfrag(Wt, 1032, 0, ks * 32, lane), acc);
#pragma unroll
        for (int r = 0; r < 4; ++r) DT[(size_t)(tile * 16 + lq * 4 + r) * 16 + l15] = softplusf_(acc[r] + bias);
    }
    __syncthreads();
}

__device__ __forceinline__ void even_post(const Params& p, int j) {
    const int lane = otid() & 63, gw = obid() * 8 + (otid() >> 6), nw = gridDim.x * 8;
    const u16* P = (const u16*)(WSP(p) + WS_P); const u16* XB = (const u16*)(WSP(p) + EV_XBC);
    const u16* AOF = (const u16*)(WSP(p) + EV_AOF); const u16* AOB = (const u16*)(WSP(p) + EV_AOB);
    const u16* BYF = (const u16*)(WSP(p) + EV_BYF); const u16* BYB = (const u16*)(WSP(p) + EV_BYB);
    u16* O = (u16*)(WSP(p) + WS_XA);
    const int c = lane * 8;
    float hnw[8], mnw[8];
#pragma unroll
    for (int i = 0; i < 8; ++i) { hnw[i] = INP(p, I_HGNW)[j * 128 + ((c + i) & 127)]; mnw[i] = INP(p, I_M2NW)[j * 512 + c + i]; }
    const float dsk = INP(p, I_M2D)[j * 8 + (lane >> 3)];
    for (int rowb = gw * 2; rowb < T_TOK; rowb += nw * 2) {
        uint4 q[2][7];
#pragma unroll
        for (int r = 0; r < 2; ++r) {
            const size_t row = rowb + r;
            q[r][0] = *(const uint4*)(AOF + row * 512 + c); q[r][1] = *(const uint4*)(AOB + row * 512 + c); q[r][2] = *(const uint4*)(P + row * EV_N + 2048 + c);
            q[r][3] = *(const uint4*)(BYF + row * 512 + c); q[r][4] = *(const uint4*)(BYB + row * 512 + c); q[r][5] = *(const uint4*)(XB + row * 1024 + c); q[r][6] = *(const uint4*)(P + row * EV_N + 2560 + c);
        }
#pragma unroll
        for (int r = 0; r < 2; ++r) {
            const size_t row = rowb + r;
            float a[8], t[8], o[8];
            UNPACK8_BF(q[r][0], a); UNPACK8_BF(q[r][1], t);
            float ss = 0.f;
#pragma unroll
            for (int i = 0; i < 8; ++i) { a[i] += t[i]; ss += a[i] * a[i]; }
            ss = red16(ss);
            float rs = rsqrtf(ss * (1.f / 128.f) + 1e-6f);
            UNPACK8_BF(q[r][2], t);
#pragma unroll
            for (int i = 0; i < 8; ++i) o[i] = a[i] * rs * hnw[i] * t[i];
            *(uint4*)(O + row * DM + c) = PACK8_BF(o);
            UNPACK8_BF(q[r][3], a); UNPACK8_BF(q[r][4], t);
#pragma unroll
            for (int i = 0; i < 8; ++i) a[i] += t[i];
            UNPACK8_BF(q[r][5], t);
#pragma unroll
            for (int i = 0; i < 8; ++i) a[i] = fmaf(t[i], dsk, a[i]);
            UNPACK8_BF(q[r][6], t);
            ss = 0.f;
#pragma unroll
            for (int i = 0; i < 8; ++i) { a[i] *= t[i]; ss += a[i] * a[i]; }
            ss = red32(ss);
            rs = rsqrtf(ss * (1.f / 256.f) + 1e-6f);
#pragma unroll
            for (int i = 0; i < 8; ++i) o[i] = a[i] * rs * mnw[i];
            *(uint4*)(O + row * DM + 512 + c) = PACK8_BF(o);
        }
    }
}

__device__ __forceinline__ void odd_shift(const Params& p, int j) {
    const int lane = otid() & 63, gw = obid() * 8 + (otid() >> 6), nw = gridDim.x * 8;
    const u16* P = (const u16*)(WSP(p) + WS_P);
    const float* mu0 = INP(p, I_MU) + (size_t)(j * 2 + 0) * RWIN; const float* mu1 = INP(p, I_MU) + (size_t)(j * 2 + 1) * RWIN;
    u16* R = (u16*)(WSP(p) + OD_R); u16* V = (u16*)(WSP(p) + OD_V); u16* KK = (u16*)(WSP(p) + OD_KK); u16* KP = (u16*)(WSP(p) + OD_KP);
    u16* XL = (u16*)(WSP(p) + OD_XL); u16* A1 = (u16*)(WSP(p) + OD_A1);
    float kkw[8];
#pragma unroll
    for (int e = 0; e < 8; ++e) kkw[e] = INP(p, I_KK)[j * 512 + lane * 8 + e];
    for (int row = gw; row < T_TOK; row += nw) {
        const int tpos = row & (SEQ - 1);
        unsigned zz = 0; asm volatile("" : "+v"(zz));
        const u16* pc = P + (size_t)row * OD_N;
        uint4 cv[4], pv[4], nv[4];
#pragma unroll
        for (int i = 0; i < 4; ++i) {
            const int o = lane + 64 * i;
            cv[i] = make_uint4(zz, zz, zz, zz); pv[i] = cv[i]; nv[i] = cv[i];
            if (o < 220) { cv[i] = *(const uint4*)(pc + o * 8); if (tpos > 0) pv[i] = *(const uint4*)(pc - OD_N + o * 8); if (tpos < SEQ - 1) nv[i] = *(const uint4*)(pc + OD_N + o * 8); }
        }
        const uint4 uv = *(const uint4*)(pc + RWIN + lane * 8);
#pragma unroll
        for (int i = 0; i < 4; ++i) {
            const int o = lane + 64 * i, col = o * 8;
            if (o < 220) {
                float c8[8], p8[8], n8[8], m0[8], m1[8], sh[8];
                UNPACK8_BF(cv[i], c8); UNPACK8_BF(pv[i], p8); UNPACK8_BF(nv[i], n8);
                { const float4 a = *(const float4*)(mu0 + col), b2 = *(const float4*)(mu0 + col + 4); m0[0] = a.x; m0[1] = a.y; m0[2] = a.z; m0[3] = a.w; m0[4] = b2.x; m0[5] = b2.y; m0[6] = b2.z; m0[7] = b2.w; }
                { const float4 a = *(const float4*)(mu1 + col), b2 = *(const float4*)(mu1 + col + 4); m1[0] = a.x; m1[1] = a.y; m1[2] = a.z; m1[3] = a.w; m1[4] = b2.x; m1[5] = b2.y; m1[6] = b2.z; m1[7] = b2.w; }
#pragma unroll
                for (int e = 0; e < 8; ++e) sh[e] = c8[e] + (p8[e] - c8[e]) * m0[e] + (n8[e] - c8[e]) * m1[e];
                if (i == 0) *(uint4*)(R + (size_t)row * 512 + col) = PACK8_BF(sh);
                else if (i == 1) {
                    *(uint4*)(KP + (size_t)row * 512 + col - 512) = PACK8_BF(sh);
                    float ss = 0.f;
#pragma unroll
                    for (int e = 0; e < 8; ++e) { sh[e] *= kkw[e]; ss += sh[e] * sh[e]; }
                    ss = red8(ss);
                    const float inv = 1.f / fmaxf(sqrtf(ss), 1e-12f);
#pragma unroll
                    for (int e = 0; e < 8; ++e) sh[e] *= inv;
                    *(uint4*)(KK + (size_t)row * 512 + col - 512) = PACK8_BF(sh);
                } else if (i == 2) *(uint4*)(V + (size_t)row * 512 + col - 1024) = PACK8_BF(sh);
                else {
                    const int cc = col - 1536;
#pragma unroll
                    for (int e = 0; e < 8; ++e) sh[e] = (cc < 64) ? tanhf_(sh[e]) : ((cc >= 128) ? sigmoidf_(sh[e]) : sh[e]);
                    *(uint4*)(XL + (size_t)row * 256 + cc) = PACK8_BF(sh);
                }
            } else if (o < 224) *(uint4*)(XL + (size_t)row * 256 + (o - 192) * 8) = make_uint4(zz, zz, zz, zz);
        }
        { const int c = lane * 8; *(uint4*)(A1 + ((size_t)(c >> 4) * 1024 + (row >> 13) * 512 + (tpos >> 4)) * 512 + (tpos & 15) * 16 + (c & 15)) = uv; }
    }
}
__device__ __forceinline__ void build_lora_weight(const Params& p, int j) {
    u16* BT = (u16*)(WSP(p) + OD_BTL);
    const float* w2 = INP(p, I_W2) + (size_t)j * 2 * 32 * 512; const float* a2 = INP(p, I_A2) + (size_t)j * 2 * 32 * 512; const float* g2 = INP(p, I_G2) + (size_t)j * 96 * 512;
    for (int e = obid() * 512 + otid(); e < 2560 * 32; e += gridDim.x * 512) {
        const int n = e % 2560, ko = e / 2560, k0 = ko * 8, reg = n >> 9, c = n & 511;
        float o[8];
#pragma unroll
        for (int q = 0; q < 8; ++q) {
            const int k = k0 + q; float v = 0.f;
            if (reg < 4) { if (k >= reg * 32 && k < reg * 32 + 32) v = ((reg < 2) ? w2 : a2)[((reg & 1) * 32 + (k - reg * 32)) * 512 + c]; }
            else if (k >= 128 && k < 224) v = g2[(k - 128) * 512 + c];
            o[q] = v;
        }
        *(uint4*)(BT + (size_t)n * 256 + k0) = PACK8_BF(o);
    }
}
struct EpiLora {
    static constexpr bool PERM = true, AFTER_DRAIN = false;
    unsigned char* ws; const float* w0; const float* a0;
    __device__ __forceinline__ void operator()(const f32x4 (&acc)[2][2][4][2], const pg8::Unit& u, int wr, int wc, int fr, int fq) const {
        const int reg = u.pn >> 1, row0 = u.pm * 256 + wr * 64 + fr, c0 = (u.pn & 1) * 256 + wc * 32 + 8 * fq;
        if (reg < 2) {
            u16* dst = (u16*)(ws + (reg ? OD_WB1 : OD_WF1));
#pragma unroll
            for (int bj = 0; bj < 2; ++bj) {
                const int c = c0 + bj * 128;
                float bias[8];
#pragma unroll
                for (int e = 0; e < 8; ++e) bias[e] = w0[reg * 512 + c + e];
#pragma unroll
                for (int ai = 0; ai < 2; ++ai)
#pragma unroll
                    for (int m = 0; m < 4; ++m) {
                        float x[8];
#pragma unroll
                        for (int n = 0; n < 2; ++n)
#pragma unroll
                            for (int e = 0; e < 4; ++e) x[n * 4 + e] = 1.f - __expf(-0.6065306597f * sigmoidf_(acc[ai][bj][m][n][e] + bias[n * 4 + e]));
                        *(uint4*)(dst + (size_t)(row0 + ai * 128 + m * 16) * 512 + c) = PACK8_H(x);
                    }
            }
        } else if (reg < 4) {
            u16* dA = (u16*)(ws + (reg == 3 ? OD_AB : OD_AF));
#pragma unroll
            for (int bj = 0; bj < 2; ++bj) {
                const int c = c0 + bj * 128;
                float bias[8];
#pragma unroll
                for (int e = 0; e < 8; ++e) bias[e] = a0[(reg & 1) * 512 + c + e];
#pragma unroll
                for (int ai = 0; ai < 2; ++ai)
#pragma unroll
                    for (int m = 0; m < 4; ++m) {
                        float x[8];
#pragma unroll
                        for (int n = 0; n < 2; ++n)
#pragma unroll
                            for (int e = 0; e < 4; ++e) x[n * 4 + e] = sigmoidf_(acc[ai][bj][m][n][e] + bias[n * 4 + e]);
                        *(uint4*)(dA + (size_t)(row0 + ai * 128 + m * 16) * 512 + c) = PACK8_BF(x);
                    }
            }
        } else {
            u16* dst = (u16*)(ws + OD_G);
#pragma unroll
            for (int ai = 0; ai < 2; ++ai)
#pragma unroll
                for (int m = 0; m < 4; ++m)
#pragma unroll
                    for (int bj = 0; bj < 2; ++bj) {
                        const f32x4 v0 = acc[ai][bj][m][0], v1 = acc[ai][bj][m][1];
                        *(uint4*)(dst + (size_t)(row0 + ai * 128 + m * 16) * 512 + c0 + bj * 128) = make_uint4(pk2(v0[0], v0[1]), pk2(v0[2], v0[3]), pk2(v1[0], v1[1]), pk2(v1[2], v1[3]));
                    }
        }
    }
};

template <int PASS>
__device__ __forceinline__ void rw_scan(const Params& p, unsigned char* lds) {
    const int tid = otid();
    constexpr int NTH = (PASS == 1) ? 512 : 256;
    const int half = (PASS == 1) ? 0 : (tid >> 8), lt = tid & (NTH - 1);
    float* base = (float*)lds + half * (6 * 2048 + 1024);
    float* Lkk = base; float* Lw = base + 2048; float* Lb = base + 4096; float* Lk = base + 6144; float* Lv = base + 8192; float* Lr = base + 10240;
    u16* Lo = (u16*)(base + 12288);
    const int row = lt >> 2, cg = lt & 3;
    const int lrow = (lt & 255) >> 3, lch = (lt & 7) * 8, lsel = (PASS == 1) ? (tid >> 8) : 0;
    float* LCs = (float*)(WSP(p) + OD_CLC); float* PM = (float*)(WSP(p) + OD_CPM);
    const int nitems = (PASS == 1) ? 512 : 256;
    for (int item = obid(); item < nitems; item += gridDim.x) {
        const int unit = (PASS == 1) ? item : item * 2 + half;
        const int seg = unit & 15, hd = (unit >> 4) & 7, b = (unit >> 7) & 1, dir = unit >> 8;
        const u16* aKK = (const u16*)(WSP(p) + OD_KK); const u16* aA = (const u16*)(WSP(p) + (dir ? OD_AB : OD_AF)); const u16* aV = (const u16*)(WSP(p) + OD_V);
        const u16* aK = (const u16*)(WSP(p) + (dir ? OD_KB : OD_KF)); const u16* aW = (const u16*)(WSP(p) + (dir ? OD_WB1 : OD_WF1)); const u16* aR = (const u16*)(WSP(p) + OD_R);
        u16* YO = (u16*)(WSP(p) + (dir ? OD_CYB : OD_CYF));
        float st[16];
        if (PASS == 1) {
#pragma unroll
            for (int e = 0; e < 16; ++e) st[e] = (row >= 64 && (row - 64) == cg * 16 + e) ? 1.f : 0.f;
        } else {
#pragma unroll
            for (int e = 0; e < 16; ++e) st[e] = LCs[(size_t)unit * 4096 + row * 64 + cg * 16 + e];
        }
        uint4 r0, r1, r2, r3 = make_uint4(0, 0, 0, 0), r4 = make_uint4(0, 0, 0, 0), r5 = make_uint4(0, 0, 0, 0);
#define RW_LOAD(s0) do { const size_t go = (size_t)TIME_ROW(seg, (s0) + lrow, dir, b) * 512 + hd * 64 + lch; \
        if (PASS == 1) { if (lsel == 0) { r0 = *(const uint4*)(aKK + go); r1 = *(const uint4*)(aA + go); r2 = *(const uint4*)(aV + go); } \
                         else { r0 = *(const uint4*)(aK + go); r1 = *(const uint4*)(aW + go); r2 = make_uint4(0, 0, 0, 0); } } \
        else { r0 = *(const uint4*)(aKK + go); r1 = *(const uint4*)(aA + go); r2 = *(const uint4*)(aV + go); r3 = *(const uint4*)(aK + go); r4 = *(const uint4*)(aW + go); r5 = *(const uint4*)(aR + go); } } while (0)
        RW_LOAD(0);
        for (int tile = 0; tile < LSEG / 32; ++tile) {
            __syncthreads();
            {
                float f[8], g8[8]; const int lo = lrow * 64 + lch;
                if (PASS == 1) {
                    if (lsel == 0) { UNPACK8_BF(r0, f); ST8F(Lkk + lo, f); UNPACK8_BF(r1, g8);
#pragma unroll
                        for (int e = 0; e < 8; ++e) g8[e] *= f[e];
                        ST8F(Lb + lo, g8); UNPACK8_BF(r2, f); ST8F(Lv + lo, f); }
                    else { UNPACK8_BF(r0, f); ST8F(Lk + lo, f); UNPACK8_H(r1, f);
#pragma unroll
                        for (int e = 0; e < 8; ++e) f[e] = 1.f - f[e];
                        ST8F(Lw + lo, f); }
                } else {
                    UNPACK8_BF(r0, f); ST8F(Lkk + lo, f); UNPACK8_BF(r1, g8);
#pragma unroll
                    for (int e = 0; e < 8; ++e) g8[e] *= f[e];
                    ST8F(Lb + lo, g8); UNPACK8_BF(r2, f); ST8F(Lv + lo, f);
                    UNPACK8_BF(r3, f); ST8F(Lk + lo, f); UNPACK8_H(r4, f);
#pragma unroll
                    for (int e = 0; e < 8; ++e) f[e] = 1.f - f[e];
                    ST8F(Lw + lo, f); UNPACK8_BF(r5, f); ST8F(Lr + lo, f);
                }
            }
            __syncthreads();
            if (tile + 1 < LSEG / 32) RW_LOAD((tile + 1) * 32);
            for (int s = 0; s < 32; ++s) {
                const float vv = (PASS == 1 && row >= 64) ? 0.f : Lv[s * 64 + (row & 63)];
                float4 kk4[4];
                float sa = 0.f;
#pragma unroll
                for (int q = 0; q < 4; ++q) {
                    kk4[q] = *(const float4*)(Lkk + s * 64 + cg * 16 + q * 4);
                    sa = fmaf(st[q * 4 + 0], kk4[q].x, sa); sa = fmaf(st[q * 4 + 1], kk4[q].y, sa); sa = fmaf(st[q * 4 + 2], kk4[q].z, sa); sa = fmaf(st[q * 4 + 3], kk4[q].w, sa);
                }
                sa = -red4(sa);
                float y = 0.f;
#pragma unroll
                for (int q = 0; q < 4; ++q) {
                    const float4 w4 = *(const float4*)(Lw + s * 64 + cg * 16 + q * 4), b4 = *(const float4*)(Lb + s * 64 + cg * 16 + q * 4), k4 = *(const float4*)(Lk + s * 64 + cg * 16 + q * 4);
                    st[q * 4 + 0] = fmaf(st[q * 4 + 0], w4.x, fmaf(sa, b4.x, vv * k4.x));
                    st[q * 4 + 1] = fmaf(st[q * 4 + 1], w4.y, fmaf(sa, b4.y, vv * k4.y));
                    st[q * 4 + 2] = fmaf(st[q * 4 + 2], w4.z, fmaf(sa, b4.z, vv * k4.z));
                    st[q * 4 + 3] = fmaf(st[q * 4 + 3], w4.w, fmaf(sa, b4.w, vv * k4.w));
                    if (PASS == 3) {
                        const float4 r4v = *(const float4*)(Lr + s * 64 + cg * 16 + q * 4);
                        y = fmaf(st[q * 4 + 0], r4v.x, y); y = fmaf(st[q * 4 + 1], r4v.y, y); y = fmaf(st[q * 4 + 2], r4v.z, y); y = fmaf(st[q * 4 + 3], r4v.w, y);
                    }
                }
                if (PASS == 3) { y = red4(y); if (cg == 0) Lo[s * 64 + row] = (u16)f2bf(y); }
            }
            if (PASS == 3) {
                __syncthreads();
                const uint4 ov = *(const uint4*)(Lo + lrow * 64 + lch);
                *(uint4*)(YO + (size_t)TIME_ROW(seg, tile * 32 + lrow, dir, b) * 512 + hd * 64 + lch) = ov;
            }
        }
#undef RW_LOAD
        if (PASS == 1) {
            float* dst = (row < 64) ? (LCs + (size_t)unit * 4096 + row * 64 + cg * 16) : (PM + (size_t)unit * 4096 + (row - 64) * 64 + cg * 16);
#pragma unroll
            for (int e = 0; e < 16; ++e) dst[e] = st[e];
        }
    }
    __syncthreads();
}


template <int PASS>
__device__ __forceinline__ void rw_mma(const Params& p, int jl, unsigned char* lds) {
    constexpr int NRT = (PASS == 1) ? 2 : 1, NST = (PASS == 1) ? 4 : 2;
    const int tid = otid(), lane = tid & 63, wave = tid >> 6, l15 = lane & 15, lq = lane >> 4;
    u16* At = (u16*)lds;
    u16* Rt = At + 32 * 72;
    u16* Bn = Rt + 32 * 72;
    u16* Kn = Bn + 32 * 72;
    u16* BhT = Kn + 32 * 72;
    u16* KhT = BhT + 64 * 40;
    u16* VT = KhT + 64 * 40;
    u16* Sb = VT + 128 * 40;
    u16* RhsT = Sb + 128 * 72;
    u16* SAT = RhsT + 128 * 40;
    u16* Mx = SAT + 128 * 40;
    u16* Mak = Mx; u16* Mrb = Mx + 1280; u16* Mrk = Mx + 2560;
    u16* Yb = Mx + 9 * 1280;
    float* Lc = (float*)(Yb + 2048);
    float* Lp = Lc + 2048;
    float* Ltot = Lp + 512;
    u16* Lkkh = (u16*)(Ltot + 64); u16* Lah = Lkkh + 2048; u16* Lkdh = Lah + 2048; u16* Lvh2 = Lkdh + 2048;
    float* LCs = (float*)(WSP(p) + OD_CLC); float* PM = (float*)(WSP(p) + OD_CPM);
    u16* TIG = (u16*)(WSP(p) + OD_TINV);
    const int et = tid >> 4, ech = (tid & 15) * 4;
    const int svt = (PASS == 1) ? wave : (wave >> 1), kt0 = (PASS == 1) ? 0 : (wave & 1) * 2;
    for (int unit = obid(); unit < 512; unit += gridDim.x) {
        const int seg = unit & 15, hd = (unit >> 4) & 7, b = (unit >> 7) & 1, dir = unit >> 8;
        const u16* aKK = (const u16*)(WSP(p) + OD_KK); const u16* aA = (const u16*)(WSP(p) + (dir ? OD_AB : OD_AF)); const u16* aV = (const u16*)(WSP(p) + OD_V);
        const u16* aK = (const u16*)(WSP(p) + OD_KP); const u16* aW = (const u16*)(WSP(p) + (dir ? OD_WB1 : OD_WF1)); const u16* aR = (const u16*)(WSP(p) + OD_R);
        u16* YO = (u16*)(WSP(p) + (dir ? OD_CYB : OD_CYF));
        const float4 ka4 = *(const float4*)(INP(p, I_KA) + jl * 512 + hd * 64 + ech); const float kag = INP(p, I_KA)[jl * 512 + hd * 64 + (tid & 63)];
        f32x4 S[NST];
        __syncthreads();
#pragma unroll
        for (int q = 0; q < NST; ++q)
#pragma unroll
            for (int r = 0; r < 4; ++r) {
                const int v = svt * 16 + lq * 4 + r, k = (kt0 + q) * 16 + l15;
                S[q][r] = (PASS == 1) ? ((v >= 64 && v - 64 == k) ? 1.f : 0.f) : LCs[(size_t)unit * 4096 + v * 64 + k];
                Sb[v * 72 + k] = (u16)f2bf(S[q][r]);
            }
        if (PASS == 1) { for (int e = tid; e < 64 * 40; e += 512) VT[64 * 40 + e] = 0; }
        uint2 r0, r1, r2, r3, r4, r5 = make_uint2(0, 0); uint4 rti = make_uint4(0, 0, 0, 0);
#define RWM_LOAD(s0) do { const size_t go = (size_t)TIME_ROW(seg, (s0) + et, dir, b) * 512 + hd * 64 + ech; \
        r0 = *(const uint2*)(aKK + go); r1 = *(const uint2*)(aA + go); r2 = *(const uint2*)(aV + go); r3 = *(const uint2*)(aK + go); r4 = *(const uint2*)(aW + go); if (PASS == 3) { r5 = *(const uint2*)(aR + go); if (tid < 160) rti = *(const uint4*)(TIG + ((size_t)unit * 16 + ((s0) >> 5)) * 1280 + tid * 8); } } while (0)
        RWM_LOAD(0);
        for (int chunk = 0; chunk < LSEG / 32; ++chunk) {
            float kk[4], ai[4], vv[4], kd[4], w1[4], rr[4];
            kk[0] = bf2f(r0.x & 0xffffu); kk[1] = bf2f(r0.x >> 16); kk[2] = bf2f(r0.y & 0xffffu); kk[3] = bf2f(r0.y >> 16);
            ai[0] = bf2f(r1.x & 0xffffu); ai[1] = bf2f(r1.x >> 16); ai[2] = bf2f(r1.y & 0xffffu); ai[3] = bf2f(r1.y >> 16);
            vv[0] = bf2f(r2.x & 0xffffu); vv[1] = bf2f(r2.x >> 16); vv[2] = bf2f(r2.y & 0xffffu); vv[3] = bf2f(r2.y >> 16);
            kd[0] = bf2f(r3.x & 0xffffu); kd[1] = bf2f(r3.x >> 16); kd[2] = bf2f(r3.y & 0xffffu); kd[3] = bf2f(r3.y >> 16);
            kd[0] *= 1.f + (ai[0] - 1.f) * ka4.x; kd[1] *= 1.f + (ai[1] - 1.f) * ka4.y; kd[2] *= 1.f + (ai[2] - 1.f) * ka4.z; kd[3] *= 1.f + (ai[3] - 1.f) * ka4.w;
            w1[0] = h2f(r4.x & 0xffffu); w1[1] = h2f(r4.x >> 16); w1[2] = h2f(r4.y & 0xffffu); w1[3] = h2f(r4.y >> 16);
            rr[0] = bf2f(r5.x & 0xffffu); rr[1] = bf2f(r5.x >> 16); rr[2] = bf2f(r5.y & 0xffffu); rr[3] = bf2f(r5.y >> 16);
            lbar();
            *(float4*)(Lc + et * 64 + ech) = make_float4(__logf(1.f - w1[0]), __logf(1.f - w1[1]), __logf(1.f - w1[2]), __logf(1.f - w1[3]));
            if (PASS == 3 && tid < 160) *(uint4*)(Mx + 3 * 1280 + tid * 8) = rti;
            *(uint2*)(Lkkh + et * 64 + ech) = r0; *(uint2*)(Lah + et * 64 + ech) = r1; *(uint2*)(Lvh2 + et * 64 + ech) = r2; *(uint2*)(Lkdh + et * 64 + ech) = r3;
            if (chunk + 1 < LSEG / 32) RWM_LOAD((chunk + 1) * 32);
            lbar();
            {
                const int k = tid & 63, tg = tid >> 6;
                float c4[4]; float run = 0.f;
#pragma unroll
                for (int i = 0; i < 4; ++i) { run += Lc[(tg * 4 + i) * 64 + k]; c4[i] = run; }
                Lp[tg * 64 + k] = run;
                lbar();
                float off = 0.f;
#pragma unroll
                for (int g2 = 0; g2 < 7; ++g2) off += (g2 < tg) ? Lp[g2 * 64 + k] : 0.f;
#pragma unroll
                for (int i = 0; i < 4; ++i) Lc[(tg * 4 + i) * 64 + k] = c4[i] + off;
                if (tg == 7) Ltot[k] = c4[3] + off;
            }
            lbar();
            {
                const float4 cu = *(const float4*)(Lc + et * 64 + ech);
                float4 cx = make_float4(0.f, 0.f, 0.f, 0.f); if (et > 0) cx = *(const float4*)(Lc + (et - 1) * 64 + ech);
                const float4 tt = *(const float4*)(Ltot + ech);
                const float cum[4] = {cu.x, cu.y, cu.z, cu.w}, cmx[4] = {cx.x, cx.y, cx.z, cx.w}, tot[4] = {tt.x, tt.y, tt.z, tt.w};
                float oa[4], orr[4], ob[4], ok[4];
#pragma unroll
                for (int e = 0; e < 4; ++e) {
                    const float bq = kk[e] * ai[e], einv = __expf(-cum[e]);
                    oa[e] = -kk[e] * __expf(cmx[e]); orr[e] = rr[e] * __expf(cum[e]); ob[e] = bq * einv; ok[e] = kd[e] * einv;
                }
                *(uint2*)(At + et * 72 + ech) = make_uint2(pk2(oa[0], oa[1]), pk2(oa[2], oa[3]));
                *(uint2*)(Bn + et * 72 + ech) = make_uint2(pk2(ob[0], ob[1]), pk2(ob[2], ob[3]));
                *(uint2*)(Kn + et * 72 + ech) = make_uint2(pk2(ok[0], ok[1]), pk2(ok[2], ok[3]));
                if (PASS == 3) *(uint2*)(Rt + et * 72 + ech) = make_uint2(pk2(orr[0], orr[1]), pk2(orr[2], orr[3]));
            }
            {
                const int k = tid & 63, tq = (tid >> 6) & 3, which = tid >> 8; const float tk = Ltot[k];
                float o[8]; unsigned vb[8];
#pragma unroll
                for (int e = 0; e < 8; ++e) {
                    const int t = tq * 8 + e; const float etot = __expf(tk - Lc[t * 64 + k]);
                    const float av = bf2f(Lah[t * 64 + k]);
                    o[e] = (which ? bf2f(Lkdh[t * 64 + k]) * (1.f + (av - 1.f) * kag) : bf2f(Lkkh[t * 64 + k]) * av) * etot; vb[e] = Lvh2[t * 64 + k];
                }
                *(uint4*)((which ? KhT : BhT) + k * 40 + tq * 8) = PACK8_BF(o);
                if (which == 0) *(uint4*)(VT + k * 40 + tq * 8) = make_uint4(vb[0] | (vb[1] << 16), vb[2] | (vb[3] << 16), vb[4] | (vb[5] << 16), vb[6] | (vb[7] << 16));
            }
            lbar();
            u16* Xc = Mx + 3 * 1280; u16* Xn = Mx + 4 * 1280; u16* Nc = Mx + 5 * 1280; u16* NcT = Mx + 6 * 1280; u16* Nn = Mx + 7 * 1280; u16* NnT = Mx + 8 * 1280;
            {
                const int mat = wave >> 1, ti = wave & 1;
                if ((PASS == 3 && mat > 0) || (PASS == 1 && mat < 2)) {
                    const u16* Aop = (mat < 2) ? At : Rt; const u16* Bop = (mat & 1) ? Kn : Bn;
                    const bf16x8_t a0 = ldfrag(Aop, 72, ti * 16, 0, lane), a1 = ldfrag(Aop, 72, ti * 16, 32, lane);
#pragma unroll
                    for (int si = 0; si < 2; ++si) {
                        f32x4 am = {0.f, 0.f, 0.f, 0.f};
                        am = mma16(a0, ldfrag(Bop, 72, si * 16, 0, lane), am); am = mma16(a1, ldfrag(Bop, 72, si * 16, 32, lane), am);
                        const int s = si * 16 + l15;
                        float mv[4];
#pragma unroll
                        for (int r = 0; r < 4; ++r) { const int t = ti * 16 + lq * 4 + r; mv[r] = ((mat < 2) ? (s < t) : (s <= t)) ? am[r] : 0.f; }
                        u16* dst = (mat == 0) ? Nc : (mat == 1) ? Mak : (mat == 2) ? Mrb : Mrk;
#pragma unroll
                        for (int r = 0; r < 4; ++r) dst[(ti * 16 + lq * 4 + r) * 40 + s] = (u16)f2bf(mv[r]);
                        if (mat == 0) {
                            *(uint2*)(NcT + s * 40 + ti * 16 + lq * 4) = make_uint2(pk2(mv[0], mv[1]), pk2(mv[2], mv[3]));
#pragma unroll
                            for (int r = 0; r < 4; ++r) { const int t = ti * 16 + lq * 4 + r; Xc[t * 40 + s] = (u16)f2bf(mv[r] + (t == s ? 1.f : 0.f)); }
                        }
                    }
                }
            }
            lbar();
            f32x4 yv[NRT];
            {
#pragma unroll
                for (int q = 0; q < NRT; ++q) {
                    const int tt = (PASS == 1) ? q : (wave >> 2), vt = (PASS == 1) ? wave : (wave & 3);
                    const bf16x8_t s0 = ldfrag(Sb, 72, vt * 16, 0, lane), s1 = ldfrag(Sb, 72, vt * 16, 32, lane);
                    f32x4 rh = {0.f, 0.f, 0.f, 0.f};
                    rh = mma16(ldfrag(At, 72, tt * 16, 0, lane), s0, rh); rh = mma16(ldfrag(At, 72, tt * 16, 32, lane), s1, rh);
                    rh = mma16(ldfrag(Mak, 40, tt * 16, 0, lane), ldfrag(VT, 40, vt * 16, 0, lane), rh);
                    *(uint2*)(RhsT + (vt * 16 + l15) * 40 + tt * 16 + lq * 4) = make_uint2(pk2(rh[0], rh[1]), pk2(rh[2], rh[3]));
                    yv[q] = (f32x4){0.f, 0.f, 0.f, 0.f};
                    if (PASS == 3) { yv[q] = mma16(ldfrag(Rt, 72, tt * 16, 0, lane), s0, yv[q]); yv[q] = mma16(ldfrag(Rt, 72, tt * 16, 32, lane), s1, yv[q]); }
                }
            }
            if (PASS == 1) {
#pragma unroll
            for (int rnd = 0; rnd < 5; ++rnd) {
                if (wave < 4) {
                    if (rnd > 0) {
                        const int ti = wave >> 1, si = wave & 1;
                        f32x4 x;
#pragma unroll
                        for (int r = 0; r < 4; ++r) x[r] = bf2f(Xc[(ti * 16 + lq * 4 + r) * 40 + si * 16 + l15]);
                        x = mma16(ldfrag(Xc, 40, ti * 16, 0, lane), ldfrag(NcT, 40, si * 16, 0, lane), x);
#pragma unroll
                        for (int r = 0; r < 4; ++r) Xn[(ti * 16 + lq * 4 + r) * 40 + si * 16 + l15] = (u16)f2bf(x[r]);
                    }
                } else if (rnd < 4) {
                    const int ti = (wave - 4) >> 1, si = wave & 1;
                    f32x4 n2 = {0.f, 0.f, 0.f, 0.f};
                    n2 = mma16(ldfrag(Nc, 40, ti * 16, 0, lane), ldfrag(NcT, 40, si * 16, 0, lane), n2);
#pragma unroll
                    for (int r = 0; r < 4; ++r) Nn[(ti * 16 + lq * 4 + r) * 40 + si * 16 + l15] = (u16)f2bf(n2[r]);
                    *(uint2*)(NnT + (si * 16 + l15) * 40 + ti * 16 + lq * 4) = make_uint2(pk2(n2[0], n2[1]), pk2(n2[2], n2[3]));
                }
                lbar();
                if (rnd > 0) { u16* t0 = Xc; Xc = Xn; Xn = t0; }
                if (rnd < 4) { u16* t1 = Nc; Nc = Nn; Nn = t1; u16* t2 = NcT; NcT = NnT; NnT = t2; }
            }
            if (tid < 160) *(uint4*)(TIG + ((size_t)unit * 16 + chunk) * 1280 + tid * 8) = *(const uint4*)(Xc + tid * 8);
            } else lbar();
            {
#pragma unroll
                for (int q = 0; q < NRT; ++q) {
                    const int tt = (PASS == 1) ? q : (wave >> 2), vt = (PASS == 1) ? wave : (wave & 3);
                    f32x4 sa = {0.f, 0.f, 0.f, 0.f};
                    sa = mma16(ldfrag(Xc, 40, tt * 16, 0, lane), ldfrag(RhsT, 40, vt * 16, 0, lane), sa);
                    *(uint2*)(SAT + (vt * 16 + l15) * 40 + tt * 16 + lq * 4) = make_uint2(pk2(sa[0], sa[1]), pk2(sa[2], sa[3]));
                }
            }
            lbar();
            if (PASS == 3) {
                const int tt = wave >> 2, vt = wave & 3;
                yv[0] = mma16(ldfrag(Mrb, 40, tt * 16, 0, lane), ldfrag(SAT, 40, vt * 16, 0, lane), yv[0]);
                yv[0] = mma16(ldfrag(Mrk, 40, tt * 16, 0, lane), ldfrag(VT, 40, vt * 16, 0, lane), yv[0]);
#pragma unroll
                for (int r = 0; r < 4; ++r) Yb[(tt * 16 + lq * 4 + r) * 64 + vt * 16 + l15] = (u16)f2bf(yv[0][r]);
            }
            {
                const bf16x8_t sa = ldfrag(SAT, 40, svt * 16, 0, lane), va = ldfrag(VT, 40, svt * 16, 0, lane);
#pragma unroll
                for (int q = 0; q < NST; ++q) {
                    const int kt = kt0 + q;
                    const float dk = __expf(Ltot[kt * 16 + l15]);
#pragma unroll
                    for (int r = 0; r < 4; ++r) S[q][r] *= dk;
                    S[q] = mma16(sa, ldfrag(BhT, 40, kt * 16, 0, lane), S[q]);
                    S[q] = mma16(va, ldfrag(KhT, 40, kt * 16, 0, lane), S[q]);
#pragma unroll
                    for (int r = 0; r < 4; ++r) Sb[(svt * 16 + lq * 4 + r) * 72 + kt * 16 + l15] = (u16)f2bf(S[q][r]);
                }
            }
            if (PASS == 3) {
                lbar();
                const uint2 ov = *(const uint2*)(Yb + et * 64 + ech);
                *(uint2*)(YO + (size_t)TIME_ROW(seg, chunk * 32 + et, dir, b) * 512 + hd * 64 + ech) = ov;
            }
        }
#undef RWM_LOAD
        if (PASS == 1) {
#pragma unroll
            for (int q = 0; q < NST; ++q)
#pragma unroll
                for (int r = 0; r < 4; ++r) {
                    const int v = svt * 16 + lq * 4 + r, k = (kt0 + q) * 16 + l15;
                    if (v < 64) LCs[(size_t)unit * 4096 + v * 64 + k] = S[q][r]; else PM[(size_t)unit * 4096 + (v - 64) * 64 + k] = S[q][r];
                }
        }
    }
    lbar();
}

__device__ __forceinline__ void s5_lambar(const Params& p, int j, int dir, int g, int lane, float& lr, float& li, float& are, float& aim) {
    are = INP(p, I_SARE)[(j * 32 + g) * 64 + lane]; aim = INP(p, I_SAIM)[(j * 32 + g) * 64 + lane];
    const float dl = __expf(INP(p, I_SLS)[(j * 2 + dir) * 32 + g]);
    const float mag = __expf(are * dl), ang = aim * dl;
    const float n = rintf(ang * 0.15915494309189535f);
    float r = fmaf(-n, 6.28318548202514648f, ang); r = fmaf(n, 1.74845553e-07f, r);
    lr = mag * __cosf(r); li = mag * __sinf(r);
}

__device__ __forceinline__ void s5_weights(const Params& p, int j, unsigned char* lds) {
    const int tid = otid();
    float* pw = (float*)lds;
    float* cf = pw + 2 * 17 * 64 * 2;
    float* bb = cf + 2 * 16 * 64 * 2;
    float* Kt = bb + 2 * 64 * 16 * 2;
    u16* Bt1 = (u16*)(WSP(p) + OD_BT1); u16* Bt0 = (u16*)(WSP(p) + OD_BT0);
    for (int item = obid(); item < 256; item += gridDim.x) {
        const int g = item >> 3, slice = item & 7;
        __syncthreads();
        if (tid < 128) {
            const int dir = tid >> 6, pp = tid & 63;
            float lr, li, are, aim; s5_lambar(p, j, dir, g, pp, lr, li, are, aim);
            float xr = 1.f, xi = 0.f;
#pragma nounroll
            for (int d = 0; d <= 16; ++d) { pw[((dir * 17 + d) * 64 + pp) * 2] = xr; pw[((dir * 17 + d) * 64 + pp) * 2 + 1] = xi; const float nr = xr * lr - xi * li, ni = xr * li + xi * lr; xr = nr; xi = ni; }
            const float den = are * are + aim * aim, nr = lr - 1.f;
            const float cr = (nr * are + li * aim) / den, ci = (li * are - nr * aim) / den;
            const float* br = INP(p, I_SBRE) + ((size_t)(j * 32 + g) * 64 + pp) * 16; const float* bi = INP(p, I_SBIM) + ((size_t)(j * 32 + g) * 64 + pp) * 16;
#pragma unroll 4
            for (int q = 0; q < 16; ++q) { bb[((dir * 64 + pp) * 16 + q) * 2] = cr * br[q] - ci * bi[q]; bb[((dir * 64 + pp) * 16 + q) * 2 + 1] = cr * bi[q] + ci * br[q]; }
        }
        for (int e = tid; e < 2048; e += 512) {
            const int dir = e >> 10, i = (e >> 6) & 15, pp = e & 63;
            const size_t so = ((size_t)((j * 2 + dir) * 32 + g) * 16 + i) * 64 + pp;
            cf[e * 2] = INP(p, I_SCRE)[so]; cf[e * 2 + 1] = INP(p, I_SCIM)[so];
        }
        __syncthreads();
        {
            const int dir = tid >> 8, d = (tid >> 4) & 15, i = tid & 15;
            float acc[16];
#pragma unroll
            for (int q = 0; q < 16; ++q) acc[q] = 0.f;
#pragma unroll 2
            for (int pp = 0; pp < 64; ++pp) {
                const float2 cc = *(const float2*)(cf + ((dir * 16 + i) * 64 + pp) * 2), ww = *(const float2*)(pw + ((dir * 17 + d) * 64 + pp) * 2);
                const float zr = cc.x * ww.x - cc.y * ww.y, zi = cc.x * ww.y + cc.y * ww.x;
                const float* bp = bb + (dir * 64 + pp) * 32;
#pragma unroll
                for (int q = 0; q < 8; ++q) { const float4 b4 = *(const float4*)(bp + q * 4); acc[q * 2] = fmaf(zr, b4.x, fmaf(-zi, b4.y, acc[q * 2])); acc[q * 2 + 1] = fmaf(zr, b4.z, fmaf(-zi, b4.w, acc[q * 2 + 1])); }
            }
#pragma unroll
            for (int q = 0; q < 4; ++q) *(float4*)(Kt + tid * 16 + q * 4) = make_float4(acc[q * 4], acc[q * 4 + 1], acc[q * 4 + 2], acc[q * 4 + 3]);
        }
        __syncthreads();
        {
            const int n = slice * 32 + (tid >> 4), tl = n >> 4, i = n & 15, k0 = (tid & 15) * 32;
            const float dsk = INP(p, I_SD)[j * 512 + g * 16 + i];
#pragma nounroll
            for (int q = 0; q < 4; ++q) {
                float o[8];
#pragma unroll
                for (int e = 0; e < 8; ++e) {
                    const int k = k0 + q * 8 + e; float val;
                    if (k < 256) {
                        const int sl = k >> 4, jj = k & 15;
                        val = 0.f;
                        if (sl <= tl) val += Kt[((0 * 16 + (tl - sl)) * 16 + i) * 16 + jj];
                        if (sl >= tl) val += Kt[((1 * 16 + (sl - tl)) * 16 + i) * 16 + jj];
                        if (sl == tl && i == jj) val += dsk;
                    } else {
                        const int dir = (k >= 384) ? 1 : 0, kk = k - 256 - dir * 128, pp = kk >> 1, im = kk & 1, d = dir ? (16 - tl) : (tl + 1);
                        const float c_r = cf[((dir * 16 + i) * 64 + pp) * 2], c_i = cf[((dir * 16 + i) * 64 + pp) * 2 + 1];
                        const float w_r = pw[((dir * 17 + d) * 64 + pp) * 2], w_i = pw[((dir * 17 + d) * 64 + pp) * 2 + 1];
                        val = im ? -(c_r * w_i + c_i * w_r) : (c_r * w_r - c_i * w_i);
                    }
                    o[e] = val;
                }
                *(uint4*)(Bt1 + ((size_t)g * 256 + n) * 512 + k0 + q * 8) = PACK8_BF(o);
            }
        }
        {
            const int n = slice * 32 + (tid >> 4), dir = n >> 7, nn = n & 127, pp = nn >> 1, im = nn & 1, k0 = (tid & 15) * 16;
#pragma nounroll
            for (int q = 0; q < 2; ++q) {
                float o[8];
#pragma unroll
                for (int e = 0; e < 8; ++e) {
                    const int k = k0 + q * 8 + e, sl = k >> 4, jj = k & 15, d = dir ? sl : (15 - sl);
                    const float w_r = pw[((dir * 17 + d) * 64 + pp) * 2], w_i = pw[((dir * 17 + d) * 64 + pp) * 2 + 1];
                    const float b_r = bb[((dir * 64 + pp) * 16 + jj) * 2], b_i = bb[((dir * 64 + pp) * 16 + jj) * 2 + 1];
                    o[e] = im ? (w_r * b_i + w_i * b_r) : (w_r * b_r - w_i * b_i);
                }
                *(uint4*)(Bt0 + ((size_t)g * 256 + n) * 256 + k0 + q * 8) = PACK8_BF(o);
            }
        }
    }
    __syncthreads();
}

struct S5Order {
    int G, c;
    __device__ __forceinline__ bool next(int i, pg8::Unit& u) const { const int L = i * G + c; if (L >= 128) return false; u.pm = L; u.pn = L >> 2; return true; }
    __device__ __forceinline__ void a_ready(const pg8::Unit&) const {}
    __device__ __forceinline__ void done(const pg8::Unit&) const {}
};
struct EpiXloc {
    static constexpr bool PERM = true, AFTER_DRAIN = false;
    float* X;
    __device__ __forceinline__ void operator()(const f32x4 (&acc)[2][2][4][2], const pg8::Unit& u, int wr, int wc, int fr, int fq) const {
        asm volatile("" : "+v"(fr), "+v"(fq));
        const int row0 = u.pm * 256 + wr * 64 + fr, col0 = wc * 32 + 8 * fq;
#pragma unroll
        for (int ai = 0; ai < 2; ++ai)
#pragma unroll
            for (int m = 0; m < 4; ++m)
#pragma unroll
                for (int bj = 0; bj < 2; ++bj) {
                    float* d = X + (size_t)(row0 + ai * 128 + m * 16) * 256 + col0 + bj * 128;
                    const f32x4 v0 = acc[ai][bj][m][0], v1 = acc[ai][bj][m][1];
                    *(float4*)d = make_float4(v0[0], v0[1], v0[2], v0[3]); *(float4*)(d + 4) = make_float4(v1[0], v1[1], v1[2], v1[3]);
                }
    }
};
struct EpiS5Out {
    static constexpr bool PERM = true, AFTER_DRAIN = false;
    u16* YG;
    __device__ __forceinline__ void operator()(const f32x4 (&acc)[2][2][4][2], const pg8::Unit& u, int wr, int wc, int fr, int fq) const {
        asm volatile("" : "+v"(fr), "+v"(fq));
        const int row0 = u.pm * 256 + wr * 64 + fr, col0 = wc * 32 + 8 * fq;
#pragma unroll
        for (int ai = 0; ai < 2; ++ai)
#pragma unroll
            for (int m = 0; m < 4; ++m) {
                const int row = row0 + ai * 128 + m * 16, g = row >> 10, rig = row & 1023, b = rig >> 9, cc = rig & 511;
#pragma unroll
                for (int bj = 0; bj < 2; ++bj) {
                    const int col = col0 + bj * 128, tl = col >> 4, i0 = col & 15;
                    float o[8];
#pragma unroll
                    for (int n = 0; n < 2; ++n)
#pragma unroll
                        for (int e = 0; e < 4; ++e) { const float x = acc[ai][bj][m][n][e]; o[n * 4 + e] = 0.5f * x * (1.f + tanhf_(0.7978845608028654f * (x + 0.044715f * x * x * x))); }
                    *(uint4*)(YG + ((size_t)b * SEQ + cc * 16 + tl) * 512 + g * 16 + i0) = PACK8_BF(o);
                }
            }
    }
};

__device__ __forceinline__ void s5_chunk_scan(const Params& p, int j, unsigned char* lds) {
    const int tid = otid(), blk = tid >> 5;
    float* ends = (float*)lds;
    const float* X = (const float*)(WSP(p) + OD_XLOC); u16* A1 = (u16*)(WSP(p) + OD_A1);
    for (int item = obid(); item < 256; item += gridDim.x) {
        const int pp = (tid & 31) + 32 * (item & 1), dir = (item >> 1) & 1, b = (item >> 2) & 1, g = item >> 3;
        float lr, li, are, aim; s5_lambar(p, j, dir, g, pp, lr, li, are, aim);
#pragma unroll
        for (int q = 0; q < 4; ++q) { const float nr = lr * lr - li * li, ni = 2.f * lr * li; lr = nr; li = ni; }
        float Lr = lr, Li = li;
#pragma unroll
        for (int q = 0; q < 5; ++q) { const float nr = Lr * Lr - Li * Li, ni = 2.f * Lr * Li; Lr = nr; Li = ni; }
        const size_t row0 = (size_t)g * 1024 + b * 512;
        const int xc = dir * 128 + 2 * pp;
        float xr = 0.f, xi = 0.f;
#pragma nounroll
        for (int cb = 0; cb < 32; cb += 8) {
            float2 v[8];
#pragma unroll
            for (int q = 0; q < 8; ++q) { const int c = dir ? (blk * 32 + 31 - cb - q) : (blk * 32 + cb + q); v[q] = *(const float2*)(X + (row0 + c) * 256 + xc); }
#pragma unroll
            for (int q = 0; q < 8; ++q) { const float nr = fmaf(lr, xr, fmaf(-li, xi, v[q].x)), ni = fmaf(lr, xi, fmaf(li, xr, v[q].y)); xr = nr; xi = ni; }
        }
        __syncthreads();
        ends[(blk * 64 + pp) * 2] = xr; ends[(blk * 64 + pp) * 2 + 1] = xi;
        __syncthreads();
        xr = 0.f; xi = 0.f;
        if (dir == 0) { for (int q = 0; q < blk; ++q) { const float er = ends[(q * 64 + pp) * 2], ei = ends[(q * 64 + pp) * 2 + 1]; const float nr = fmaf(Lr, xr, fmaf(-Li, xi, er)), ni = fmaf(Lr, xi, fmaf(Li, xr, ei)); xr = nr; xi = ni; } }
        else { for (int q = 15; q > blk; --q) { const float er = ends[(q * 64 + pp) * 2], ei = ends[(q * 64 + pp) * 2 + 1]; const float nr = fmaf(Lr, xr, fmaf(-Li, xi, er)), ni = fmaf(Lr, xi, fmaf(Li, xr, ei)); xr = nr; xi = ni; } }
#pragma nounroll
        for (int cb = 0; cb < 32; cb += 8) {
            float2 v[8];
#pragma unroll
            for (int q = 0; q < 8; ++q) { const int c = dir ? (blk * 32 + 31 - cb - q) : (blk * 32 + cb + q); v[q] = *(const float2*)(X + (row0 + c) * 256 + xc); }
#pragma unroll
            for (int q = 0; q < 8; ++q) {
                const int c = dir ? (blk * 32 + 31 - cb - q) : (blk * 32 + cb + q);
                *(unsigned*)(A1 + (row0 + c) * 512 + 256 + xc) = pk2(xr, xi);
                const float nr = fmaf(lr, xr, fmaf(-li, xi, v[q].x)), ni = fmaf(lr, xi, fmaf(li, xr, v[q].y)); xr = nr; xi = ni;
            }
        }
    }
    __syncthreads();
}

__device__ __forceinline__ void odd_carry(const Params& p, int j, unsigned char* lds) {
    const int tid = otid();
    float* Lpm = (float*)lds;
    float* Lcur = Lpm + 4096;
    float* LCs = (float*)(WSP(p) + OD_CLC); const float* PM = (const float*)(WSP(p) + OD_CPM);
    int cstart = obid() - 128; if (cstart < 0) cstart += gridDim.x;
    for (int item = cstart; item < 128; item += gridDim.x) {
        const int seq = item >> 2, lr = tid >> 5, row = (item & 3) * 16 + lr, c0 = (tid & 31) * 2;
        float cu0 = 0.f, cu1 = 0.f;
        float4 pa = *(const float4*)(PM + (size_t)(seq * 16) * 4096 + tid * 8), pb = *(const float4*)(PM + (size_t)(seq * 16) * 4096 + tid * 8 + 4);
        for (int s = 0; s < NSEG; ++s) {
            const int unit = seq * 16 + s;
            __syncthreads();
            *(float4*)(Lpm + tid * 8) = pa; *(float4*)(Lpm + tid * 8 + 4) = pb;
            Lcur[lr * 65 + c0] = cu0; Lcur[lr * 65 + c0 + 1] = cu1;
            float* lp = LCs + (size_t)unit * 4096 + row * 64 + c0;
            const float2 tmp = *(const float2*)lp;
            *(float2*)lp = make_float2(cu0, cu1);
            __syncthreads();
            if (s + 1 < NSEG) { pa = *(const float4*)(PM + (size_t)(unit + 1) * 4096 + tid * 8); pb = *(const float4*)(PM + (size_t)(unit + 1) * 4096 + tid * 8 + 4); }
            float a0 = 0.f, a1 = 0.f;
#pragma unroll 8
            for (int i = 0; i < 64; ++i) { const float a = Lcur[lr * 65 + i]; const float2 pm = *(const float2*)(Lpm + i * 64 + c0); a0 = fmaf(a, pm.x, a0); a1 = fmaf(a, pm.y, a1); }
            cu0 = a0 + tmp.x; cu1 = a1 + tmp.y;
        }
    }
    __syncthreads();
}

__device__ __forceinline__ void odd_post(const Params& p, int j) {
    const int lane = otid() & 63, gw = obid() * 8 + (otid() >> 6), nw = gridDim.x * 8;
    const u16* CYF = (const u16*)(WSP(p) + OD_CYF); const u16* CYB = (const u16*)(WSP(p) + OD_CYB);
    const u16* R = (const u16*)(WSP(p) + OD_R); const u16* V = (const u16*)(WSP(p) + OD_V); const u16* G = (const u16*)(WSP(p) + OD_G);
    const u16* AF = (const u16*)(WSP(p) + OD_AF); const u16* AB = (const u16*)(WSP(p) + OD_AB); const u16* KPa = (const u16*)(WSP(p) + OD_KP);
    u16* O = (u16*)(WSP(p) + WS_XA);
    const int c = lane * 8;
    float lnw[8], lnb[8], rk[8], kav[8];
#pragma unroll
    for (int i = 0; i < 8; ++i) { lnw[i] = INP(p, I_LNW)[j * 512 + c + i]; lnb[i] = INP(p, I_LNB)[j * 512 + c + i]; rk[i] = INP(p, I_RK)[j * 512 + c + i]; kav[i] = INP(p, I_KA)[j * 512 + c + i]; }
    for (int rowb = gw * 2; rowb < T_TOK; rowb += nw * 2) {
        uint4 q[2][8];
#pragma unroll
        for (int r = 0; r < 2; ++r) {
            const size_t o = (size_t)(rowb + r) * 512 + c;
            q[r][0] = *(const uint4*)(CYF + o); q[r][1] = *(const uint4*)(CYB + o); q[r][2] = *(const uint4*)(AF + o); q[r][3] = *(const uint4*)(AB + o);
            q[r][4] = *(const uint4*)(R + o); q[r][5] = *(const uint4*)(KPa + o); q[r][6] = *(const uint4*)(V + o); q[r][7] = *(const uint4*)(G + o);
        }
#pragma unroll
        for (int r = 0; r < 2; ++r) {
            const size_t row = rowb + r;
            float y[8], t[8], t2[8], out[8];
            UNPACK8_BF(q[r][0], y); UNPACK8_BF(q[r][1], t);
            float sm = 0.f;
#pragma unroll
            for (int i = 0; i < 8; ++i) { y[i] += t[i]; sm += y[i]; }
            const float mean = red8(sm) * (1.f / 64.f);
            float sv = 0.f;
#pragma unroll
            for (int i = 0; i < 8; ++i) { y[i] -= mean; sv += y[i] * y[i]; }
            const float rstd = rsqrtf(red8(sv) * (1.f / 64.f) + 64e-5f);
            UNPACK8_BF(q[r][2], t); UNPACK8_BF(q[r][3], t2);
            float rr[8], kp8[8]; UNPACK8_BF(q[r][4], rr); UNPACK8_BF(q[r][5], kp8);
            float bs = 0.f;
#pragma unroll
            for (int i = 0; i < 8; ++i) bs = fmaf(rr[i] * kp8[i] * (2.f + (t[i] + t2[i] - 2.f) * kav[i]), rk[i], bs);
            bs = red8(bs);
            UNPACK8_BF(q[r][6], t); UNPACK8_BF(q[r][7], t2);
#pragma unroll
            for (int i = 0; i < 8; ++i) out[i] = (fmaf(y[i] * rstd, lnw[i], lnb[i]) + bs * t[i]) * t2[i];
            *(uint4*)(O + row * DM + c) = PACK8_BF(out);
        }
    }
}

template <class Epi, bool ALIGN = true>
__device__ __forceinline__ void run_gemm(unsigned char* lds, const u16* A, const u16* Bt, int N, int K, const Epi& E) {
    int Kr = K; asm volatile("" : "+s"(Kr));
    pg8::Gemm g{A, Bt, T_TOK, N, Kr, Kr, Kr}; pg8::StaticOrder S; S.init(T_TOK, N, (int)gridDim.x, obid());
    pg8::gemm_phase<Epi, pg8::StaticOrder, ALIGN, true>((PG8_LAS unsigned char*)lds, g, S, E);
}

__device__ __forceinline__ void run_phase(const Params& p, int layer, int ph, unsigned char* lds, const XcdBarrier& xbar) {
    const int j = layer >> 1; const bool even = (layer & 1) == 0;
    unsigned char* ws = WSP(p);
    u16* XA = (u16*)(ws + WS_XA);
    const float* hin = (layer == 0) ? INP(p, I_X) : OUTP(p);
    switch (ph) {
    case 0: if (PH_MASK & 1) {
        int item = obid(); const int gsz = gridDim.x;
        if (even) convert_weight(INP(p, I_EVIN) + (size_t)j * DM * 4112, DM, 4112, 4112, 0, (u16*)(ws + WS_WIN), EV_N, lds, item, gsz);
        else { convert_weight(INP(p, I_ODIN) + (size_t)j * DM * 2272, DM, 2272, 2048, 2, (u16*)(ws + WS_WIN), 2048, lds, item, gsz);
               convert_weight(INP(p, I_ODIN) + (size_t)j * DM * 2272, DM, 2272, 224, 3, (u16*)(ws + WS_WIN + 5 * MiB), 256, lds, item, gsz); }
        convert_weight((even ? INP(p, I_EVOUT) : INP(p, I_ODOUT)) + (size_t)j * DM * DM, DM, DM, DM, 0, (u16*)(ws + WS_WOUT), DM, lds, item, gsz);
        if (even || gsz != 256) {
        convert_weight(INP(p, I_FFI) + (size_t)layer * DM * 2 * DFF, DM, 2 * DFF, 2 * DFF, 1, (u16*)(ws + WS_WFI), 2 * DFF, lds, item, gsz);
        convert_weight(INP(p, I_FFO) + (size_t)layer * DFF * DM, DFF, DM, DM, 0, (u16*)(ws + WS_WFO), DM, lds, item, gsz);
        }
        if (!even) { convert_weight(INP(p, I_GLUW) + (size_t)j * 512 * 512, 512, 512, 512, 0, (u16*)(ws + WS_WGLU), 512, lds, item, gsz); build_lora_weight(p, j); }
        norm_rows_bf16(hin, INP(p, I_NMIX) + (size_t)layer * DM, XA);
    } break;
    case 1: if (PH_MASK & 2) {
        if (even) { EpiEven E{(u16*)(ws + WS_P), (float*)(ws + EV_DT), INP(p, I_HGLB), INP(p, I_M2DTB) + j * 16, j}; run_gemm(lds, XA, (const u16*)(ws + WS_WIN), 4096, DM, E); }
        else { EpiPlain E{(u16*)(ws + WS_P), OD_N, 0, 6, 224, 1 << 30}; run_gemm(lds, XA, (const u16*)(ws + WS_WIN), 2048, DM, E);
               EpiPlain E2{(u16*)(ws + WS_P), OD_N, 1536, 1 << 30, 0, 224}; run_gemm(lds, XA, (const u16*)(ws + WS_WIN + 5 * MiB), 256, DM, E2); }
    } break;
    case 2: if (!(PH_MASK & 4)) break; if (even) { even_conv(p, j); even_dt(p, j, lds); } else { odd_shift(p, j); xcd_barrier(xbar);
            EpiLora E{ws, INP(p, I_W0) + j * 1024, INP(p, I_A0) + j * 1024}; run_gemm<EpiLora, false>(lds, (const u16*)(ws + OD_XL), (const u16*)(ws + OD_BTL), 2560, 256, E); } break;
    case 3: if (!(PH_MASK & 8)) break; if (even) { hg_mma<1>(p, lds); m2_mma<1>(p, j, lds); } else { rw_mma<1>(p, j, lds); s5_weights(p, j, lds); } break;
    case 4: if (!(PH_MASK & 16)) break; if (even) even_carry(p); else {
            int Kr = 256; asm volatile("" : "+s"(Kr)); pg8::Gemm g{(const u16*)(ws + OD_A1), (const u16*)(ws + OD_BT0), 32768, 256, Kr, 512, 256}; S5Order S{(int)gridDim.x, obid()}; EpiXloc E{(float*)(ws + OD_XLOC)};
            pg8::gemm_phase<EpiXloc, S5Order, false, true>((PG8_LAS unsigned char*)lds, g, S, E); odd_carry(p, j, lds); } break;
    case 5: if (!(PH_MASK & 32)) break; if (even) { hg_mma<3>(p, lds); m2_mma<3>(p, j, lds); } else { rw_mma<3>(p, j, lds); s5_chunk_scan(p, j, lds); } break;
    case 6: if (!(PH_MASK & 64)) break; if (even) even_post(p, j); else { odd_post(p, j); __syncthreads();
            pg8::Gemm g{(const u16*)(ws + OD_A1), (const u16*)(ws + OD_BT1), 32768, 256, 512, 512, 512}; S5Order S{(int)gridDim.x, obid()}; EpiS5Out E{(u16*)(ws + OD_YG)};
            pg8::gemm_phase<EpiS5Out, S5Order, false, true>((PG8_LAS unsigned char*)lds, g, S, E);
            if (gridDim.x == 256 && obid() >= 128) { int item = obid() - 128;
                convert_weight(INP(p, I_FFO) + (size_t)layer * DFF * DM, DFF, DM, DM, 0, (u16*)(ws + WS_WFO), DM, lds, item, 128); } } break;
    case 7: if ((PH_MASK & 128) && !even) { EpiGlu E{(const u16*)(ws + OD_YG), INP(p, I_GLUB) + j * 512, XA}; run_gemm(lds, (const u16*)(ws + OD_YG), (const u16*)(ws + WS_WGLU), 512, 512, E);
        if (gridDim.x == 256 && obid() >= 128) {
            int item = obid() - 128;
            convert_weight(INP(p, I_FFI) + (size_t)layer * DM * 2 * DFF, DM, 2 * DFF, 2 * DFF, 1, (u16*)(ws + WS_WFI), 2 * DFF, lds, item, 128);
        } } break;
    case 8: if (PH_MASK & 256) { EpiResid E{hin, OUTP(p)}; run_gemm(lds, XA, (const u16*)(ws + WS_WOUT), DM, DM, E); } break;
    case 9: if (PH_MASK & 512) norm_rows_bf16(OUTP(p), INP(p, I_NFFN) + (size_t)layer * DM, XA); break;
    case 10: if (PH_MASK & 1024) { EpiFfn E{(u16*)(ws + WS_ACT)}; run_gemm(lds, XA, (const u16*)(ws + WS_WFI), 2 * DFF, DM, E); } break;
    case 11: if (PH_MASK & 2048) { EpiResid E{OUTP(p), OUTP(p)}; run_gemm(lds, (const u16*)(ws + WS_ACT), (const u16*)(ws + WS_WFO), DM, DFF, E); } break;
    default: break;
    }
}

__global__ void __launch_bounds__(512, 2) fwd_kernel(Params p) {
    extern __shared__ __attribute__((aligned(16))) unsigned char lds[];
    volatile LAS unsigned* xst = (volatile LAS unsigned*)(lds + LDS_BYTES - 64);
    if (otid() < 2) xst[otid()] = 0u;
    __syncthreads();
    const XcdBarrier xbar = xcd_barrier_post((unsigned*)(p.ws + WS_BAR), xst);
#ifdef REP_LO
    int rep = 0;
#endif
    for (int gp = p.lo; gp < p.hi; ++gp) {
        const int layer = gp / 12, ph = gp % 12;
        if (gp == 48) { norm_rows_f32_inplace(OUTP(p), INP(p, I_NFIN)); break; }
        if (ph == 7 && (layer & 1) == 0) continue;
        run_phase(p, layer, ph, lds, xbar);
        if (gp + 1 < p.hi) xcd_barrier(xbar);
#ifdef REP_LO
        if (ph == REP_HI) { if (rep == 0) { rep = 1; gp -= (REP_HI - REP_LO + 1); } else rep = 0; }
#endif
    }
}

extern "C" void kernel_launch(void* const* d_in, const int* in_sizes, int n_in, void* d_out, int out_size, void* d_ws, size_t ws_size, hipStream_t stream) {
    static int grid = 0;
    if (grid == 0) {
        if (n_in != 39 || out_size != T_TOK * DM || ws_size < WS_NEED) { fprintf(stderr, "kernel_launch: unexpected problem (n_in %d out %d ws %zu)\n", n_in, out_size, ws_size); grid = -1; return; }
        int dev = 0, cus = 0, per_cu = 0;
        hipGetDevice(&dev); hipDeviceGetAttribute(&cus, hipDeviceAttributeMultiprocessorCount, dev);
        if (hipFuncSetAttribute((const void*)fwd_kernel, hipFuncAttributeMaxDynamicSharedMemorySize, LDS_BYTES) != hipSuccess) { fprintf(stderr, "kernel_launch: hipFuncSetAttribute failed\n"); grid = -1; return; }
        if (hipOccupancyMaxActiveBlocksPerMultiprocessor(&per_cu, (const void*)fwd_kernel, 512, LDS_BYTES) != hipSuccess || per_cu < 1) { fprintf(stderr, "kernel_launch: occupancy query gave %d\n", per_cu); per_cu = 1; }
        (void)hipGetLastError();
        grid = cus * 1;
        fprintf(stderr, "kernel_launch: grid %d (cus %d, per_cu %d)\n", grid, cus, per_cu);
    }
    if (grid < 0) return;
    if (hipMemsetAsync((unsigned char*)d_ws + WS_BAR, 0, XCD_BAR_WORDS * 4, stream) != hipSuccess) { fprintf(stderr, "kernel_launch: memset failed\n"); return; }
    Params p{};
    for (int i = 0; i < 39; ++i) p.in[i] = (const float*)d_in[i];
    p.out = (float*)d_out; p.ws = (unsigned char*)d_ws;
#if ONE_LAUNCH
    p.lo = 0; p.hi = 49;
    void* args[] = {&p};
    hipError_t e = hipLaunchCooperativeKernel((const void*)fwd_kernel, dim3(grid), dim3(512), args, LDS_BYTES, stream);
    if (e != hipSuccess) fprintf(stderr, "cooperative launch failed: %s (grid %d)\n", hipGetErrorString(e), grid);
#else
    for (int gp = 0; gp < 49; ++gp) {
        if (gp != 48 && (gp % 12) == 7 && ((gp / 12) & 1) == 0) continue;
        p.lo = gp; p.hi = gp + 1;
        hipLaunchKernelGGL(fwd_kernel, dim3(grid), dim3(512), LDS_BYTES, stream, p);
    }
#endif
}
```

```cpp
#include <hip/hip_runtime.h>
#include <hip/hip_cooperative_groups.h>
#include <cstdio>
#include <cstdint>
namespace cg = cooperative_groups;
#ifndef ONE_LAUNCH
#define ONE_LAUNCH 1
#endif
__device__ __forceinline__ int otid() { int t = threadIdx.x; asm volatile("" : "+v"(t)); return t; }
__device__ __forceinline__ int obid() { int b = blockIdx.x; asm volatile("" : "+s"(b)); return b; }
namespace pg8 {
#define PG8_LAS __attribute__((address_space(3)))
typedef unsigned short bf16_t;
typedef short bf16x8 __attribute__((ext_vector_type(8)));
typedef float f32x4 __attribute__((ext_vector_type(4)));
typedef unsigned u32x4 __attribute__((ext_vector_type(4)));
constexpr int BM = 256, BK = 64, HALF = 128, HTB = HALF * BK * 2  , STAGE_BYTES = 8 * HTB, NXCD = 8, WGM = 8;

__host__ __device__ __forceinline__ int lds_byte(int r, int c) { const int st = (r >> 4) * 2 + (c >> 5), rr = r & 15, cc = c & 31, ob = rr * 64 + cc * 2; return st * 1024 + (ob ^ (((ob >> 9) & 1) << 5)); }
__host__ __device__ __forceinline__ void stage_rc(int b, int& R, int& C) { const int st = b / 1024, sb = b % 1024, swz = sb ^ (((sb >> 9) & 1) << 5); R = (st >> 1) * 16 + swz / 64; C = (st & 1) * 32 + (swz % 64) / 2; }
__host__ __device__ __forceinline__ int perm32(int rho) { const int n = rho >> 4, i = rho & 15; return 8 * (i >> 2) + 4 * n + (i & 3); }

struct Unit { int pm, pn; };
struct Gemm { const bf16_t* A; const bf16_t* Bt; int M, N, K, lda, ldb; };

struct StaticOrder {
    int nM, nN, nwg, G, c;
    __host__ __device__ void init(int M, int N, int G_, int c_) { nM = M / BM; nN = N / BM; nwg = nM * nN; G = G_; c = c_; }
    __host__ __device__ bool next(int i, Unit& u) const {
        const long L = (long)i * G + c; if (L >= nwg) return false;
        int wgid = (int)L; { const int q = nwg / NXCD, r = nwg % NXCD, xcd = wgid % NXCD, off = wgid / NXCD; wgid = (xcd < r ? xcd * (q + 1) : r * (q + 1) + (xcd - r) * q) + off; }
        const int nig = WGM * nN, gid = wgid / nig, fm = gid * WGM, gsz = (nM - fm) < WGM ? (nM - fm) : WGM;
        u.pm = fm + ((wgid % nig) % gsz); u.pn = (wgid % nig) / gsz; return true;
    }
    __device__ __forceinline__ void a_ready(const Unit&) const {}
    __device__ __forceinline__ void done(const Unit&) const {}
};
template <class Epi, class Sched, bool ALIGN_EPI = false, bool SP2 = false>
__device__ __forceinline__ void gemm_phase(PG8_LAS unsigned char* lds, const Gemm g, const Sched& S, const Epi& E) {
    const int tid = otid(), wid = __builtin_amdgcn_readfirstlane(tid >> 6), lane = tid & 63, wr = wid >> 2, wc = wid & 3, fr = lane & 15, fq = lane >> 4;
    const int K = g.K, nt = K / BK;
    unsigned voffA[2], voffB[2];
#pragma unroll
    for (int i = 0; i < 2; ++i) { int R, C; stage_rc(tid * 16 + i * 8192, R, C); const int Rb = Epi::PERM ? ((R & ~31) + perm32(R & 31)) : R;
        voffA[i] = (unsigned)(R * g.lda + C) * 2u; voffB[i] = (unsigned)(Rb * g.ldb + C) * 2u; }
    const size_t kstep = (size_t)(BK * 2);
    const size_t hstepA = (size_t)HALF * g.lda * 2, hstepB = (size_t)HALF * g.ldb * 2;
    const size_t tstepA = 2 * hstepA, tstepB = 2 * hstepB;
    const unsigned ldsw = (unsigned)wid * 1024u;
    const int aoff = lds_byte(wr * 64 + fr, fq * 8), boff = lds_byte(wc * 32 + fr, fq * 8);
#define PG8_SA(b, h) (((b) * 2 + (h)) * HTB)
#define PG8_SB(b, h) ((4 + (b) * 2 + (h)) * HTB)
#define PG8_STAGE(bufoff, gbase, voff) do { _Pragma("unroll") for (int _i = 0; _i < 2; ++_i) \
        __builtin_amdgcn_global_load_lds((const unsigned*)((const char*)(gbase) + (voff)[_i]), (PG8_LAS unsigned*)(lds + (bufoff) + ldsw + _i * 8192), 16, 0, 0); } while (0)
#define PG8_LDA(dst, b, h) do { _Pragma("unroll") for (int m = 0; m < 4; ++m) _Pragma("unroll") for (int k = 0; k < 2; ++k) dst[m][k] = *(const PG8_LAS bf16x8*)(lds + PG8_SA(b, h) + aoff + m * 2048 + k * 1024); } while (0)
#define PG8_LDB(dst, b, h) do { _Pragma("unroll") for (int n = 0; n < 2; ++n) _Pragma("unroll") for (int k = 0; k < 2; ++k) dst[n][k] = *(const PG8_LAS bf16x8*)(lds + PG8_SB(b, h) + boff + n * 2048 + k * 1024); } while (0)
#define PG8_MMA(ai, bj, At, Bt) do { __builtin_amdgcn_s_setprio(1); _Pragma("unroll") for (int m = 0; m < 4; ++m) _Pragma("unroll") for (int n = 0; n < 2; ++n) _Pragma("unroll") for (int k = 0; k < 2; ++k) \
        acc[ai][bj][m][n] = __builtin_amdgcn_mfma_f32_16x16x32_bf16(Bt[n][k], At[m][k], acc[ai][bj][m][n], 0, 0, 0); __builtin_amdgcn_s_setprio(0); } while (0)
#define PG8_WAIT_V(n) asm volatile("s_waitcnt vmcnt(" #n ")" ::: "memory")
#define PG8_WAIT_L(n) asm volatile("s_waitcnt lgkmcnt(" #n ")" ::: "memory")
#define PG8_BAR __builtin_amdgcn_s_barrier()
#define PG8_SCHED __builtin_amdgcn_sched_barrier(0)
    Unit cur, nxt; int ui = 0;
    if (!S.next(0, cur)) return;
    f32x4 acc[2][2][4][2];
#pragma unroll
    for (int a = 0; a < 2; ++a)
#pragma unroll
        for (int b = 0; b < 2; ++b)
#pragma unroll
            for (int m = 0; m < 4; ++m)
#pragma unroll
                for (int n = 0; n < 2; ++n) acc[a][b][m][n] = (f32x4){0.f, 0.f, 0.f, 0.f};
    bf16x8 At[4][2], B0[2][2], B1[2][2];
    const char* cA = (const char*)g.A + (size_t)cur.pm * tstepA; const char* cB = (const char*)g.Bt + (size_t)cur.pn * tstepB;
    S.a_ready(cur);
    if constexpr (SP2) {
        PG8_STAGE(PG8_SB(0, 0), cB, voffB); PG8_STAGE(PG8_SB(0, 1), cB + hstepB, voffB); PG8_STAGE(PG8_SA(0, 0), cA, voffA); PG8_STAGE(PG8_SA(0, 1), cA + hstepA, voffA);
        if (wr == 1) PG8_BAR;
        PG8_WAIT_V(2); PG8_BAR;
        PG8_STAGE(PG8_SB(1, 0), cB + kstep, voffB); PG8_STAGE(PG8_SA(1, 0), cA + kstep, voffA); PG8_STAGE(PG8_SB(1, 1), cB + hstepB + kstep, voffB);
        PG8_WAIT_V(6); PG8_BAR;
    } else {
        PG8_STAGE(PG8_SB(0, 0), cB, voffB); PG8_STAGE(PG8_SA(0, 0), cA, voffA); PG8_STAGE(PG8_SB(0, 1), cB + hstepB, voffB); PG8_STAGE(PG8_SA(0, 1), cA + hstepA, voffA);
        if (wr == 1) PG8_BAR;
        PG8_WAIT_V(4); PG8_BAR;
        PG8_STAGE(PG8_SB(1, 0), cB + kstep, voffB); PG8_STAGE(PG8_SA(1, 0), cA + kstep, voffA); PG8_STAGE(PG8_SB(1, 1), cB + hstepB + kstep, voffB);
        PG8_WAIT_V(6); PG8_BAR;
    }
    for (;;) {
        const bool has_next = S.next(ui + 1, nxt);
        const char* nA = has_next ? (const char*)g.A + (size_t)nxt.pm * tstepA : cA; const char* nB = has_next ? (const char*)g.Bt + (size_t)nxt.pn * tstepB : cB;
        for (int t = 0; t < nt; t += 2) {
            const bool last = (t == nt - 2);
            const char* a1 = cA + (size_t)(t + 1) * kstep;
            const char* a2 = last ? nA : cA + (size_t)(t + 2) * kstep; const char* b2 = last ? nB : cB + (size_t)(t + 2) * kstep;
            const char* a3 = a2 + kstep; const char* b3 = b2 + kstep;
            if (last && has_next) S.a_ready(nxt);
            if constexpr (SP2) {
            PG8_LDB(B0, 0, 0); PG8_LDB(B1, 0, 1); PG8_SCHED; PG8_LDA(At, 0, 0); PG8_STAGE(PG8_SA(1, 1), a1 + hstepA, voffA);
            PG8_WAIT_V(8); PG8_WAIT_L(0); PG8_BAR; PG8_MMA(0, 0, At, B0); PG8_MMA(0, 1, At, B1); PG8_BAR; PG8_SCHED;
            PG8_LDA(At, 0, 1); PG8_STAGE(PG8_SB(0, 0), b2, voffB); PG8_STAGE(PG8_SB(0, 1), b2 + hstepB, voffB); PG8_STAGE(PG8_SA(0, 0), a2, voffA);
            PG8_WAIT_V(8); PG8_WAIT_L(0); PG8_BAR; PG8_MMA(1, 0, At, B0); PG8_MMA(1, 1, At, B1); PG8_BAR; PG8_SCHED;
            PG8_LDB(B0, 1, 0); PG8_LDB(B1, 1, 1); PG8_SCHED; PG8_LDA(At, 1, 0); PG8_STAGE(PG8_SA(0, 1), a2 + hstepA, voffA);
            PG8_WAIT_V(8); PG8_WAIT_L(0); PG8_BAR; PG8_MMA(0, 0, At, B0); PG8_MMA(0, 1, At, B1); PG8_BAR; PG8_SCHED;
            PG8_LDA(At, 1, 1); PG8_STAGE(PG8_SB(1, 0), b3, voffB); PG8_STAGE(PG8_SB(1, 1), b3 + hstepB, voffB); PG8_STAGE(PG8_SA(1, 0), a3, voffA);
            PG8_WAIT_V(8); PG8_WAIT_L(0); PG8_BAR; PG8_MMA(1, 0, At, B0); PG8_MMA(1, 1, At, B1); PG8_BAR; PG8_SCHED;
            } else {
            PG8_LDB(B0, 0, 0); PG8_SCHED; PG8_LDA(At, 0, 0); PG8_STAGE(PG8_SA(1, 1), a1 + hstepA, voffA);
            PG8_WAIT_L(8); PG8_BAR; PG8_WAIT_L(0); PG8_MMA(0, 0, At, B0); PG8_BAR; PG8_SCHED;
            PG8_LDB(B1, 0, 1); PG8_STAGE(PG8_SB(0, 0), b2, voffB);
            PG8_BAR; PG8_WAIT_L(0); PG8_MMA(0, 1, At, B1); PG8_BAR;
            PG8_LDA(At, 0, 1); PG8_STAGE(PG8_SA(0, 0), a2, voffA);
            PG8_BAR; PG8_WAIT_L(0); PG8_MMA(1, 0, At, B0); PG8_BAR; PG8_SCHED;
            PG8_STAGE(PG8_SB(0, 1), b2 + hstepB, voffB);
            PG8_WAIT_V(6); PG8_BAR; PG8_MMA(1, 1, At, B1); PG8_BAR;
            PG8_LDB(B0, 1, 0); PG8_SCHED; PG8_LDA(At, 1, 0); PG8_STAGE(PG8_SA(0, 1), a2 + hstepA, voffA);
            PG8_WAIT_L(8); PG8_BAR; PG8_WAIT_L(0); PG8_MMA(0, 0, At, B0); PG8_BAR; PG8_SCHED;
            PG8_LDB(B1, 1, 1); PG8_STAGE(PG8_SB(1, 0), b3, voffB);
            PG8_BAR; PG8_WAIT_L(0); PG8_MMA(0, 1, At, B1); PG8_BAR;
            PG8_LDA(At, 1, 1); PG8_STAGE(PG8_SA(1, 0), a3, voffA);
            PG8_BAR; PG8_WAIT_L(0); PG8_MMA(1, 0, At, B0); PG8_BAR; PG8_SCHED;
            PG8_STAGE(PG8_SB(1, 1), b3 + hstepB, voffB);
            PG8_WAIT_V(6); PG8_BAR; PG8_MMA(1, 1, At, B1); PG8_BAR;
            }
        }
        if constexpr (ALIGN_EPI) { if (wr == 0) PG8_BAR; }
        if constexpr (!Epi::AFTER_DRAIN) { E(acc, cur, wr, wc, fr, fq); S.done(cur); }
        if (!has_next) break;
#pragma unroll
        for (int a = 0; a < 2; ++a)
#pragma unroll
            for (int b = 0; b < 2; ++b)
#pragma unroll
                for (int m = 0; m < 4; ++m)
#pragma unroll
                    for (int n = 0; n < 2; ++n) acc[a][b][m][n] = (f32x4){0.f, 0.f, 0.f, 0.f};
        cur = nxt; cA = nA; cB = nB; ++ui;
        if constexpr (ALIGN_EPI) { if (wr == 1) PG8_BAR; }
    }
    PG8_WAIT_V(0);
    if constexpr (!ALIGN_EPI) { if (wr == 0) PG8_BAR; }
    PG8_BAR;
    if constexpr (Epi::AFTER_DRAIN) { E.fused(acc, cur, wr, wc, fr, fq, lds, wid, lane); S.done(cur); }
#undef PG8_SA
#undef PG8_SB
#undef PG8_STAGE
#undef PG8_LDA
#undef PG8_LDB
#undef PG8_MMA
#undef PG8_WAIT_V
#undef PG8_WAIT_L
#undef PG8_BAR
#undef PG8_SCHED
}
}

typedef unsigned short u16;
using pg8::f32x4;
constexpr int T_TOK = 16384, SEQ = 8192, DM = 1024, DFF = 2816;
constexpr int EV_N = 4352, OD_N = 2304, RWIN = 1760;
constexpr int NSEG = 16, LSEG = 512;
constexpr int LDS_BYTES = 144 * 1024;
#ifndef PH_MASK
#define PH_MASK 0xFFF
#endif
constexpr size_t MiB = 1048576;
constexpr size_t WS_WIN = 0, WS_WOUT = 9 * MiB, WS_WFI = 11 * MiB, WS_WFO = 22 * MiB, WS_WGLU = 28 * MiB;
constexpr size_t WS_XA = 30 * MiB, WS_R0 = 62 * MiB;
constexpr size_t WS_P = WS_R0, WS_ACT = WS_R0;
constexpr size_t EV_XBC = WS_R0 + 136 * MiB, EV_DT = EV_XBC + 32 * MiB, EV_AOF = EV_DT + 1 * MiB, EV_AOB = EV_AOF + 16 * MiB,
                 EV_BYF = EV_AOB + 16 * MiB, EV_BYB = EV_BYF + 16 * MiB, EV_ALC = EV_BYB + 16 * MiB, EV_BLC = EV_ALC + 16 * MiB,
                 EV_ADEC = EV_BLC + 16 * MiB, EV_BDEC = EV_ADEC + 1 * MiB;
constexpr size_t OD_CYF = WS_R0, OD_CYB = WS_R0 + 16 * MiB;
constexpr size_t OD_PREP = WS_R0 + 72 * MiB;
constexpr size_t OD_R = OD_PREP, OD_V = OD_PREP + 16 * MiB, OD_KK = OD_PREP + 32 * MiB, OD_G = OD_PREP + 48 * MiB, OD_KF = OD_PREP + 64 * MiB,
                 OD_KB = OD_PREP + 80 * MiB, OD_AF = OD_PREP + 96 * MiB, OD_AB = OD_PREP + 112 * MiB, OD_WF1 = OD_PREP + 128 * MiB, OD_WB1 = OD_PREP + 144 * MiB;
constexpr size_t OD_A1 = OD_PREP + 160 * MiB, OD_CLC = OD_A1 + 32 * MiB, OD_CPM = OD_CLC + 8 * MiB;
constexpr size_t OD_XLOC = WS_XA, OD_BT1 = WS_R0 + 32 * MiB, OD_BT0 = WS_R0 + 40 * MiB;
constexpr size_t OD_TINV = WS_R0 + 44 * MiB;
constexpr size_t OD_KP = OD_KF, OD_XL = WS_XA + 16 * MiB, OD_BTL = OD_CPM + 8 * MiB;
constexpr size_t OD_YG = OD_WF1;
constexpr size_t WS_NEED = 344 * MiB;

struct Params { const float* in[39]; float* out; unsigned char* ws; int lo, hi; };
enum { I_X = 0, I_NMIX, I_NFFN, I_NFIN, I_FFI, I_FFO, I_EVIN, I_EVOUT, I_HGLB, I_HGNW, I_M2CW, I_M2CB, I_M2DTB, I_M2ALOG, I_M2D, I_M2NW,
       I_ODIN, I_ODOUT, I_MU, I_W0, I_W2, I_A0, I_A2, I_G2, I_KK, I_KA, I_RK, I_LNW, I_LNB, I_SARE, I_SAIM, I_SBRE, I_SBIM, I_SCRE, I_SCIM, I_SD, I_SLS, I_GLUW, I_GLUB };


__device__ __forceinline__ const float* inp_(const Params& p, int i) { asm volatile("" : "+s"(i)); return p.in[i]; }
__device__ __forceinline__ unsigned char* wsp_(const Params& p) { size_t z = 0; asm volatile("" : "+s"(z)); return p.ws + z; }
__device__ __forceinline__ float* outp_(const Params& p) { size_t z = 0; asm volatile("" : "+s"(z)); return p.out + z; }
#define INP(p, i) inp_(p, i)
#define WSP(p) wsp_(p)
#define OUTP(p) outp_(p)


constexpr size_t WS_BAR = 29 * MiB;
#define LAS __attribute__((address_space(3)))
#define XB_TMO      128
#define XB_XCNT(j)  (256  + 64 * (j))
#define XB_XSUB(j)  (1280 + 64 * (j))
#define XB_XGEN(j)  (2304 + 64 * (j))
#define XB_TOP      3328
#define XB_TOPGEN   3392
#define XCD_BAR_WORDS 3456
#define XB_SPIN_CAP (1u << 18)

__device__ __forceinline__ unsigned xb_ld(unsigned* p)              { return __hip_atomic_load(p, __ATOMIC_RELAXED, __HIP_MEMORY_SCOPE_AGENT); }
__device__ __forceinline__ unsigned xb_add(unsigned* p, unsigned v) { return __hip_atomic_fetch_add(p, v, __ATOMIC_RELAXED, __HIP_MEMORY_SCOPE_AGENT); }
__device__ __forceinline__ unsigned xb_xcc_id() { return (unsigned)__builtin_amdgcn_s_getreg((3 << 11) | 20) & 0xFu; }
#define XB_SPIN(cond, bar) do { unsigned _sp = 0; while (cond) { __builtin_amdgcn_s_sleep(1); \
    if ((++_sp & 255u) == 0u) { if (xb_ld(&(bar)[XB_TMO])) break; if (_sp > XB_SPIN_CAP) { atomicAdd(&(bar)[XB_TMO], 1u); break; } } } } while (0)

struct XcdBarrier {
    unsigned* bar; unsigned x;
    volatile LAS unsigned* st;
};

__device__ __forceinline__ XcdBarrier xcd_barrier_post(unsigned* bar, volatile LAS unsigned* st) {
    XcdBarrier b; b.bar = bar; b.x = xb_xcc_id(); b.st = st;
    if (otid() == 0) (void)xb_add(&bar[XB_XCNT(b.x)], 1u);
    return b;
}
__device__ __forceinline__ void xcd_barrier_complete(unsigned* bar, unsigned x, unsigned& nloc, unsigned& nx) {
    const unsigned G = gridDim.x * gridDim.y * gridDim.z;
    unsigned sum, cnt, mine, sp = 0u;
    for (;;) {
        sum = 0u; cnt = 0u; mine = 0u;
#pragma unroll
        for (unsigned j = 0; j < 16; ++j) { const unsigned c = xb_ld(&bar[XB_XCNT(j)]); sum += c; cnt += (c > 0u) ? 1u : 0u; mine = (j == x) ? c : mine; }
        if (sum == G) break;
        __builtin_amdgcn_s_sleep(1);
        if ((++sp & 255u) == 0u) { if (xb_ld(&bar[XB_TMO])) break; if (sp > XB_SPIN_CAP) { atomicAdd(&bar[XB_TMO], 1u); break; } }
    }
    nloc = mine > 0u ? mine : 1u; nx = cnt > 0u ? cnt : 1u;
}

__device__ __forceinline__ void xcd_barrier(const XcdBarrier& b) {
    asm volatile("s_waitcnt vmcnt(0)" ::: "memory");
    __syncthreads();
    if (otid() == 0) {
        unsigned* bar = b.bar;
        __builtin_amdgcn_s_waitcnt(0);
        unsigned nloc = b.st[0], nx = b.st[1];
        if (nloc == 0u) { xcd_barrier_complete(bar, b.x, nloc, nx); b.st[0] = nloc; b.st[1] = nx; }
        const unsigned old = xb_add(&bar[XB_XSUB(b.x)], 1u);
        const unsigned gen = old / nloc;
        if (old + 1u == (gen + 1u) * nloc) {
            __builtin_amdgcn_fence(__ATOMIC_RELEASE, "agent");
            asm volatile("s_waitcnt vmcnt(0)" ::: "memory");
            const unsigned og = xb_add(&bar[XB_TOP], 1u);
            const unsigned tg = og / nx;
            if (og + 1u == (tg + 1u) * nx) xb_add(&bar[XB_TOPGEN], 1u);
            else XB_SPIN(xb_ld(&bar[XB_TOPGEN]) == tg, bar);
            __builtin_amdgcn_fence(__ATOMIC_ACQUIRE, "agent");
            xb_add(&bar[XB_XGEN(b.x)], 1u);
            asm volatile("s_waitcnt vmcnt(0)" ::: "memory");
        } else {
            XB_SPIN(xb_ld(&bar[XB_XGEN(b.x)]) == gen, bar);
            __builtin_amdgcn_fence(__ATOMIC_ACQUIRE, "agent");
            asm volatile("s_waitcnt vmcnt(0)" ::: "memory");
        }
    }
    __syncthreads();
}

__device__ __forceinline__ float bf2f(unsigned b) { return __builtin_bit_cast(float, b << 16); }
typedef float f32x2_t __attribute__((ext_vector_type(2)));
typedef __bf16 bf16x2_t __attribute__((ext_vector_type(2)));
__device__ __forceinline__ unsigned pk2(float lo, float hi) { const f32x2_t v = {lo, hi}; const bf16x2_t b = __builtin_convertvector(v, bf16x2_t); return __builtin_bit_cast(unsigned, b); }
__device__ __forceinline__ unsigned f2bf(float f) { return pk2(f, f) & 0xffffu; }
__device__ __forceinline__ float h2f(unsigned h) { return (float)__builtin_bit_cast(_Float16, (u16)h); }
__device__ __forceinline__ unsigned f2h(float f) { return (unsigned)__builtin_bit_cast(u16, (_Float16)f); }
__device__ __forceinline__ unsigned pk2h(float lo, float hi) { return f2h(lo) | (f2h(hi) << 16); }
#define UNPACK8_BF(v, o) do { o[0] = bf2f((v).x & 0xffffu); o[1] = __builtin_bit_cast(float, (v).x & 0xffff0000u); o[2] = bf2f((v).y & 0xffffu); o[3] = __builtin_bit_cast(float, (v).y & 0xffff0000u); \
    o[4] = bf2f((v).z & 0xffffu); o[5] = __builtin_bit_cast(float, (v).z & 0xffff0000u); o[6] = bf2f((v).w & 0xffffu); o[7] = __builtin_bit_cast(float, (v).w & 0xffff0000u); } while (0)
#define UNPACK8_H(v, o) do { o[0] = h2f((v).x & 0xffffu); o[1] = h2f((v).x >> 16); o[2] = h2f((v).y & 0xffffu); o[3] = h2f((v).y >> 16); \
    o[4] = h2f((v).z & 0xffffu); o[5] = h2f((v).z >> 16); o[6] = h2f((v).w & 0xffffu); o[7] = h2f((v).w >> 16); } while (0)
#define PACK8_BF(o) make_uint4(pk2(o[0], o[1]), pk2(o[2], o[3]), pk2(o[4], o[5]), pk2(o[6], o[7]))
#define PACK8_H(o) make_uint4(pk2h(o[0], o[1]), pk2h(o[2], o[3]), pk2h(o[4], o[5]), pk2h(o[6], o[7]))
__device__ __forceinline__ float sigmoidf_(float x) { return __builtin_amdgcn_rcpf(1.f + __expf(-x)); }
__device__ __forceinline__ float siluf_(float x) { return x * __builtin_amdgcn_rcpf(1.f + __expf(-x)); }
__device__ __forceinline__ float tanhf_(float x) { x = fminf(fmaxf(x, -15.f), 15.f); const float t = __expf(2.f * x); return (t - 1.f) * __builtin_amdgcn_rcpf(t + 1.f); }
__device__ __forceinline__ float softplusf_(float x) { return fmaxf(x, 0.f) + log1pf(__expf(-fabsf(x))); }
__device__ __forceinline__ float dppf(float x, const int ctrl_sel) {
    const int v = __builtin_bit_cast(int, x); int r;
    if (ctrl_sel == 0) r = __builtin_amdgcn_update_dpp(0, v, 0xB1, 0xF, 0xF, true);
    else if (ctrl_sel == 1) r = __builtin_amdgcn_update_dpp(0, v, 0x4E, 0xF, 0xF, true);
    else if (ctrl_sel == 2) r = __builtin_amdgcn_update_dpp(0, v, 0x141, 0xF, 0xF, true);
    else r = __builtin_amdgcn_update_dpp(0, v, 0x140, 0xF, 0xF, true);
    return __builtin_bit_cast(float, r);
}
__device__ __forceinline__ float red4(float x) { x += dppf(x, 0); x += dppf(x, 1); return x; }
__device__ __forceinline__ float red8(float x) { x = red4(x); x += dppf(x, 2); return x; }
__device__ __forceinline__ float red16(float x) { x = red8(x); x += dppf(x, 3); return x; }
__device__ __forceinline__ float lane_xor(float x, int m) { return __builtin_bit_cast(float, __builtin_amdgcn_ds_bpermute((((otid() & 63) ^ m) << 2), __builtin_bit_cast(int, x))); }
__device__ __forceinline__ float red32(float x) { x = red16(x); x += lane_xor(x, 16); return x; }
__device__ __forceinline__ float red64(float x) { x = red32(x); x += lane_xor(x, 32); return x; }

struct EpiPlain {
    static constexpr bool PERM = true, AFTER_DRAIN = false;
    u16* O; int ld, col_base, shift_from, shift, nvalid;
    __device__ __forceinline__ void operator()(const f32x4 (&acc)[2][2][4][2], const pg8::Unit& u, int wr, int wc, int fr, int fq) const {
        asm volatile("" : "+v"(fr), "+v"(fq));
        const int row0 = u.pm * 256 + wr * 64 + fr, col0 = u.pn * 256 + wc * 32 + 8 * fq, cadd = col_base + (u.pn >= shift_from ? shift : 0);
#pragma unroll
        for (int ai = 0; ai < 2; ++ai)
#pragma unroll
            for (int m = 0; m < 4; ++m)
#pragma unroll
                for (int bj = 0; bj < 2; ++bj) {
                    const f32x4 v0 = acc[ai][bj][m][0], v1 = acc[ai][bj][m][1];
                    if (col0 + bj * 128 < nvalid)
                        *(uint4*)(O + (size_t)(row0 + ai * 128 + m * 16) * ld + cadd + col0 + bj * 128) = make_uint4(pk2(v0[0], v0[1]), pk2(v0[2], v0[3]), pk2(v1[0], v1[1]), pk2(v1[2], v1[3]));
                }
    }
};
struct EpiResid {
    static constexpr bool PERM = true, AFTER_DRAIN = false;
    const float* hin; float* out;
    __device__ __forceinline__ void operator()(const f32x4 (&acc)[2][2][4][2], const pg8::Unit& u, int wr, int wc, int fr, int fq) const {
        asm volatile("" : "+v"(fr), "+v"(fq));
        const int row0 = u.pm * 256 + wr * 64 + fr, col0 = u.pn * 256 + wc * 32 + 8 * fq;
#pragma unroll
        for (int ai = 0; ai < 2; ++ai)
#pragma unroll
            for (int m = 0; m < 4; ++m)
#pragma unroll
                for (int bj = 0; bj < 2; ++bj) {
                    const size_t o = (size_t)(row0 + ai * 128 + m * 16) * DM + col0 + bj * 128;
                    const float4 a = *(const float4*)(hin + o), b = *(const float4*)(hin + o + 4);
                    const f32x4 v0 = acc[ai][bj][m][0], v1 = acc[ai][bj][m][1];
                    *(float4*)(out + o) = make_float4(a.x + v0[0], a.y + v0[1], a.z + v0[2], a.w + v0[3]);
                    *(float4*)(out + o + 4) = make_float4(b.x + v1[0], b.y + v1[1], b.z + v1[2], b.w + v1[3]);
                }
    }
};
struct EpiFfn {
    static constexpr bool PERM = true, AFTER_DRAIN = false;
    u16* ACT;
    __device__ __forceinline__ void operator()(const f32x4 (&acc)[2][2][4][2], const pg8::Unit& u, int wr, int wc, int fr, int fq) const {
        asm volatile("" : "+v"(fr), "+v"(fq));
        const int row0 = u.pm * 256 + wr * 64 + fr, col0 = u.pn * 128 + wc * 32 + 8 * fq;
#pragma unroll
        for (int ai = 0; ai < 2; ++ai)
#pragma unroll
            for (int m = 0; m < 4; ++m) {
                float o[8];
#pragma unroll
                for (int n = 0; n < 2; ++n)
#pragma unroll
                    for (int e = 0; e < 4; ++e) o[n * 4 + e] = siluf_(acc[ai][0][m][n][e]) * acc[ai][1][m][n][e];
                *(uint4*)(ACT + (size_t)(row0 + ai * 128 + m * 16) * DFF + col0) = PACK8_BF(o);
            }
    }
};
struct EpiGlu {
    static constexpr bool PERM = true, AFTER_DRAIN = false;
    const u16* YG; const float* gb; u16* O;
    __device__ __forceinline__ void operator()(const f32x4 (&acc)[2][2][4][2], const pg8::Unit& u, int wr, int wc, int fr, int fq) const {
        asm volatile("" : "+v"(fr), "+v"(fq));
        const int row0 = u.pm * 256 + wr * 64 + fr, col0 = u.pn * 256 + wc * 32 + 8 * fq;
#pragma unroll
        for (int bj = 0; bj < 2; ++bj) {
            const int col = col0 + bj * 128;
            float bb[8];
#pragma unroll
            for (int e = 0; e < 8; ++e) bb[e] = gb[col + e];
#pragma unroll
            for (int ai = 0; ai < 2; ++ai)
#pragma unroll
                for (int m = 0; m < 4; ++m) {
                    const int row = row0 + ai * 128 + m * 16;
                    const uint4 yv = *(const uint4*)(YG + (size_t)row * 512 + col);
                    float y[8], o[8]; UNPACK8_BF(yv, y);
#pragma unroll
                    for (int n = 0; n < 2; ++n)
#pragma unroll
                        for (int e = 0; e < 4; ++e) o[n * 4 + e] = y[n * 4 + e] * sigmoidf_(acc[ai][bj][m][n][e] + bb[n * 4 + e]);
                    *(uint4*)(O + (size_t)row * DM + 512 + col) = PACK8_BF(o);
                }
        }
    }
};
struct EpiEven {
    static constexpr bool PERM = true, AFTER_DRAIN = false;
    u16* P; float* DT; const float* lbp; const float* dtb; int j;
    __device__ __forceinline__ void operator()(const f32x4 (&acc)[2][2][4][2], const pg8::Unit& u, int wr, int wc, int fr, int fq) const {
        asm volatile("" : "+v"(fr), "+v"(fq));
        const int pn = u.pn, row0 = u.pm * 256 + wr * 64 + fr;
        if (pn == 16) {
            if (wc == 0 && fq < 2) {
                float bias[8];
#pragma unroll
                for (int e = 0; e < 8; ++e) bias[e] = dtb[8 * fq + e];
#pragma unroll
                for (int ai = 0; ai < 2; ++ai)
#pragma unroll
                    for (int m = 0; m < 4; ++m) {
                        float o[8];
#pragma unroll
                        for (int n = 0; n < 2; ++n)
#pragma unroll
                            for (int e = 0; e < 4; ++e) o[n * 4 + e] = softplusf_(acc[ai][0][m][n][e] + bias[n * 4 + e]);
                        float* d = DT + (size_t)(row0 + ai * 128 + m * 16) * 16 + 8 * fq;
                        *(float4*)d = make_float4(o[0], o[1], o[2], o[3]); *(float4*)(d + 4) = make_float4(o[4], o[5], o[6], o[7]);
                    }
            }
            return;
        }
        const int region = pn >> 1;
#pragma unroll
        for (int bj = 0; bj < 2; ++bj) {
            const int col = pn * 256 + bj * 128 + wc * 32 + 8 * fq;
            float oml[8];
#pragma unroll
            for (int e = 0; e < 8; ++e) oml[e] = 1.f;
            if (region == 1 || region == 2) {
                const int c = col - region * 512;
#pragma unroll
                for (int e = 0; e < 8; ++e) oml[e] = (j == 0) ? 1.f : 1.f - sigmoidf_(lbp[512 + c + e] - lbp[c + e]);
            }
#pragma unroll
            for (int ai = 0; ai < 2; ++ai)
#pragma unroll
                for (int m = 0; m < 4; ++m) {
                    float x[8];
#pragma unroll
                    for (int n = 0; n < 2; ++n)
#pragma unroll
                        for (int e = 0; e < 4; ++e) x[n * 4 + e] = acc[ai][bj][m][n][e];
                    uint4 w;
                    if (region == 0) {
#pragma unroll
                        for (int e = 0; e < 8; ++e) x[e] = siluf_(x[e]) * 0.08838834764831845f;
                        w = PACK8_BF(x);
                    } else if (region == 1 || region == 2) {
#pragma unroll
                        for (int e = 0; e < 8; ++e) x[e] = oml[e] * sigmoidf_(-x[e]);
                        w = PACK8_H(x);
                    } else if (region == 4 || region == 5) {
#pragma unroll
                        for (int e = 0; e < 8; ++e) x[e] = siluf_(x[e]);
                        w = PACK8_BF(x);
                    } else {
                        w = PACK8_BF(x);
                    }
                    *(uint4*)(P + (size_t)(row0 + ai * 128 + m * 16) * EV_N + col) = w;
                }
        }
    }
};

__device__ __forceinline__ void convert_weight(const float* W, int K, int ld, int nvalid, int mode, u16* WT, int Nout, unsigned char* lds, int& item, int gsz) {
    float* tile = (float*)lds;
    const int tid = otid();
    const int nk = K / 64, nn = Nout / 128, total = nk * nn;
    for (; item < total; item += gsz) {
        const int tn = item / nk, tk = item % nk, n0 = tn * 128, k0 = tk * 64;
        int sc0 = n0; if (mode == 1) { const int t = n0 >> 8, b = (n0 >> 7) & 1; sc0 = b * DFF + 128 * t; }
        else if (mode == 2) sc0 = (n0 < 1536) ? n0 : n0 + 224;
        else if (mode == 3) sc0 = n0 + 1536;
        float v[16];
#pragma unroll
        for (int i = 0; i < 16; ++i) {
            const int kk = (tid >> 7) + 4 * i, nnn = tid & 127;
            v[i] = (n0 + nnn < nvalid) ? W[(size_t)(k0 + kk) * ld + sc0 + nnn] : 0.f;
        }
        __syncthreads();
#pragma unroll
        for (int i = 0; i < 16; ++i) tile[((tid >> 7) + 4 * i) * 129 + (tid & 127)] = v[i];
        __syncthreads();
        const int on = tid >> 2, kc = tid & 3;
        float o[16];
#pragma unroll
        for (int e = 0; e < 16; ++e) o[e] = tile[(kc * 16 + e) * 129 + on];
        *(uint4*)(WT + (size_t)(n0 + on) * K + k0 + kc * 16) = make_uint4(pk2(o[0], o[1]), pk2(o[2], o[3]), pk2(o[4], o[5]), pk2(o[6], o[7]));
        *(uint4*)(WT + (size_t)(n0 + on) * K + k0 + kc * 16 + 8) = make_uint4(pk2(o[8], o[9]), pk2(o[10], o[11]), pk2(o[12], o[13]), pk2(o[14], o[15]));
    }
    item -= total;
}

__device__ __forceinline__ void norm_rows_bf16(const float* h, const float* w, u16* o) {
    const int lane = otid() & 63, gw = obid() * 8 + (otid() >> 6), nw = gridDim.x * 8;
    float4 wv[4];
#pragma unroll
    for (int i = 0; i < 4; ++i) wv[i] = *(const float4*)(w + lane * 4 + 256 * i);
    for (int row0 = gw * 4; row0 < T_TOK; row0 += nw * 4) {
        float4 v[4][4]; float ss[4];
#pragma unroll
        for (int r = 0; r < 4; ++r)
#pragma unroll
            for (int i = 0; i < 4; ++i) v[r][i] = *(const float4*)(h + (size_t)(row0 + r) * DM + lane * 4 + 256 * i);
#pragma unroll
        for (int r = 0; r < 4; ++r) {
            float a = 0.f;
#pragma unroll
            for (int i = 0; i < 4; ++i) a += v[r][i].x * v[r][i].x + v[r][i].y * v[r][i].y + v[r][i].z * v[r][i].z + v[r][i].w * v[r][i].w;
            ss[r] = a;
        }
#pragma unroll
        for (int r = 0; r < 4; ++r) ss[r] = red64(ss[r]);
#pragma unroll
        for (int r = 0; r < 4; ++r) {
            const float rs = rsqrtf(ss[r] * (1.f / DM) + 1e-6f);
#pragma unroll
            for (int i = 0; i < 4; ++i)
                *(uint2*)(o + (size_t)(row0 + r) * DM + lane * 4 + 256 * i) = make_uint2(pk2(v[r][i].x * rs * wv[i].x, v[r][i].y * rs * wv[i].y), pk2(v[r][i].z * rs * wv[i].z, v[r][i].w * rs * wv[i].w));
        }
    }
}
__device__ __forceinline__ void norm_rows_f32_inplace(float* h, const float* w) {
    const int lane = otid() & 63, gw = obid() * 8 + (otid() >> 6), nw = gridDim.x * 8;
    float4 wv[4];
#pragma unroll
    for (int i = 0; i < 4; ++i) wv[i] = *(const float4*)(w + lane * 4 + 256 * i);
    for (int row = gw; row < T_TOK; row += nw) {
        float4 v[4]; float ss = 0.f;
#pragma unroll
        for (int i = 0; i < 4; ++i) { v[i] = *(const float4*)(h + (size_t)row * DM + lane * 4 + 256 * i); ss += v[i].x * v[i].x + v[i].y * v[i].y + v[i].z * v[i].z + v[i].w * v[i].w; }
        ss = red64(ss);
        const float r = rsqrtf(ss * (1.f / DM) + 1e-6f);
#pragma unroll
        for (int i = 0; i < 4; ++i)
            *(float4*)(h + (size_t)row * DM + lane * 4 + 256 * i) = make_float4(v[i].x * r * wv[i].x, v[i].y * r * wv[i].y, v[i].z * r * wv[i].z, v[i].w * r * wv[i].w);
    }
}

#define ST8F(dst, o) do { *(float4*)(dst) = make_float4(o[0], o[1], o[2], o[3]); *(float4*)((dst) + 4) = make_float4(o[4], o[5], o[6], o[7]); } while (0)
#define TIME_ROW(seg, s, dir, b) ((b) * SEQ + ((dir) ? (SEQ - 1 - ((seg) * LSEG + (s))) : ((seg) * LSEG + (s))))

template <int PASS>
__device__ __forceinline__ void hg_scan(const Params& p, unsigned char* lds) {
    const int tid = otid();
    float* Lk = (float*)lds;
    float* Lq = Lk + 32 * 144;
    float* Lv = Lq + 32 * 144;
    u16* Lo = (u16*)(Lv + 32 * 128);
    const u16* P = (const u16*)(WSP(p) + WS_P);
    float* LC = (float*)(WSP(p) + EV_ALC); float* DEC = (float*)(WSP(p) + EV_ADEC);
    const int v = tid >> 2, kg = tid & 3, lrow = tid >> 4, lch = (tid & 15) * 8;
    const int lko = lrow * 144 + (lch >> 5) * 36 + (lch & 31);
    for (int unit = obid(); unit < 256; unit += gridDim.x) {
        const int seg = unit & 15, h = (unit >> 4) & 3, b = (unit >> 6) & 1, dir = unit >> 7;
        u16* AO = (u16*)(WSP(p) + (dir ? EV_AOB : EV_AOF));
        float S[32];
#pragma unroll
        for (int i = 0; i < 32; ++i) S[i] = (PASS == 1) ? 0.f : LC[(size_t)unit * 16384 + (kg * 32 + i) * 128 + v];
        float Dk = 1.f;
        uint4 rk, rv, rq = make_uint4(0, 0, 0, 0);
        {
            const u16* base = P + (size_t)TIME_ROW(seg, lrow, dir, b) * EV_N + h * 128 + lch;
            rk = *(const uint4*)(base + 512 + dir * 512); rv = *(const uint4*)(base + 1536); if (PASS == 3) rq = *(const uint4*)(base);
        }
        for (int tile = 0; tile < LSEG / 32; ++tile) {
            __syncthreads();
            { float f[8]; UNPACK8_H(rk, f); ST8F(Lk + lko, f); UNPACK8_BF(rv, f); ST8F(Lv + lrow * 128 + lch, f); if (PASS == 3) { UNPACK8_BF(rq, f); ST8F(Lq + lko, f); } }
            __syncthreads();
            if (tile + 1 < LSEG / 32) {
                const u16* base = P + (size_t)TIME_ROW(seg, (tile + 1) * 32 + lrow, dir, b) * EV_N + h * 128 + lch;
                rk = *(const uint4*)(base + 512 + dir * 512); rv = *(const uint4*)(base + 1536); if (PASS == 3) rq = *(const uint4*)(base);
            }
            for (int s = 0; s < 32; ++s) {
                const float vs = Lv[s * 128 + v];
                float o = 0.f;
#pragma unroll
                for (int i4 = 0; i4 < 8; ++i4) {
                    const float4 kk = *(const float4*)(Lk + s * 144 + kg * 36 + i4 * 4);
                    S[i4 * 4 + 0] = fmaf(kk.x, vs - S[i4 * 4 + 0], S[i4 * 4 + 0]);
                    S[i4 * 4 + 1] = fmaf(kk.y, vs - S[i4 * 4 + 1], S[i4 * 4 + 1]);
                    S[i4 * 4 + 2] = fmaf(kk.z, vs - S[i4 * 4 + 2], S[i4 * 4 + 2]);
                    S[i4 * 4 + 3] = fmaf(kk.w, vs - S[i4 * 4 + 3], S[i4 * 4 + 3]);
                    if (PASS == 3) {
                        const float4 qq = *(const float4*)(Lq + s * 144 + kg * 36 + i4 * 4);
                        o = fmaf(S[i4 * 4 + 0], qq.x, o); o = fmaf(S[i4 * 4 + 1], qq.y, o); o = fmaf(S[i4 * 4 + 2], qq.z, o); o = fmaf(S[i4 * 4 + 3], qq.w, o);
                    }
                }
                if (PASS == 3) { o = red4(o); if (kg == 0) Lo[s * 128 + v] = (u16)f2bf(o); }
            }
            if (PASS == 1) { if (tid < 128) { for (int s = 0; s < 32; ++s) Dk *= 1.f - Lk[s * 144 + (tid >> 5) * 36 + (tid & 31)]; } }
            if (PASS == 3) {
                __syncthreads();
                const uint4 ov = *(const uint4*)(Lo + lrow * 128 + lch);
                *(uint4*)(AO + (size_t)TIME_ROW(seg, tile * 32 + lrow, dir, b) * 512 + h * 128 + lch) = ov;
            }
        }
        if (PASS == 1) {
#pragma unroll
            for (int i = 0; i < 32; ++i) LC[(size_t)unit * 16384 + (kg * 32 + i) * 128 + v] = S[i];
            if (tid < 128) DEC[unit * 128 + tid] = Dk;
        }
    }
    __syncthreads();
}

template <int PASS>
__device__ __forceinline__ void m2_scan(const Params& p, int j, unsigned char* lds) {
    const int tid = otid();
    float* Lx = (float*)lds;
    float* LB = Lx + 32 * 64;
    float* LCm = LB + 32 * 160;
    float* Ldt = LCm + 32 * 160;
    float* LdA = Ldt + 32;
    u16* Lo = (u16*)(LdA + 32);
    const u16* XB = (const u16*)(WSP(p) + EV_XBC);
    const float* DT = (const float*)(WSP(p) + EV_DT);
    float* LC = (float*)(WSP(p) + EV_BLC); float* DEC = (float*)(WSP(p) + EV_BDEC);
    const int pp = tid >> 3, ng = tid & 7;
    const int xrow = (tid & 255) >> 3, xch = (tid & 7) * 8;
    const int brow = tid >> 4, bch = (tid & 15) * 8;
    const int lbo = brow * 160 + (bch >> 4) * 20 + (bch & 15);
    for (int unit = obid(); unit < 512; unit += gridDim.x) {
        const int seg = unit & 15, hd = (unit >> 4) & 7, b = (unit >> 7) & 1, dir = unit >> 8, g = hd >> 2;
        u16* YO = (u16*)(WSP(p) + (dir ? EV_BYB : EV_BYF));
        const float a = -__expf(INP(p, I_M2ALOG)[(j * 2 + dir) * 8 + hd]);
        float hS[16];
#pragma unroll
        for (int i = 0; i < 16; ++i) hS[i] = (PASS == 1) ? 0.f : LC[(size_t)unit * 8192 + pp * 128 + ng * 16 + i];
        float dsum = 0.f;
        uint4 rx = make_uint4(0, 0, 0, 0), rb, rc = make_uint4(0, 0, 0, 0); float rdt = 0.f;
        {
            if (tid < 256) rx = *(const uint4*)(XB + (size_t)TIME_ROW(seg, xrow, dir, b) * 1024 + hd * 64 + xch);
            const u16* base = XB + (size_t)TIME_ROW(seg, brow, dir, b) * 1024 + 512 + g * 128 + bch;
            rb = *(const uint4*)base; if (PASS == 3) rc = *(const uint4*)(base + 256);
            if (tid < 32) rdt = DT[(size_t)TIME_ROW(seg, tid, dir, b) * 16 + dir * 8 + hd];
        }
        for (int tile = 0; tile < LSEG / 32; ++tile) {
            __syncthreads();
            { float f[8]; if (tid < 256) { UNPACK8_BF(rx, f); ST8F(Lx + xrow * 64 + xch, f); } UNPACK8_BF(rb, f); ST8F(LB + lbo, f); if (PASS == 3) { UNPACK8_BF(rc, f); ST8F(LCm + lbo, f); }
              if (tid < 32) { Ldt[tid] = rdt; LdA[tid] = __expf(rdt * a); } }
            __syncthreads();
            if (tile + 1 < LSEG / 32) {
                const int s0 = (tile + 1) * 32;
                if (tid < 256) rx = *(const uint4*)(XB + (size_t)TIME_ROW(seg, s0 + xrow, dir, b) * 1024 + hd * 64 + xch);
                const u16* base = XB + (size_t)TIME_ROW(seg, s0 + brow, dir, b) * 1024 + 512 + g * 128 + bch;
                rb = *(const uint4*)base; if (PASS == 3) rc = *(const uint4*)(base + 256);
                if (tid < 32) rdt = DT[(size_t)TIME_ROW(seg, s0 + tid, dir, b) * 16 + dir * 8 + hd];
            }
            for (int s = 0; s < 32; ++s) {
                const float dt = Ldt[s], dA = LdA[s], xdt = dt * Lx[s * 64 + pp];
                dsum += dt * a;
                float y = 0.f;
#pragma unroll
                for (int i4 = 0; i4 < 4; ++i4) {
                    const float4 bv = *(const float4*)(LB + s * 160 + ng * 20 + i4 * 4);
                    hS[i4 * 4 + 0] = fmaf(hS[i4 * 4 + 0], dA, xdt * bv.x);
                    hS[i4 * 4 + 1] = fmaf(hS[i4 * 4 + 1], dA, xdt * bv.y);
                    hS[i4 * 4 + 2] = fmaf(hS[i4 * 4 + 2], dA, xdt * bv.z);
                    hS[i4 * 4 + 3] = fmaf(hS[i4 * 4 + 3], dA, xdt * bv.w);
                    if (PASS == 3) {
                        const float4 cv = *(const float4*)(LCm + s * 160 + ng * 20 + i4 * 4);
                        y = fmaf(hS[i4 * 4 + 0], cv.x, y); y = fmaf(hS[i4 * 4 + 1], cv.y, y); y = fmaf(hS[i4 * 4 + 2], cv.z, y); y = fmaf(hS[i4 * 4 + 3], cv.w, y);
                    }
                }
                if (PASS == 3) { y = red8(y); if (ng == 0) Lo[s * 64 + pp] = (u16)f2bf(y); }
            }
            if (PASS == 3) {
                __syncthreads();
                if (tid < 256) {
                    const uint4 ov = *(const uint4*)(Lo + xrow * 64 + xch);
                    *(uint4*)(YO + (size_t)TIME_ROW(seg, tile * 32 + xrow, dir, b) * 512 + hd * 64 + xch) = ov;
                }
            }
        }
        if (PASS == 1) {
#pragma unroll
            for (int i = 0; i < 16; ++i) LC[(size_t)unit * 8192 + pp * 128 + ng * 16 + i] = hS[i];
            if (tid == 0) DEC[unit] = __expf(dsum);
        }
    }
    __syncthreads();
}


__device__ __forceinline__ void lbar() { asm volatile("s_waitcnt lgkmcnt(0)" ::: "memory"); __builtin_amdgcn_s_barrier(); asm volatile("" ::: "memory"); }
typedef short bf16x8_t __attribute__((ext_vector_type(8)));
__device__ __forceinline__ f32x4 mma16(bf16x8_t a, bf16x8_t b, f32x4 c) { return __builtin_amdgcn_mfma_f32_16x16x32_bf16(a, b, c, 0, 0, 0); }
__device__ __forceinline__ bf16x8_t ldfrag(const u16* base, int ld, int r0, int k0, int lane) { return *(const bf16x8_t*)(base + (r0 + (lane & 15)) * ld + k0 + 8 * (lane >> 4)); }

template <int PASS>
__device__ __forceinline__ void hg_mma(const Params& p, unsigned char* lds) {
    const int tid = otid(), lane = tid & 63, wave = tid >> 6, l15 = lane & 15, lq = lane >> 4;
    u16* Qs = (u16*)lds;
    u16* Kp = Qs + 32 * 136;
    u16* Kt = Kp + 32 * 136;
    u16* Vt = Kt + 128 * 40;
    u16* Pm = Vt + 128 * 40;
    u16* St = Pm + 32 * 40;
    u16* Ob = St + 128 * 136;
    float* Lb = (float*)(Ob + 32 * 128);
    float* Lpart = Lb + 32 * 128;
    float* Ldec = Lpart + 4 * 128;
    u16* Lk1h = (u16*)(Ldec + 128);
    u16* Lvh = Lk1h + 32 * 128;
    const u16* P = (const u16*)(WSP(p) + WS_P);
    float* LC = (float*)(WSP(p) + EV_ALC); float* DEC = (float*)(WSP(p) + EV_ADEC);
    const int lrow = tid >> 4, lch = (tid & 15) * 8;
    for (int unit = obid(); unit < 256; unit += gridDim.x) {
        const int seg = unit & 15, h = (unit >> 4) & 3, b = (unit >> 6) & 1, dir = unit >> 7;
        u16* AO = (u16*)(WSP(p) + (dir ? EV_AOB : EV_AOF));
        f32x4 S[8];
#pragma unroll
        for (int vt = 0; vt < 8; ++vt)
#pragma unroll
            for (int r = 0; r < 4; ++r) S[vt][r] = (PASS == 1) ? 0.f : LC[(size_t)unit * 16384 + (wave * 16 + lq * 4 + r) * 128 + vt * 16 + l15];
        __syncthreads();
        if (PASS == 3) {
#pragma unroll
            for (int vt = 0; vt < 8; ++vt) *(uint2*)(St + (vt * 16 + l15) * 136 + wave * 16 + lq * 4) = make_uint2(pk2(S[vt][0], S[vt][1]), pk2(S[vt][2], S[vt][3]));
        }
        float ltot = 0.f;
        uint4 rk, rv, rq = make_uint4(0, 0, 0, 0);
        {
            const u16* base = P + (size_t)TIME_ROW(seg, lrow, dir, b) * EV_N + h * 128 + lch;
            rk = *(const uint4*)(base + 512 + dir * 512); rv = *(const uint4*)(base + 1536); if (PASS == 3) rq = *(const uint4*)(base);
        }
        for (int chunk = 0; chunk < LSEG / 32; ++chunk) {
            float k1f[8], qf[8], vf[8];
            UNPACK8_H(rk, k1f); UNPACK8_BF(rv, vf); UNPACK8_BF(rq, qf);
            lbar();
            {
                float lg[8];
#pragma unroll
                for (int e = 0; e < 8; ++e) lg[e] = fmaxf(__logf(1.f - k1f[e]), -30.f);
                ST8F(Lb + lrow * 128 + lch, lg);
                *(uint4*)(Lk1h + lrow * 128 + lch) = rk; *(uint4*)(Lvh + lrow * 128 + lch) = rv;
            }
            if (chunk + 1 < LSEG / 32) {
                const u16* base = P + (size_t)TIME_ROW(seg, (chunk + 1) * 32 + lrow, dir, b) * EV_N + h * 128 + lch;
                rk = *(const uint4*)(base + 512 + dir * 512); rv = *(const uint4*)(base + 1536); if (PASS == 3) rq = *(const uint4*)(base);
            }
            lbar();
            {
                const int k = tid & 127, tg = tid >> 7;
                float c8[8]; float run = 0.f;
#pragma unroll
                for (int i = 0; i < 8; ++i) { run += Lb[(tg * 8 + i) * 128 + k]; c8[i] = run; }
                Lpart[tg * 128 + k] = run;
                lbar();
                float off = 0.f;
#pragma unroll
                for (int g2 = 0; g2 < 3; ++g2) off += (g2 < tg) ? Lpart[g2 * 128 + k] : 0.f;
#pragma unroll
                for (int i = 0; i < 8; ++i) Lb[(tg * 8 + i) * 128 + k] = c8[i] + off;
                if (tg == 3) { Ldec[k] = c8[7] + off; ltot += c8[7] + off; }
            }
            lbar();
            {
                float bb[8], bt[8], o1[8], o2[8];
                { const float4 x0 = *(const float4*)(Lb + lrow * 128 + lch), x1 = *(const float4*)(Lb + lrow * 128 + lch + 4); bb[0] = x0.x; bb[1] = x0.y; bb[2] = x0.z; bb[3] = x0.w; bb[4] = x1.x; bb[5] = x1.y; bb[6] = x1.z; bb[7] = x1.w; }
                { const float4 x0 = *(const float4*)(Ldec + lch), x1 = *(const float4*)(Ldec + lch + 4); bt[0] = x0.x; bt[1] = x0.y; bt[2] = x0.z; bt[3] = x0.w; bt[4] = x1.x; bt[5] = x1.y; bt[6] = x1.z; bt[7] = x1.w; }
                if (PASS == 3) {
#pragma unroll
                    for (int e = 0; e < 8; ++e) { o1[e] = qf[e] * __expf(bb[e]); o2[e] = k1f[e] * __expf(fminf(-bb[e], 80.f)); }
                    *(uint4*)(Qs + lrow * 136 + lch) = PACK8_BF(o1);
                    *(uint4*)(Kp + lrow * 136 + lch) = PACK8_BF(o2);
                }
            }
            {
                const int k = tid & 127, tq = tid >> 7; const float btk = Ldec[k];
                float o[8]; unsigned vb[8];
#pragma unroll
                for (int e = 0; e < 8; ++e) { const int t = tq * 8 + e; o[e] = h2f(Lk1h[t * 128 + k]) * __expf(btk - Lb[t * 128 + k]); vb[e] = Lvh[t * 128 + k]; }
                *(uint4*)(Kt + k * 40 + tq * 8) = PACK8_BF(o);
                *(uint4*)(Vt + k * 40 + tq * 8) = make_uint4(vb[0] | (vb[1] << 16), vb[2] | (vb[3] << 16), vb[4] | (vb[5] << 16), vb[6] | (vb[7] << 16));
            }
            lbar();
            f32x4 o0 = {0.f, 0.f, 0.f, 0.f}, o1v = {0.f, 0.f, 0.f, 0.f};
            if (PASS == 3) {
#pragma unroll
                for (int ks = 0; ks < 4; ++ks) {
                    const bf16x8_t bf = ldfrag(St, 136, wave * 16, ks * 32, lane);
                    o0 = mma16(ldfrag(Qs, 136, 0, ks * 32, lane), bf, o0);
                    o1v = mma16(ldfrag(Qs, 136, 16, ks * 32, lane), bf, o1v);
                }
                if (wave < 4) {
                    const int ti = wave >> 1, si = wave & 1;
                    f32x4 am = {0.f, 0.f, 0.f, 0.f};
#pragma unroll
                    for (int ks = 0; ks < 4; ++ks) am = mma16(ldfrag(Qs, 136, ti * 16, ks * 32, lane), ldfrag(Kp, 136, si * 16, ks * 32, lane), am);
#pragma unroll
                    for (int r = 0; r < 4; ++r) { const int t = ti * 16 + lq * 4 + r, s = si * 16 + l15; Pm[t * 40 + s] = (u16)f2bf(s <= t ? am[r] : 0.f); }
                }
            }
            lbar();
            if (PASS == 3) {
                const bf16x8_t bf = ldfrag(Vt, 40, wave * 16, 0, lane);
                o0 = mma16(ldfrag(Pm, 40, 0, 0, lane), bf, o0);
                o1v = mma16(ldfrag(Pm, 40, 16, 0, lane), bf, o1v);
#pragma unroll
                for (int r = 0; r < 4; ++r) { Ob[(lq * 4 + r) * 128 + wave * 16 + l15] = (u16)f2bf(o0[r]); Ob[(16 + lq * 4 + r) * 128 + wave * 16 + l15] = (u16)f2bf(o1v[r]); }
            }
            {
                float d4[4];
#pragma unroll
                for (int r = 0; r < 4; ++r) d4[r] = __expf(Ldec[wave * 16 + lq * 4 + r]);
                const bf16x8_t af = ldfrag(Kt, 40, wave * 16, 0, lane);
#pragma unroll
                for (int vt = 0; vt < 8; ++vt) {
#pragma unroll
                    for (int r = 0; r < 4; ++r) S[vt][r] *= d4[r];
                    S[vt] = mma16(af, ldfrag(Vt, 40, vt * 16, 0, lane), S[vt]);
                }
                if (PASS == 3) {
#pragma unroll
                    for (int vt = 0; vt < 8; ++vt) *(uint2*)(St + (vt * 16 + l15) * 136 + wave * 16 + lq * 4) = make_uint2(pk2(S[vt][0], S[vt][1]), pk2(S[vt][2], S[vt][3]));
                }
            }
            if (PASS == 3) {
                lbar();
                const uint4 ov = *(const uint4*)(Ob + lrow * 128 + lch);
                *(uint4*)(AO + (size_t)TIME_ROW(seg, chunk * 32 + lrow, dir, b) * 512 + h * 128 + lch) = ov;
            }
        }
        if (PASS == 1) {
#pragma unroll
            for (int vt = 0; vt < 8; ++vt)
#pragma unroll
                for (int r = 0; r < 4; ++r) LC[(size_t)unit * 16384 + (wave * 16 + lq * 4 + r) * 128 + vt * 16 + l15] = S[vt][r];
            if (tid >= 384) DEC[unit * 128 + (tid & 127)] = __expf(ltot);
        }
    }
    lbar();
}

template <int PASS>
__device__ __forceinline__ void m2_mma(const Params& p, int j, unsigned char* lds) {
    const int tid = otid(), lane = tid & 63, wave = tid >> 6, l15 = lane & 15, lq = lane >> 4;
    constexpr int UB = 61184;
#define M2_QS(uu)  ((u16*)(lds + (uu) * UB))
#define M2_KP(uu)  (M2_QS(uu) + 32 * 136)
#define M2_KT(uu)  (M2_KP(uu) + 32 * 136)
#define M2_VT(uu)  (M2_KT(uu) + 128 * 40)
#define M2_PM(uu)  (M2_VT(uu) + 64 * 40)
#define M2_ST(uu)  (M2_PM(uu) + 32 * 40)
#define M2_OB(uu)  (M2_ST(uu) + 64 * 136)
#define M2_LAC(uu) ((float*)(M2_OB(uu) + 32 * 64))
#define M2_LDT(uu) (M2_LAC(uu) + 32)
#define M2_LXH(uu) ((u16*)(M2_LDT(uu) + 32))
    const u16* XB = (const u16*)(WSP(p) + EV_XBC);
    const float* DT = (const float*)(WSP(p) + EV_DT);
    float* LC = (float*)(WSP(p) + EV_BLC); float* DEC = (float*)(WSP(p) + EV_BDEC);
    const int xrow = (tid & 255) >> 3, xch = (tid & 7) * 8, brow = tid >> 4, bch = (tid & 15) * 8;
    const int ti = wave >> 2, pi = wave & 3;
    for (int up = obid(); up < 256; up += gridDim.x) {
        const int unit0 = up * 2;
        const int hd = (unit0 >> 4) & 7, b = (unit0 >> 7) & 1, dir = unit0 >> 8, g = hd >> 2, seg0 = unit0 & 15;
        u16* YO = (u16*)(WSP(p) + (dir ? EV_BYB : EV_BYF));
        const float a = -__expf(INP(p, I_M2ALOG)[(j * 2 + dir) * 8 + hd]);
        f32x4 S[2][4];
        __syncthreads();
#pragma unroll
        for (int uu = 0; uu < 2; ++uu) {
#pragma unroll
            for (int pt = 0; pt < 4; ++pt)
#pragma unroll
                for (int r = 0; r < 4; ++r) S[uu][pt][r] = (PASS == 1) ? 0.f : LC[(size_t)(unit0 + uu) * 8192 + (wave * 16 + lq * 4 + r) * 64 + pt * 16 + l15];
            if (PASS == 3) {
#pragma unroll
                for (int pt = 0; pt < 4; ++pt) *(uint2*)(M2_ST(uu) + (pt * 16 + l15) * 136 + wave * 16 + lq * 4) = make_uint2(pk2(S[uu][pt][0], S[uu][pt][1]), pk2(S[uu][pt][2], S[uu][pt][3]));
            }
        }
        float dsum0 = 0.f, dsum1 = 0.f;
        uint4 rx0, rx1, rb0, rb1, rc0, rc1; float rdt0, rdt1;
#define M2_LOAD1(sg, s0, RX, RB, RC, RDT) do { RX = make_uint4(0, 0, 0, 0); RC = make_uint4(0, 0, 0, 0); RDT = 0.f; \
            if (tid < 256) RX = *(const uint4*)(XB + (size_t)TIME_ROW(sg, (s0) + xrow, dir, b) * 1024 + hd * 64 + xch); \
            { const u16* base = XB + (size_t)TIME_ROW(sg, (s0) + brow, dir, b) * 1024 + 512 + g * 128 + bch; \
              RB = *(const uint4*)base; if (PASS == 3) RC = *(const uint4*)(base + 256); } \
            if (tid < 64) RDT = DT[(size_t)TIME_ROW(sg, (s0) + (tid & 31), dir, b) * 16 + dir * 8 + hd]; } while (0)
#define M2_LOAD(s0) do { M2_LOAD1(seg0, s0, rx0, rb0, rc0, rdt0); M2_LOAD1(seg0 + 1, s0, rx1, rb1, rc1, rdt1); } while (0)
        M2_LOAD(0);
        for (int chunk = 0; chunk < LSEG / 32; ++chunk) {
            lbar();
#pragma unroll
            for (int uu = 0; uu < 2; ++uu) {
                if (tid < 64) {
                    float val = (uu ? rdt1 : rdt0) * a;
#pragma unroll
                    for (int off = 1; off < 32; off <<= 1) { const float t = __builtin_bit_cast(float, __builtin_amdgcn_ds_bpermute((lane - off) << 2, __builtin_bit_cast(int, val))); if ((lane & 31) >= off) val += t; }
                    if (tid < 32) { M2_LAC(uu)[tid] = val; M2_LDT(uu)[tid] = (uu ? rdt1 : rdt0); }
                }
                if (PASS == 3) *(uint4*)(M2_QS(uu) + brow * 136 + bch) = (uu ? rc1 : rc0);
                *(uint4*)(M2_KP(uu) + brow * 136 + bch) = (uu ? rb1 : rb0);
                if (tid < 256) *(uint4*)(M2_LXH(uu) + xrow * 64 + xch) = (uu ? rx1 : rx0);
            }
            if (chunk + 1 < LSEG / 32) M2_LOAD((chunk + 1) * 32);
            lbar();
#pragma unroll
            for (int uu = 0; uu < 2; ++uu) {
                const int n = tid & 127, tq = tid >> 7; const float acC = M2_LAC(uu)[31];
                float o[8];
#pragma unroll
                for (int e = 0; e < 8; ++e) { const int t = tq * 8 + e; o[e] = bf2f(M2_KP(uu)[t * 136 + n]) * __expf(acC - M2_LAC(uu)[t]); }
                *(uint4*)(M2_KT(uu) + n * 40 + tq * 8) = PACK8_BF(o);
                if (tid < 256) {
                    const int pp = tid & 63, tq2 = tid >> 6;
#pragma unroll
                    for (int e = 0; e < 8; ++e) { const int t = tq2 * 8 + e; o[e] = bf2f(M2_LXH(uu)[t * 64 + pp]) * M2_LDT(uu)[t]; }
                    *(uint4*)(M2_VT(uu) + pp * 40 + tq2 * 8) = PACK8_BF(o);
                }
            }
            lbar();
            f32x4 o[2];
#pragma unroll
            for (int uu = 0; uu < 2; ++uu) {
                o[uu] = (f32x4){0.f, 0.f, 0.f, 0.f};
                if (PASS == 3) {
#pragma unroll
                    for (int ks = 0; ks < 4; ++ks) o[uu] = mma16(ldfrag(M2_QS(uu), 136, ti * 16, ks * 32, lane), ldfrag(M2_ST(uu), 136, pi * 16, ks * 32, lane), o[uu]);
#pragma unroll
                    for (int r = 0; r < 4; ++r) o[uu][r] *= __expf(M2_LAC(uu)[ti * 16 + lq * 4 + r]);
                }
            }
            if (PASS == 3) {
                const int uu = wave >> 2, w4 = wave & 3, t2 = w4 >> 1, si = w4 & 1;
                f32x4 am = {0.f, 0.f, 0.f, 0.f};
#pragma unroll
                for (int ks = 0; ks < 4; ++ks) am = mma16(ldfrag(M2_QS(uu), 136, t2 * 16, ks * 32, lane), ldfrag(M2_KP(uu), 136, si * 16, ks * 32, lane), am);
#pragma unroll
                for (int r = 0; r < 4; ++r) { const int t = t2 * 16 + lq * 4 + r, s2 = si * 16 + l15; M2_PM(uu)[t * 40 + s2] = (u16)f2bf(s2 <= t ? am[r] * __expf(M2_LAC(uu)[t] - M2_LAC(uu)[s2]) : 0.f); }
            }
            lbar();
#pragma unroll
            for (int uu = 0; uu < 2; ++uu) {
                if (PASS == 3) {
                    o[uu] = mma16(ldfrag(M2_PM(uu), 40, ti * 16, 0, lane), ldfrag(M2_VT(uu), 40, pi * 16, 0, lane), o[uu]);
#pragma unroll
                    for (int r = 0; r < 4; ++r) M2_OB(uu)[(ti * 16 + lq * 4 + r) * 64 + pi * 16 + l15] = (u16)f2bf(o[uu][r]);
                }
                const float acC = M2_LAC(uu)[31], dec = __expf(acC);
                if (uu) dsum1 += acC; else dsum0 += acC;
                const bf16x8_t af = ldfrag(M2_KT(uu), 40, wave * 16, 0, lane);
#pragma unroll
                for (int pt = 0; pt < 4; ++pt) {
#pragma unroll
                    for (int r = 0; r < 4; ++r) S[uu][pt][r] *= dec;
                    S[uu][pt] = mma16(af, ldfrag(M2_VT(uu), 40, pt * 16, 0, lane), S[uu][pt]);
                }
                if (PASS == 3) {
#pragma unroll
                    for (int pt = 0; pt < 4; ++pt) *(uint2*)(M2_ST(uu) + (pt * 16 + l15) * 136 + wave * 16 + lq * 4) = make_uint2(pk2(S[uu][pt][0], S[uu][pt][1]), pk2(S[uu][pt][2], S[uu][pt][3]));
                }
            }
            if (PASS == 3) {
                lbar();
                {
                    const int uu = tid >> 8;
                    const uint4 ov = *(const uint4*)(M2_OB(uu) + xrow * 64 + xch);
                    *(uint4*)(YO + (size_t)TIME_ROW(seg0 + uu, chunk * 32 + xrow, dir, b) * 512 + hd * 64 + xch) = ov;
                }
            }
        }
#undef M2_LOAD
#undef M2_LOAD1
        if (PASS == 1) {
#pragma unroll
            for (int uu = 0; uu < 2; ++uu) {
#pragma unroll
                for (int pt = 0; pt < 4; ++pt)
#pragma unroll
                    for (int r = 0; r < 4; ++r) LC[(size_t)(unit0 + uu) * 8192 + (wave * 16 + lq * 4 + r) * 64 + pt * 16 + l15] = S[uu][pt][r];
                if (tid == 0) DEC[unit0 + uu] = __expf(uu ? dsum1 : dsum0);
            }
        }
    }
    __syncthreads();
}

__device__ __forceinline__ void even_carry(const Params& p) {
    const int gt = obid() * 512 + otid(), gs = gridDim.x * 512;
    float* LA = (float*)(WSP(p) + EV_ALC); const float* DA = (const float*)(WSP(p) + EV_ADEC);
    for (int e = gt; e < 16 * 16384; e += gs) {
        const int seq = e >> 14, kv = e & 16383, k = kv >> 7;
        float t[NSEG], d[NSEG];
#pragma unroll
        for (int s = 0; s < NSEG; ++s) { t[s] = LA[(size_t)(seq * 16 + s) * 16384 + kv]; d[s] = DA[(seq * 16 + s) * 128 + k]; }
        float carry = 0.f;
#pragma unroll
        for (int s = 0; s < NSEG; ++s) { const float nc = fmaf(d[s], carry, t[s]); t[s] = carry; carry = nc; }
#pragma unroll
        for (int s = 0; s < NSEG; ++s) LA[(size_t)(seq * 16 + s) * 16384 + kv] = t[s];
    }
    float* LB = (float*)(WSP(p) + EV_BLC); const float* DB = (const float*)(WSP(p) + EV_BDEC);
    for (int e = gt; e < 32 * 8192; e += gs) {
        const int seq = e >> 13, pn = e & 8191;
        float t[NSEG], d[NSEG];
#pragma unroll
        for (int s = 0; s < NSEG; ++s) { t[s] = LB[(size_t)(seq * 16 + s) * 8192 + pn]; d[s] = DB[seq * 16 + s]; }
        float carry = 0.f;
#pragma unroll
        for (int s = 0; s < NSEG; ++s) { const float nc = fmaf(d[s], carry, t[s]); t[s] = carry; carry = nc; }
#pragma unroll
        for (int s = 0; s < NSEG; ++s) LB[(size_t)(seq * 16 + s) * 8192 + pn] = t[s];
    }
}

__device__ __forceinline__ void even_conv(const Params& p, int j) {
    const int gt = obid() * 512 + otid(), gs = gridDim.x * 512;
    const u16* P = (const u16*)(WSP(p) + WS_P); u16* XB = (u16*)(WSP(p) + EV_XBC);
    const float* cw = INP(p, I_M2CW) + (size_t)j * 5 * 1024; const float* cb = INP(p, I_M2CB) + (size_t)j * 1024;
    for (int e = gt; e < (T_TOK / 16) * 128; e += gs) {
        const int ch = (e & 127) * 8, row0 = (e >> 7) * 16, tpos0 = row0 & (SEQ - 1);
        float w[5][8], bias[8];
#pragma unroll
        for (int jj = 0; jj < 5; ++jj) { const float4 a = *(const float4*)(cw + jj * 1024 + ch), b2 = *(const float4*)(cw + jj * 1024 + ch + 4); w[jj][0] = a.x; w[jj][1] = a.y; w[jj][2] = a.z; w[jj][3] = a.w; w[jj][4] = b2.x; w[jj][5] = b2.y; w[jj][6] = b2.z; w[jj][7] = b2.w; }
        { const float4 a = *(const float4*)(cb + ch), b2 = *(const float4*)(cb + ch + 4); bias[0] = a.x; bias[1] = a.y; bias[2] = a.z; bias[3] = a.w; bias[4] = b2.x; bias[5] = b2.y; bias[6] = b2.z; bias[7] = b2.w; }
        uint4 xr[20];
#pragma unroll
        for (int q = 0; q < 20; ++q) {
            const int tt = tpos0 + q - 2;
            xr[q] = make_uint4(0, 0, 0, 0);
            if (tt >= 0 && tt < SEQ) xr[q] = *(const uint4*)(P + (size_t)(row0 + q - 2) * EV_N + 3072 + ch);
        }
#pragma unroll
        for (int t = 0; t < 16; ++t) {
            float x0[8], x1[8], x2[8], x3[8], x4[8];
            UNPACK8_BF(xr[t], x0); UNPACK8_BF(xr[t + 1], x1); UNPACK8_BF(xr[t + 2], x2); UNPACK8_BF(xr[t + 3], x3); UNPACK8_BF(xr[t + 4], x4);
            float acc[8];
#pragma unroll
            for (int i = 0; i < 8; ++i) {
                float a = bias[i];
                a = fmaf(x0[i], w[0][i], a); a = fmaf(x1[i], w[1][i], a); a = fmaf(x2[i], w[2][i], a); a = fmaf(x3[i], w[3][i], a); a = fmaf(x4[i], w[4][i], a);
                acc[i] = siluf_(a);
            }
            *(uint4*)(XB + (size_t)(row0 + t) * 1024 + ch) = PACK8_BF(acc);
        }
    }
}

__device__ __forceinline__ void even_dt(const Params& p, int j, unsigned char* lds) {
    const int tid = otid(), lane = tid & 63, l15 = lane & 15, lq = lane >> 4, gw = obid() * 8 + (tid >> 6), nw = gridDim.x * 8;
    u16* Wt = (u16*)lds;
    const float* W = INP(p, I_EVIN) + (size_t)j * DM * 4112 + 4096;
    const u16* XA = (const u16*)(WSP(p) + WS_XA); float* DT = (float*)(WSP(p) + EV_DT);
    __syncthreads();
    {
        float tmp[32];
#pragma unroll
        for (int q = 0; q < 32; ++q) { const int idx = tid + 512 * q; tmp[q] = W[(size_t)(idx >> 4) * 4112 + (idx & 15)]; }
#pragma unroll
        for (int q = 0; q < 32; ++q) { const int idx = tid + 512 * q; Wt[(idx & 15) * 1032 + (idx >> 4)] = (u16)f2bf(tmp[q]); }
    }
    __syncthreads();
    const float bias = INP(p, I_M2DTB)[j * 16 + l15];
    for (int tile = gw; tile < T_TOK / 16; tile += nw) {
        const u16* arow = XA + (size_t)(tile * 16 + l15) * DM + 8 * lq;
        f32x4 acc = {0.f, 0.f, 0.f, 0.f};
#pragma unroll 8
        for (int ks = 0; ks < 32; ++ks) acc = mma16(*(const bf16x8_t*)(arow + ks * 32), ldfrag(Wt, 1032, 0, ks * 32, lane), acc);
#pragma unroll
        for (int r = 0; r < 4; ++r) DT[(size_t)(tile * 16 + lq * 4 + r) * 16 + l15] = softplusf_(acc[r] + bias);
    }
    __syncthreads();
}

__device__ __forceinline__ void even_post(const Params& p, int j) {
    const int lane = otid() & 63, gw = obid() * 8 + (otid() >> 6), nw = gridDim.x * 8;
    const u16* P = (const u16*)(WSP(p) + WS_P); const u16* XB = (const u16*)(WSP(p) + EV_XBC);
    const u16* AOF = (const u16*)(WSP(p) + EV_AOF); const u16* AOB = (const u16*)(WSP(p) + EV_AOB);
    const u16* BYF = (const u16*)(WSP(p) + EV_BYF); const u16* BYB = (const u16*)(WSP(p) + EV_BYB);
    u16* O = (u16*)(WSP(p) + WS_XA);
    const int c = lane * 8;
    float hnw[8], mnw[8];
#pragma unroll
    for (int i = 0; i < 8; ++i) { hnw[i] = INP(p, I_HGNW)[j * 128 + ((c + i) & 127)]; mnw[i] = INP(p, I_M2NW)[j * 512 + c + i]; }
    const float dsk = INP(p, I_M2D)[j * 8 + (lane >> 3)];
    for (int rowb = gw * 2; rowb < T_TOK; rowb += nw * 2) {
        uint4 q[2][7];
#pragma unroll
        for (int r = 0; r < 2; ++r) {
            const size_t row = rowb + r;
            q[r][0] = *(const uint4*)(AOF + row * 512 + c); q[r][1] = *(const uint4*)(AOB + row * 512 + c); q[r][2] = *(const uint4*)(P + row * EV_N + 2048 + c);
            q[r][3] = *(const uint4*)(BYF + row * 512 + c); q[r][4] = *(const uint4*)(BYB + row * 512 + c); q[r][5] = *(const uint4*)(XB + row * 1024 + c); q[r][6] = *(const uint4*)(P + row * EV_N + 2560 + c);
        }
#pragma unroll
        for (int r = 0; r < 2; ++r) {
            const size_t row = rowb + r;
            float a[8], t[8], o[8];
            UNPACK8_BF(q[r][0], a); UNPACK8_BF(q[r][1], t);
            float ss = 0.f;
#pragma unroll
            for (int i = 0; i < 8; ++i) { a[i] += t[i]; ss += a[i] * a[i]; }
            ss = red16(ss);
            float rs = rsqrtf(ss * (1.f / 128.f) + 1e-6f);
            UNPACK8_BF(q[r][2], t);
#pragma unroll
            for (int i = 0; i < 8; ++i) o[i] = a[i] * rs * hnw[i] * t[i];
            *(uint4*)(O + row * DM + c) = PACK8_BF(o);
            UNPACK8_BF(q[r][3], a); UNPACK8_BF(q[r][4], t);
#pragma unroll
            for (int i = 0; i < 8; ++i) a[i] += t[i];
            UNPACK8_BF(q[r][5], t);
#pragma unroll
            for (int i = 0; i < 8; ++i) a[i] = fmaf(t[i], dsk, a[i]);
            UNPACK8_BF(q[r][6], t);
            ss = 0.f;
#pragma unroll
            for (int i = 0; i < 8; ++i) { a[i] *= t[i]; ss += a[i] * a[i]; }
            ss = red32(ss);
            rs = rsqrtf(ss * (1.f / 256.f) + 1e-6f);
#pragma unroll
            for (int i = 0; i < 8; ++i) o[i] = a[i] * rs * mnw[i];
            *(uint4*)(O + row * DM + 512 + c) = PACK8_BF(o);
        }
    }
}

__device__ __forceinline__ void odd_shift(const Params& p, int j) {
    const int lane = otid() & 63, gw = obid() * 8 + (otid() >> 6), nw = gridDim.x * 8;
    const u16* P = (const u16*)(WSP(p) + WS_P);
    const float* mu0 = INP(p, I_MU) + (size_t)(j * 2 + 0) * RWIN; const float* mu1 = INP(p, I_MU) + (size_t)(j * 2 + 1) * RWIN;
    u16* R = (u16*)(WSP(p) + OD_R); u16* V = (u16*)(WSP(p) + OD_V); u16* KK = (u16*)(WSP(p) + OD_KK); u16* KP = (u16*)(WSP(p) + OD_KP);
    u16* XL = (u16*)(WSP(p) + OD_XL); u16* A1 = (u16*)(WSP(p) + OD_A1);
    float kkw[8];
#pragma unroll
    for (int e = 0; e < 8; ++e) kkw[e] = INP(p, I_KK)[j * 512 + lane * 8 + e];
    for (int row = gw; row < T_TOK; row += nw) {
        const int tpos = row & (SEQ - 1);
        unsigned zz = 0; asm volatile("" : "+v"(zz));
        const u16* pc = P + (size_t)row * OD_N;
        uint4 cv[4], pv[4], nv[4];
#pragma unroll
        for (int i = 0; i < 4; ++i) {
            const int o = lane + 64 * i;
            cv[i] = make_uint4(zz, zz, zz, zz); pv[i] = cv[i]; nv[i] = cv[i];
            if (o < 220) { cv[i] = *(const uint4*)(pc + o * 8); if (tpos > 0) pv[i] = *(const uint4*)(pc - OD_N + o * 8); if (tpos < SEQ - 1) nv[i] = *(const uint4*)(pc + OD_N + o * 8); }
        }
        const uint4 uv = *(const uint4*)(pc + RWIN + lane * 8);
#pragma unroll
        for (int i = 0; i < 4; ++i) {
            const int o = lane + 64 * i, col = o * 8;
            if (o < 220) {
                float c8[8], p8[8], n8[8], m0[8], m1[8], sh[8];
                UNPACK8_BF(cv[i], c8); UNPACK8_BF(pv[i], p8); UNPACK8_BF(nv[i], n8);
                { const float4 a = *(const float4*)(mu0 + col), b2 = *(const float4*)(mu0 + col + 4); m0[0] = a.x; m0[1] = a.y; m0[2] = a.z; m0[3] = a.w; m0[4] = b2.x; m0[5] = b2.y; m0[6] = b2.z; m0[7] = b2.w; }
                { const float4 a = *(const float4*)(mu1 + col), b2 = *(const float4*)(mu1 + col + 4); m1[0] = a.x; m1[1] = a.y; m1[2] = a.z; m1[3] = a.w; m1[4] = b2.x; m1[5] = b2.y; m1[6] = b2.z; m1[7] = b2.w; }
#pragma unroll
                for (int e = 0; e < 8; ++e) sh[e] = c8[e] + (p8[e] - c8[e]) * m0[e] + (n8[e] - c8[e]) * m1[e];
                if (i == 0) *(uint4*)(R + (size_t)row * 512 + col) = PACK8_BF(sh);
                else if (i == 1) {
                    *(uint4*)(KP + (size_t)row * 512 + col - 512) = PACK8_BF(sh);
                    float ss = 0.f;
#pragma unroll
                    for (int e = 0; e < 8; ++e) { sh[e] *= kkw[e]; ss += sh[e] * sh[e]; }
                    ss = red8(ss);
                    const float inv = 1.f / fmaxf(sqrtf(ss), 1e-12f);
#pragma unroll
                    for (int e = 0; e < 8; ++e) sh[e] *= inv;
                    *(uint4*)(KK + (size_t)row * 512 + col - 512) = PACK8_BF(sh);
                } else if (i == 2) *(uint4*)(V + (size_t)row * 512 + col - 1024) = PACK8_BF(sh);
                else {
                    const int cc = col - 1536;
#pragma unroll
                    for (int e = 0; e < 8; ++e) sh[e] = (cc < 64) ? tanhf_(sh[e]) : ((cc >= 128) ? sigmoidf_(sh[e]) : sh[e]);
                    *(uint4*)(XL + (size_t)row * 256 + cc) = PACK8_BF(sh);
                }
            } else if (o < 224) *(uint4*)(XL + (size_t)row * 256 + (o - 192) * 8) = make_uint4(zz, zz, zz, zz);
        }
        { const int c = lane * 8; *(uint4*)(A1 + ((size_t)(c >> 4) * 1024 + (row >> 13) * 512 + (tpos >> 4)) * 512 + (tpos & 15) * 16 + (c & 15)) = uv; }
    }
}
__device__ __forceinline__ void build_lora_weight(const Params& p, int j) {
    u16* BT = (u16*)(WSP(p) + OD_BTL);
    const float* w2 = INP(p, I_W2) + (size_t)j * 2 * 32 * 512; const float* a2 = INP(p, I_A2) + (size_t)j * 2 * 32 * 512; const float* g2 = INP(p, I_G2) + (size_t)j * 96 * 512;
    for (int e = obid() * 512 + otid(); e < 2560 * 32; e += gridDim.x * 512) {
        const int n = e % 2560, ko = e / 2560, k0 = ko * 8, reg = n >> 9, c = n & 511;
        float o[8];
#pragma unroll
        for (int q = 0; q < 8; ++q) {
            const int k = k0 + q; float v = 0.f;
            if (reg < 4) { if (k >= reg * 32 && k < reg * 32 + 32) v = ((reg < 2) ? w2 : a2)[((reg & 1) * 32 + (k - reg * 32)) * 512 + c]; }
            else if (k >= 128 && k < 224) v = g2[(k - 128) * 512 + c];
            o[q] = v;
        }
        *(uint4*)(BT + (size_t)n * 256 + k0) = PACK8_BF(o);
    }
}
struct EpiLora {
    static constexpr bool PERM = true, AFTER_DRAIN = false;
    unsigned char* ws; const float* w0; const float* a0;
    __device__ __forceinline__ void operator()(const f32x4 (&acc)[2][2][4][2], const pg8::Unit& u, int wr, int wc, int fr, int fq) const {
        const int reg = u.pn >> 1, row0 = u.pm * 256 + wr * 64 + fr, c0 = (u.pn & 1) * 256 + wc * 32 + 8 * fq;
        if (reg < 2) {
            u16* dst = (u16*)(ws + (reg ? OD_WB1 : OD_WF1));
#pragma unroll
            for (int bj = 0; bj < 2; ++bj) {
                const int c = c0 + bj * 128;
                float bias[8];
#pragma unroll
                for (int e = 0; e < 8; ++e) bias[e] = w0[reg * 512 + c + e];
#pragma unroll
                for (int ai = 0; ai < 2; ++ai)
#pragma unroll
                    for (int m = 0; m < 4; ++m) {
                        float x[8];
#pragma unroll
                        for (int n = 0; n < 2; ++n)
#pragma unroll
                            for (int e = 0; e < 4; ++e) x[n * 4 + e] = 1.f - __expf(-0.6065306597f * sigmoidf_(acc[ai][bj][m][n][e] + bias[n * 4 + e]));
                        *(uint4*)(dst + (size_t)(row0 + ai * 128 + m * 16) * 512 + c) = PACK8_H(x);
                    }
            }
        } else if (reg < 4) {
            u16* dA = (u16*)(ws + (reg == 3 ? OD_AB : OD_AF));
#pragma unroll
            for (int bj = 0; bj < 2; ++bj) {
                const int c = c0 + bj * 128;
                float bias[8];
#pragma unroll
                for (int e = 0; e < 8; ++e) bias[e] = a0[(reg & 1) * 512 + c + e];
#pragma unroll
                for (int ai = 0; ai < 2; ++ai)
#pragma unroll
                    for (int m = 0; m < 4; ++m) {
                        float x[8];
#pragma unroll
                        for (int n = 0; n < 2; ++n)
#pragma unroll
                            for (int e = 0; e < 4; ++e) x[n * 4 + e] = sigmoidf_(acc[ai][bj][m][n][e] + bias[n * 4 + e]);
                        *(uint4*)(dA + (size_t)(row0 + ai * 128 + m * 16) * 512 + c) = PACK8_BF(x);
                    }
            }
        } else {
            u16* dst = (u16*)(ws + OD_G);
#pragma unroll
            for (int ai = 0; ai < 2; ++ai)
#pragma unroll
                for (int m = 0; m < 4; ++m)
#pragma unroll
                    for (int bj = 0; bj < 2; ++bj) {
                        const f32x4 v0 = acc[ai][bj][m][0], v1 = acc[ai][bj][m][1];
                        *(uint4*)(dst + (size_t)(row0 + ai * 128 + m * 16) * 512 + c0 + bj * 128) = make_uint4(pk2(v0[0], v0[1]), pk2(v0[2], v0[3]), pk2(v1[0], v1[1]), pk2(v1[2], v1[3]));
                    }
        }
    }
};

template <int PASS>
__device__ __forceinline__ void rw_scan(const Params& p, unsigned char* lds) {
    const int tid = otid();
    constexpr int NTH = (PASS == 1) ? 512 : 256;
    const int half = (PASS == 1) ? 0 : (tid >> 8), lt = tid & (NTH - 1);
    float* base = (float*)lds + half * (6 * 2048 + 1024);
    float* Lkk = base; float* Lw = base + 2048; float* Lb = base + 4096; float* Lk = base + 6144; float* Lv = base + 8192; float* Lr = base + 10240;
    u16* Lo = (u16*)(base + 12288);
    const int row = lt >> 2, cg = lt & 3;
    const int lrow = (lt & 255) >> 3, lch = (lt & 7) * 8, lsel = (PASS == 1) ? (tid >> 8) : 0;
    float* LCs = (float*)(WSP(p) + OD_CLC); float* PM = (float*)(WSP(p) + OD_CPM);
    const int nitems = (PASS == 1) ? 512 : 256;
    for (int item = obid(); item < nitems; item += gridDim.x) {
        const int unit = (PASS == 1) ? item : item * 2 + half;
        const int seg = unit & 15, hd = (unit >> 4) & 7, b = (unit >> 7) & 1, dir = unit >> 8;
        const u16* aKK = (const u16*)(WSP(p) + OD_KK); const u16* aA = (const u16*)(WSP(p) + (dir ? OD_AB : OD_AF)); const u16* aV = (const u16*)(WSP(p) + OD_V);
        const u16* aK = (const u16*)(WSP(p) + (dir ? OD_KB : OD_KF)); const u16* aW = (const u16*)(WSP(p) + (dir ? OD_WB1 : OD_WF1)); const u16* aR = (const u16*)(WSP(p) + OD_R);
        u16* YO = (u16*)(WSP(p) + (dir ? OD_CYB : OD_CYF));
        float st[16];
        if (PASS == 1) {
#pragma unroll
            for (int e = 0; e < 16; ++e) st[e] = (row >= 64 && (row - 64) == cg * 16 + e) ? 1.f : 0.f;
        } else {
#pragma unroll
            for (int e = 0; e < 16; ++e) st[e] = LCs[(size_t)unit * 4096 + row * 64 + cg * 16 + e];
        }
        uint4 r0, r1, r2, r3 = make_uint4(0, 0, 0, 0), r4 = make_uint4(0, 0, 0, 0), r5 = make_uint4(0, 0, 0, 0);
#define RW_LOAD(s0) do { const size_t go = (size_t)TIME_ROW(seg, (s0) + lrow, dir, b) * 512 + hd * 64 + lch; \
        if (PASS == 1) { if (lsel == 0) { r0 = *(const uint4*)(aKK + go); r1 = *(const uint4*)(aA + go); r2 = *(const uint4*)(aV + go); } \
                         else { r0 = *(const uint4*)(aK + go); r1 = *(const uint4*)(aW + go); r2 = make_uint4(0, 0, 0, 0); } } \
        else { r0 = *(const uint4*)(aKK + go); r1 = *(const uint4*)(aA + go); r2 = *(const uint4*)(aV + go); r3 = *(const uint4*)(aK + go); r4 = *(const uint4*)(aW + go); r5 = *(const uint4*)(aR + go); } } while (0)
        RW_LOAD(0);
        for (int tile = 0; tile < LSEG / 32; ++tile) {
            __syncthreads();
            {
                float f[8], g8[8]; const int lo = lrow * 64 + lch;
                if (PASS == 1) {
                    if (lsel == 0) { UNPACK8_BF(r0, f); ST8F(Lkk + lo, f); UNPACK8_BF(r1, g8);
#pragma unroll
                        for (int e = 0; e < 8; ++e) g8[e] *= f[e];
                        ST8F(Lb + lo, g8); UNPACK8_BF(r2, f); ST8F(Lv + lo, f); }
                    else { UNPACK8_BF(r0, f); ST8F(Lk + lo, f); UNPACK8_H(r1, f);
#pragma unroll
                        for (int e = 0; e < 8; ++e) f[e] = 1.f - f[e];
                        ST8F(Lw + lo, f); }
                } else {
                    UNPACK8_BF(r0, f); ST8F(Lkk + lo, f); UNPACK8_BF(r1, g8);
#pragma unroll
                    for (int e = 0; e < 8; ++e) g8[e] *= f[e];
                    ST8F(Lb + lo, g8); UNPACK8_BF(r2, f); ST8F(Lv + lo, f);
                    UNPACK8_BF(r3, f); ST8F(Lk + lo, f); UNPACK8_H(r4, f);
#pragma unroll
                    for (int e = 0; e < 8; ++e) f[e] = 1.f - f[e];
                    ST8F(Lw + lo, f); UNPACK8_BF(r5, f); ST8F(Lr + lo, f);
                }
            }
            __syncthreads();
            if (tile + 1 < LSEG / 32) RW_LOAD((tile + 1) * 32);
            for (int s = 0; s < 32; ++s) {
                const float vv = (PASS == 1 && row >= 64) ? 0.f : Lv[s * 64 + (row & 63)];
                float4 kk4[4];
                float sa = 0.f;
#pragma unroll
                for (int q = 0; q < 4; ++q) {
                    kk4[q] = *(const float4*)(Lkk + s * 64 + cg * 16 + q * 4);
                    sa = fmaf(st[q * 4 + 0], kk4[q].x, sa); sa = fmaf(st[q * 4 + 1], kk4[q].y, sa); sa = fmaf(st[q * 4 + 2], kk4[q].z, sa); sa = fmaf(st[q * 4 + 3], kk4[q].w, sa);
                }
                sa = -red4(sa);
                float y = 0.f;
#pragma unroll
                for (int q = 0; q < 4; ++q) {
                    const float4 w4 = *(const float4*)(Lw + s * 64 + cg * 16 + q * 4), b4 = *(const float4*)(Lb + s * 64 + cg * 16 + q * 4), k4 = *(const float4*)(Lk + s * 64 + cg * 16 + q * 4);
                    st[q * 4 + 0] = fmaf(st[q * 4 + 0], w4.x, fmaf(sa, b4.x, vv * k4.x));
                    st[q * 4 + 1] = fmaf(st[q * 4 + 1], w4.y, fmaf(sa, b4.y, vv * k4.y));
                    st[q * 4 + 2] = fmaf(st[q * 4 + 2], w4.z, fmaf(sa, b4.z, vv * k4.z));
                    st[q * 4 + 3] = fmaf(st[q * 4 + 3], w4.w, fmaf(sa, b4.w, vv * k4.w));
                    if (PASS == 3) {
                        const float4 r4v = *(const float4*)(Lr + s * 64 + cg * 16 + q * 4);
                        y = fmaf(st[q * 4 + 0], r4v.x, y); y = fmaf(st[q * 4 + 1], r4v.y, y); y = fmaf(st[q * 4 + 2], r4v.z, y); y = fmaf(st[q * 4 + 3], r4v.w, y);
                    }
                }
                if (PASS == 3) { y = red4(y); if (cg == 0) Lo[s * 64 + row] = (u16)f2bf(y); }
            }
            if (PASS == 3) {
                __syncthreads();
                const uint4 ov = *(const uint4*)(Lo + lrow * 64 + lch);
                *(uint4*)(YO + (size_t)TIME_ROW(seg, tile * 32 + lrow, dir, b) * 512 + hd * 64 + lch) = ov;
            }
        }
#undef RW_LOAD
        if (PASS == 1) {
            float* dst = (row < 64) ? (LCs + (size_t)unit * 4096 + row * 64 + cg * 16) : (PM + (size_t)unit * 4096 + (row - 64) * 64 + cg * 16);
#pragma unroll
            for (int e = 0; e < 16; ++e) dst[e] = st[e];
        }
    }
    __syncthreads();
}


template <int PASS>
__device__ __forceinline__ void rw_mma(const Params& p, int jl, unsigned char* lds) {
    constexpr int NRT = (PASS == 1) ? 2 : 1, NST = (PASS == 1) ? 4 : 2;
    const int tid = otid(), lane = tid & 63, wave = tid >> 6, l15 = lane & 15, lq = lane >> 4;
    u16* At = (u16*)lds;
    u16* Rt = At + 32 * 72;
    u16* Bn = Rt + 32 * 72;
    u16* Kn = Bn + 32 * 72;
    u16* BhT = Kn + 32 * 72;
    u16* KhT = BhT + 64 * 40;
    u16* VT = KhT + 64 * 40;
    u16* Sb = VT + 128 * 40;
    u16* RhsT = Sb + 128 * 72;
    u16* SAT = RhsT + 128 * 40;
    u16* Mx = SAT + 128 * 40;
    u16* Mak = Mx; u16* Mrb = Mx + 1280; u16* Mrk = Mx + 2560;
    u16* Yb = Mx + 9 * 1280;
    float* Lc = (float*)(Yb + 2048);
    float* Lp = Lc + 2048;
    float* Ltot = Lp + 512;
    u16* Lkkh = (u16*)(Ltot + 64); u16* Lah = Lkkh + 2048; u16* Lkdh = Lah + 2048; u16* Lvh2 = Lkdh + 2048;
    float* LCs = (float*)(WSP(p) + OD_CLC); float* PM = (float*)(WSP(p) + OD_CPM);
    u16* TIG = (u16*)(WSP(p) + OD_TINV);
    const int et = tid >> 4, ech = (tid & 15) * 4;
    const int svt = (PASS == 1) ? wave : (wave >> 1), kt0 = (PASS == 1) ? 0 : (wave & 1) * 2;
    for (int unit = obid(); unit < 512; unit += gridDim.x) {
        const int seg = unit & 15, hd = (unit >> 4) & 7, b = (unit >> 7) & 1, dir = unit >> 8;
        const u16* aKK = (const u16*)(WSP(p) + OD_KK); const u16* aA = (const u16*)(WSP(p) + (dir ? OD_AB : OD_AF)); const u16* aV = (const u16*)(WSP(p) + OD_V);
        const u16* aK = (const u16*)(WSP(p) + OD_KP); const u16* aW = (const u16*)(WSP(p) + (dir ? OD_WB1 : OD_WF1)); const u16* aR = (const u16*)(WSP(p) + OD_R);
        u16* YO = (u16*)(WSP(p) + (dir ? OD_CYB : OD_CYF));
        const float4 ka4 = *(const float4*)(INP(p, I_KA) + jl * 512 + hd * 64 + ech); const float kag = INP(p, I_KA)[jl * 512 + hd * 64 + (tid & 63)];
        f32x4 S[NST];
        __syncthreads();
#pragma unroll
        for (int q = 0; q < NST; ++q)
#pragma unroll
            for (int r = 0; r < 4; ++r) {
                const int v = svt * 16 + lq * 4 + r, k = (kt0 + q) * 16 + l15;
                S[q][r] = (PASS == 1) ? ((v >= 64 && v - 64 == k) ? 1.f : 0.f) : LCs[(size_t)unit * 4096 + v * 64 + k];
                Sb[v * 72 + k] = (u16)f2bf(S[q][r]);
            }
        if (PASS == 1) { for (int e = tid; e < 64 * 40; e += 512) VT[64 * 40 + e] = 0; }
        uint2 r0, r1, r2, r3, r4, r5 = make_uint2(0, 0); uint4 rti = make_uint4(0, 0, 0, 0);
#define RWM_LOAD(s0) do { const size_t go = (size_t)TIME_ROW(seg, (s0) + et, dir, b) * 512 + hd * 64 + ech; \
        r0 = *(const uint2*)(aKK + go); r1 = *(const uint2*)(aA + go); r2 = *(const uint2*)(aV + go); r3 = *(const uint2*)(aK + go); r4 = *(const uint2*)(aW + go); if (PASS == 3) { r5 = *(const uint2*)(aR + go); if (tid < 160) rti = *(const uint4*)(TIG + ((size_t)unit * 16 + ((s0) >> 5)) * 1280 + tid * 8); } } while (0)
        RWM_LOAD(0);
        for (int chunk = 0; chunk < LSEG / 32; ++chunk) {
            float kk[4], ai[4], vv[4], kd[4], w1[4], rr[4];
            kk[0] = bf2f(r0.x & 0xffffu); kk[1] = bf2f(r0.x >> 16); kk[2] = bf2f(r0.y & 0xffffu); kk[3] = bf2f(r0.y >> 16);
            ai[0] = bf2f(r1.x & 0xffffu); ai[1] = bf2f(r1.x >> 16); ai[2] = bf2f(r1.y & 0xffffu); ai[3] = bf2f(r1.y >> 16);
            vv[0] = bf2f(r2.x & 0xffffu); vv[1] = bf2f(r2.x >> 16); vv[2] = bf2f(r2.y & 0xffffu); vv[3] = bf2f(r2.y >> 16);
            kd[0] = bf2f(r3.x & 0xffffu); kd[1] = bf2f(r3.x >> 16); kd[2] = bf2f(r3.y & 0xffffu); kd[3] = bf2f(r3.y >> 16);
            kd[0] *= 1.f + (ai[0] - 1.f) * ka4.x; kd[1] *= 1.f + (ai[1] - 1.f) * ka4.y; kd[2] *= 1.f + (ai[2] - 1.f) * ka4.z; kd[3] *= 1.f + (ai[3] - 1.f) * ka4.w;
            w1[0] = h2f(r4.x & 0xffffu); w1[1] = h2f(r4.x >> 16); w1[2] = h2f(r4.y & 0xffffu); w1[3] = h2f(r4.y >> 16);
            rr[0] = bf2f(r5.x & 0xffffu); rr[1] = bf2f(r5.x >> 16); rr[2] = bf2f(r5.y & 0xffffu); rr[3] = bf2f(r5.y >> 16);
            lbar();
            *(float4*)(Lc + et * 64 + ech) = make_float4(__logf(1.f - w1[0]), __logf(1.f - w1[1]), __logf(1.f - w1[2]), __logf(1.f - w1[3]));
            if (PASS == 3 && tid < 160) *(uint4*)(Mx + 3 * 1280 + tid * 8) = rti;
            *(uint2*)(Lkkh + et * 64 + ech) = r0; *(uint2*)(Lah + et * 64 + ech) = r1; *(uint2*)(Lvh2 + et * 64 + ech) = r2; *(uint2*)(Lkdh + et * 64 + ech) = r3;
            if (chunk + 1 < LSEG / 32) RWM_LOAD((chunk + 1) * 32);
            lbar();
            {
                const int k = tid & 63, tg = tid >> 6;
                float c4[4]; float run = 0.f;
#pragma unroll
                for (int i = 0; i < 4; ++i) { run += Lc[(tg * 4 + i) * 64 + k]; c4[i] = run; }
                Lp[tg * 64 + k] = run;
                lbar();
                float off = 0.f;
#pragma unroll
                for (int g2 = 0; g2 < 7; ++g2) off += (g2 < tg) ? Lp[g2 * 64 + k] : 0.f;
#pragma unroll
                for (int i = 0; i < 4; ++i) Lc[(tg * 4 + i) * 64 + k] = c4[i] + off;
                if (tg == 7) Ltot[k] = c4[3] + off;
            }
            lbar();
            {
                const float4 cu = *(const float4*)(Lc + et * 64 + ech);
                float4 cx = make_float4(0.f, 0.f, 0.f, 0.f); if (et > 0) cx = *(const float4*)(Lc + (et - 1) * 64 + ech);
                const float4 tt = *(const float4*)(Ltot + ech);
                const float cum[4] = {cu.x, cu.y, cu.z, cu.w}, cmx[4] = {cx.x, cx.y, cx.z, cx.w}, tot[4] = {tt.x, tt.y, tt.z, tt.w};
                float oa[4], orr[4], ob[4], ok[4];
#pragma unroll
                for (int e = 0; e < 4; ++e) {
                    const float bq = kk[e] * ai[e], einv = __expf(-cum[e]);
                    oa[e] = -kk[e] * __expf(cmx[e]); orr[e] = rr[e] * __expf(cum[e]); ob[e] = bq * einv; ok[e] = kd[e] * einv;
                }
                *(uint2*)(At + et * 72 + ech) = make_uint2(pk2(oa[0], oa[1]), pk2(oa[2], oa[3]));
                *(uint2*)(Bn + et * 72 + ech) = make_uint2(pk2(ob[0], ob[1]), pk2(ob[2], ob[3]));
                *(uint2*)(Kn + et * 72 + ech) = make_uint2(pk2(ok[0], ok[1]), pk2(ok[2], ok[3]));
                if (PASS == 3) *(uint2*)(Rt + et * 72 + ech) = make_uint2(pk2(orr[0], orr[1]), pk2(orr[2], orr[3]));
            }
            {
                const int k = tid & 63, tq = (tid >> 6) & 3, which = tid >> 8; const float tk = Ltot[k];
                float o[8]; unsigned vb[8];
#pragma unroll
                for (int e = 0; e < 8; ++e) {
                    const int t = tq * 8 + e; const float etot = __expf(tk - Lc[t * 64 + k]);
                    const float av = bf2f(Lah[t * 64 + k]);
                    o[e] = (which ? bf2f(Lkdh[t * 64 + k]) * (1.f + (av - 1.f) * kag) : bf2f(Lkkh[t * 64 + k]) * av) * etot; vb[e] = Lvh2[t * 64 + k];
                }
                *(uint4*)((which ? KhT : BhT) + k * 40 + tq * 8) = PACK8_BF(o);
                if (which == 0) *(uint4*)(VT + k * 40 + tq * 8) = make_uint4(vb[0] | (vb[1] << 16), vb[2] | (vb[3] << 16), vb[4] | (vb[5] << 16), vb[6] | (vb[7] << 16));
            }
            lbar();
            u16* Xc = Mx + 3 * 1280; u16* Xn = Mx + 4 * 1280; u16* Nc = Mx + 5 * 1280; u16* NcT = Mx + 6 * 1280; u16* Nn = Mx + 7 * 1280; u16* NnT = Mx + 8 * 1280;
            {
                const int mat = wave >> 1, ti = wave & 1;
                if ((PASS == 3 && mat > 0) || (PASS == 1 && mat < 2)) {
                    const u16* Aop = (mat < 2) ? At : Rt; const u16* Bop = (mat & 1) ? Kn : Bn;
                    const bf16x8_t a0 = ldfrag(Aop, 72, ti * 16, 0, lane), a1 = ldfrag(Aop, 72, ti * 16, 32, lane);
#pragma unroll
                    for (int si = 0; si < 2; ++si) {
                        f32x4 am = {0.f, 0.f, 0.f, 0.f};
                        am = mma16(a0, ldfrag(Bop, 72, si * 16, 0, lane), am); am = mma16(a1, ldfrag(Bop, 72, si * 16, 32, lane), am);
                        const int s = si * 16 + l15;
                        float mv[4];
#pragma unroll
                        for (int r = 0; r < 4; ++r) { const int t = ti * 16 + lq * 4 + r; mv[r] = ((mat < 2) ? (s < t) : (s <= t)) ? am[r] : 0.f; }
                        u16* dst = (mat == 0) ? Nc : (mat == 1) ? Mak : (mat == 2) ? Mrb : Mrk;
#pragma unroll
                        for (int r = 0; r < 4; ++r) dst[(ti * 16 + lq * 4 + r) * 40 + s] = (u16)f2bf(mv[r]);
                        if (mat == 0) {
                            *(uint2*)(NcT + s * 40 + ti * 16 + lq * 4) = make_uint2(pk2(mv[0], mv[1]), pk2(mv[2], mv[3]));
#pragma unroll
                            for (int r = 0; r < 4; ++r) { const int t = ti * 16 + lq * 4 + r; Xc[t * 40 + s] = (u16)f2bf(mv[r] + (t == s ? 1.f : 0.f)); }
                        }
                    }
                }
            }
            lbar();
            f32x4 yv[NRT];
            {
#pragma unroll
                for (int q = 0; q < NRT; ++q) {
                    const int tt = (PASS == 1) ? q : (wave >> 2), vt = (PASS == 1) ? wave : (wave & 3);
                    const bf16x8_t s0 = ldfrag(Sb, 72, vt * 16, 0, lane), s1 = ldfrag(Sb, 72, vt * 16, 32, lane);
                    f32x4 rh = {0.f, 0.f, 0.f, 0.f};
                    rh = mma16(ldfrag(At, 72, tt * 16, 0, lane), s0, rh); rh = mma16(ldfrag(At, 72, tt * 16, 32, lane), s1, rh);
                    rh = mma16(ldfrag(Mak, 40, tt * 16, 0, lane), ldfrag(VT, 40, vt * 16, 0, lane), rh);
                    *(uint2*)(RhsT + (vt * 16 + l15) * 40 + tt * 16 + lq * 4) = make_uint2(pk2(rh[0], rh[1]), pk2(rh[2], rh[3]));
                    yv[q] = (f32x4){0.f, 0.f, 0.f, 0.f};
                    if (PASS == 3) { yv[q] = mma16(ldfrag(Rt, 72, tt * 16, 0, lane), s0, yv[q]); yv[q] = mma16(ldfrag(Rt, 72, tt * 16, 32, lane), s1, yv[q]); }
                }
            }
            if (PASS == 1) {
#pragma unroll
            for (int rnd = 0; rnd < 5; ++rnd) {
                if (wave < 4) {
                    if (rnd > 0) {
                        const int ti = wave >> 1, si = wave & 1;
                        f32x4 x;
#pragma unroll
                        for (int r = 0; r < 4; ++r) x[r] = bf2f(Xc[(ti * 16 + lq * 4 + r) * 40 + si * 16 + l15]);
                        x = mma16(ldfrag(Xc, 40, ti * 16, 0, lane), ldfrag(NcT, 40, si * 16, 0, lane), x);
#pragma unroll
                        for (int r = 0; r < 4; ++r) Xn[(ti * 16 + lq * 4 + r) * 40 + si * 16 + l15] = (u16)f2bf(x[r]);
                    }
                } else if (rnd < 4) {
                    const int ti = (wave - 4) >> 1, si = wave & 1;
                    f32x4 n2 = {0.f, 0.f, 0.f, 0.f};
                    n2 = mma16(ldfrag(Nc, 40, ti * 16, 0, lane), ldfrag(NcT, 40, si * 16, 0, lane), n2);
#pragma unroll
                    for (int r = 0; r < 4; ++r) Nn[(ti * 16 + lq * 4 + r) * 40 + si * 16 + l15] = (u16)f2bf(n2[r]);
                    *(uint2*)(NnT + (si * 16 + l15) * 40 + ti * 16 + lq * 4) = make_uint2(pk2(n2[0], n2[1]), pk2(n2[2], n2[3]));
                }
                lbar();
                if (rnd > 0) { u16* t0 = Xc; Xc = Xn; Xn = t0; }
                if (rnd < 4) { u16* t1 = Nc; Nc = Nn; Nn = t1; u16* t2 = NcT; NcT = NnT; NnT = t2; }
            }
            if (tid < 160) *(uint4*)(TIG + ((size_t)unit * 16 + chunk) * 1280 + tid * 8) = *(const uint4*)(Xc + tid * 8);
            } else lbar();
            {
#pragma unroll
                for (int q = 0; q < NRT; ++q) {
                    const int tt = (PASS == 1) ? q : (wave >> 2), vt = (PASS == 1) ? wave : (wave & 3);
                    f32x4 sa = {0.f, 0.f, 0.f, 0.f};
                    sa = mma16(ldfrag(Xc, 40, tt * 16, 0, lane), ldfrag(RhsT, 40, vt * 16, 0, lane), sa);
                    *(uint2*)(SAT + (vt * 16 + l15) * 40 + tt * 16 + lq * 4) = make_uint2(pk2(sa[0], sa[1]), pk2(sa[2], sa[3]));
                }
            }
            lbar();
            if (PASS == 3) {
                const int tt = wave >> 2, vt = wave & 3;
                yv[0] = mma16(ldfrag(Mrb, 40, tt * 16, 0, lane), ldfrag(SAT, 40, vt * 16, 0, lane), yv[0]);
                yv[0] = mma16(ldfrag(Mrk, 40, tt * 16, 0, lane), ldfrag(VT, 40, vt * 16, 0, lane), yv[0]);
#pragma unroll
                for (int r = 0; r < 4; ++r) Yb[(tt * 16 + lq * 4 + r) * 64 + vt * 16 + l15] = (u16)f2bf(yv[0][r]);
            }
            {
                const bf16x8_t sa = ldfrag(SAT, 40, svt * 16, 0, lane), va = ldfrag(VT, 40, svt * 16, 0, lane);
#pragma unroll
                for (int q = 0; q < NST; ++q) {
                    const int kt = kt0 + q;
                    const float dk = __expf(Ltot[kt * 16 + l15]);
#pragma unroll
                    for (int r = 0; r < 4; ++r) S[q][r] *= dk;
                    S[q] = mma16(sa, ldfrag(BhT, 40, kt * 16, 0, lane), S[q]);
                    S[q] = mma16(va, ldfrag(KhT, 40, kt * 16, 0, lane), S[q]);
#pragma unroll
                    for (int r = 0; r < 4; ++r) Sb[(svt * 16 + lq * 4 + r) * 72 + kt * 16 + l15] = (u16)f2bf(S[q][r]);
                }
            }
            if (PASS == 3) {
                lbar();
                const uint2 ov = *(const uint2*)(Yb + et * 64 + ech);
                *(uint2*)(YO + (size_t)TIME_ROW(seg, chunk * 32 + et, dir, b) * 512 + hd * 64 + ech) = ov;
            }
        }
#undef RWM_LOAD
        if (PASS == 1) {
#pragma unroll
            for (int q = 0; q < NST; ++q)
#pragma unroll
                for (int r = 0; r < 4; ++r) {
                    const int v = svt * 16 + lq * 4 + r, k = (kt0 + q) * 16 + l15;
                    if (v < 64) LCs[(size_t)unit * 4096 + v * 64 + k] = S[q][r]; else PM[(size_t)unit * 4096 + (v - 64) * 64 + k] = S[q][r];
                }
        }
    }
    lbar();
}

__device__ __forceinline__ void s5_lambar(const Params& p, int j, int dir, int g, int lane, float& lr, float& li, float& are, float& aim) {
    are = INP(p, I_SARE)[(j * 32 + g) * 64 + lane]; aim = INP(p, I_SAIM)[(j * 32 + g) * 64 + lane];
    const float dl = __expf(INP(p, I_SLS)[(j * 2 + dir) * 32 + g]);
    const float mag = __expf(are * dl), ang = aim * dl;
    const float n = rintf(ang * 0.15915494309189535f);
    float r = fmaf(-n, 6.28318548202514648f, ang); r = fmaf(n, 1.74845553e-07f, r);
    lr = mag * __cosf(r); li = mag * __sinf(r);
}

__device__ __forceinline__ void s5_weights(const Params& p, int j, unsigned char* lds) {
    const int tid = otid();
    float* pw = (float*)lds;
    float* cf = pw + 2 * 17 * 64 * 2;
    float* bb = cf + 2 * 16 * 64 * 2;
    float* Kt = bb + 2 * 64 * 16 * 2;
    u16* Bt1 = (u16*)(WSP(p) + OD_BT1); u16* Bt0 = (u16*)(WSP(p) + OD_BT0);
    for (int item = obid(); item < 256; item += gridDim.x) {
        const int g = item >> 3, slice = item & 7;
        __syncthreads();
        if (tid < 128) {
            const int dir = tid >> 6, pp = tid & 63;
            float lr, li, are, aim; s5_lambar(p, j, dir, g, pp, lr, li, are, aim);
            float xr = 1.f, xi = 0.f;
#pragma nounroll
            for (int d = 0; d <= 16; ++d) { pw[((dir * 17 + d) * 64 + pp) * 2] = xr; pw[((dir * 17 + d) * 64 + pp) * 2 + 1] = xi; const float nr = xr * lr - xi * li, ni = xr * li + xi * lr; xr = nr; xi = ni; }
            const float den = are * are + aim * aim, nr = lr - 1.f;
            const float cr = (nr * are + li * aim) / den, ci = (li * are - nr * aim) / den;
            const float* br = INP(p, I_SBRE) + ((size_t)(j * 32 + g) * 64 + pp) * 16; const float* bi = INP(p, I_SBIM) + ((size_t)(j * 32 + g) * 64 + pp) * 16;
#pragma unroll 4
            for (int q = 0; q < 16; ++q) { bb[((dir * 64 + pp) * 16 + q) * 2] = cr * br[q] - ci * bi[q]; bb[((dir * 64 + pp) * 16 + q) * 2 + 1] = cr * bi[q] + ci * br[q]; }
        }
        for (int e = tid; e < 2048; e += 512) {
            const int dir = e >> 10, i = (e >> 6) & 15, pp = e & 63;
            const size_t so = ((size_t)((j * 2 + dir) * 32 + g) * 16 + i) * 64 + pp;
            cf[e * 2] = INP(p, I_SCRE)[so]; cf[e * 2 + 1] = INP(p, I_SCIM)[so];
        }
        __syncthreads();
        {
            const int dir = tid >> 8, d = (tid >> 4) & 15, i = tid & 15;
            float acc[16];
#pragma unroll
            for (int q = 0; q < 16; ++q) acc[q] = 0.f;
#pragma unroll 2
            for (int pp = 0; pp < 64; ++pp) {
                const float2 cc = *(const float2*)(cf + ((dir * 16 + i) * 64 + pp) * 2), ww = *(const float2*)(pw + ((dir * 17 + d) * 64 + pp) * 2);
                const float zr = cc.x * ww.x - cc.y * ww.y, zi = cc.x * ww.y + cc.y * ww.x;
                const float* bp = bb + (dir * 64 + pp) * 32;
#pragma unroll
                for (int q = 0; q < 8; ++q) { const float4 b4 = *(const float4*)(bp + q * 4); acc[q * 2] = fmaf(zr, b4.x, fmaf(-zi, b4.y, acc[q * 2])); acc[q * 2 + 1] = fmaf(zr, b4.z, fmaf(-zi, b4.w, acc[q * 2 + 1])); }
            }
#pragma unroll
            for (int q = 0; q < 4; ++q) *(float4*)(Kt + tid * 16 + q * 4) = make_float4(acc[q * 4], acc[q * 4 + 1], acc[q * 4 + 2], acc[q * 4 + 3]);
        }
        __syncthreads();
        {
            const int n = slice * 32 + (tid >> 4), tl = n >> 4, i = n & 15, k0 = (tid & 15) * 32;
            const float dsk = INP(p, I_SD)[j * 512 + g * 16 + i];
#pragma nounroll
            for (int q = 0; q < 4; ++q) {
                float o[8];
#pragma unroll
                for (int e = 0; e < 8; ++e) {
                    const int k = k0 + q * 8 + e; float val;
                    if (k < 256) {
                        const int sl = k >> 4, jj = k & 15;
                        val = 0.f;
                        if (sl <= tl) val += Kt[((0 * 16 + (tl - sl)) * 16 + i) * 16 + jj];
                        if (sl >= tl) val += Kt[((1 * 16 + (sl - tl)) * 16 + i) * 16 + jj];
                        if (sl == tl && i == jj) val += dsk;
                    } else {
                        const int dir = (k >= 384) ? 1 : 0, kk = k - 256 - dir * 128, pp = kk >> 1, im = kk & 1, d = dir ? (16 - tl) : (tl + 1);
                        const float c_r = cf[((dir * 16 + i) * 64 + pp) * 2], c_i = cf[((dir * 16 + i) * 64 + pp) * 2 + 1];
                        const float w_r = pw[((dir * 17 + d) * 64 + pp) * 2], w_i = pw[((dir * 17 + d) * 64 + pp) * 2 + 1];
                        val = im ? -(c_r * w_i + c_i * w_r) : (c_r * w_r - c_i * w_i);
                    }
                    o[e] = val;
                }
                *(uint4*)(Bt1 + ((size_t)g * 256 + n) * 512 + k0 + q * 8) = PACK8_BF(o);
            }
        }
        {
            const int n = slice * 32 + (tid >> 4), dir = n >> 7, nn = n & 127, pp = nn >> 1, im = nn & 1, k0 = (tid & 15) * 16;
#pragma nounroll
            for (int q = 0; q < 2; ++q) {
                float o[8];
#pragma unroll
                for (int e = 0; e < 8; ++e) {
                    const int k = k0 + q * 8 + e, sl = k >> 4, jj = k & 15, d = dir ? sl : (15 - sl);
                    const float w_r = pw[((dir * 17 + d) * 64 + pp) * 2], w_i = pw[((dir * 17 + d) * 64 + pp) * 2 + 1];
                    const float b_r = bb[((dir * 64 + pp) * 16 + jj) * 2], b_i = bb[((dir * 64 + pp) * 16 + jj) * 2 + 1];
                    o[e] = im ? (w_r * b_i + w_i * b_r) : (w_r * b_r - w_i * b_i);
                }
                *(uint4*)(Bt0 + ((size_t)g * 256 + n) * 256 + k0 + q * 8) = PACK8_BF(o);
            }
        }
    }
    __syncthreads();
}

struct S5Order {
    int G, c;
    __device__ __forceinline__ bool next(int i, pg8::Unit& u) const { const int L = i * G + c; if (L >= 128) return false; u.pm = L; u.pn = L >> 2; return true; }
    __device__ __forceinline__ void a_ready(const pg8::Unit&) const {}
    __device__ __forceinline__ void done(const pg8::Unit&) const {}
};
struct EpiXloc {
    static constexpr bool PERM = true, AFTER_DRAIN = false;
    float* X;
    __device__ __forceinline__ void operator()(const f32x4 (&acc)[2][2][4][2], const pg8::Unit& u, int wr, int wc, int fr, int fq) const {
        asm volatile("" : "+v"(fr), "+v"(fq));
        const int row0 = u.pm * 256 + wr * 64 + fr, col0 = wc * 32 + 8 * fq;
#pragma unroll
        for (int ai = 0; ai < 2; ++ai)
#pragma unroll
            for (int m = 0; m < 4; ++m)
#pragma unroll
                for (int bj = 0; bj < 2; ++bj) {
                    float* d = X + (size_t)(row0 + ai * 128 + m * 16) * 256 + col0 + bj * 128;
                    const f32x4 v0 = acc[ai][bj][m][0], v1 = acc[ai][bj][m][1];
                    *(float4*)d = make_float4(v0[0], v0[1], v0[2], v0[3]); *(float4*)(d + 4) = make_float4(v1[0], v1[1], v1[2], v1[3]);
                }
    }
};
struct EpiS5Out {
    static constexpr bool PERM = true, AFTER_DRAIN = false;
    u16* YG;
    __device__ __forceinline__ void operator()(const f32x4 (&acc)[2][2][4][2], const pg8::Unit& u, int wr, int wc, int fr, int fq) const {
        asm volatile("" : "+v"(fr), "+v"(fq));
        const int row0 = u.pm * 256 + wr * 64 + fr, col0 = wc * 32 + 8 * fq;
#pragma unroll
        for (int ai = 0; ai < 2; ++ai)
#pragma unroll
            for (int m = 0; m < 4; ++m) {
                const int row = row0 + ai * 128 + m * 16, g = row >> 10, rig = row & 1023, b = rig >> 9, cc = rig & 511;
#pragma unroll
                for (int bj = 0; bj < 2; ++bj) {
                    const int col = col0 + bj * 128, tl = col >> 4, i0 = col & 15;
                    float o[8];
#pragma unroll
                    for (int n = 0; n < 2; ++n)
#pragma unroll
                        for (int e = 0; e < 4; ++e) { const float x = acc[ai][bj][m][n][e]; o[n * 4 + e] = 0.5f * x * (1.f + tanhf_(0.7978845608028654f * (x + 0.044715f * x * x * x))); }
                    *(uint4*)(YG + ((size_t)b * SEQ + cc * 16 + tl) * 512 + g * 16 + i0) = PACK8_BF(o);
                }
            }
    }
};

__device__ __forceinline__ void s5_chunk_scan(const Params& p, int j, unsigned char* lds) {
    const int tid = otid(), blk = tid >> 5;
    float* ends = (float*)lds;
    const float* X = (const float*)(WSP(p) + OD_XLOC); u16* A1 = (u16*)(WSP(p) + OD_A1);
    for (int item = obid(); item < 256; item += gridDim.x) {
        const int pp = (tid & 31) + 32 * (item & 1), dir = (item >> 1) & 1, b = (item >> 2) & 1, g = item >> 3;
        float lr, li, are, aim; s5_lambar(p, j, dir, g, pp, lr, li, are, aim);
#pragma unroll
        for (int q = 0; q < 4; ++q) { const float nr = lr * lr - li * li, ni = 2.f * lr * li; lr = nr; li = ni; }
        float Lr = lr, Li = li;
#pragma unroll
        for (int q = 0; q < 5; ++q) { const float nr = Lr * Lr - Li * Li, ni = 2.f * Lr * Li; Lr = nr; Li = ni; }
        const size_t row0 = (size_t)g * 1024 + b * 512;
        const int xc = dir * 128 + 2 * pp;
        float xr = 0.f, xi = 0.f;
#pragma nounroll
        for (int cb = 0; cb < 32; cb += 8) {
            float2 v[8];
#pragma unroll
            for (int q = 0; q < 8; ++q) { const int c = dir ? (blk * 32 + 31 - cb - q) : (blk * 32 + cb + q); v[q] = *(const float2*)(X + (row0 + c) * 256 + xc); }
#pragma unroll
            for (int q = 0; q < 8; ++q) { const float nr = fmaf(lr, xr, fmaf(-li, xi, v[q].x)), ni = fmaf(lr, xi, fmaf(li, xr, v[q].y)); xr = nr; xi = ni; }
        }
        __syncthreads();
        ends[(blk * 64 + pp) * 2] = xr; ends[(blk * 64 + pp) * 2 + 1] = xi;
        __syncthreads();
        xr = 0.f; xi = 0.f;
        if (dir == 0) { for (int q = 0; q < blk; ++q) { const float er = ends[(q * 64 + pp) * 2], ei = ends[(q * 64 + pp) * 2 + 1]; const float nr = fmaf(Lr, xr, fmaf(-Li, xi, er)), ni = fmaf(Lr, xi, fmaf(Li, xr, ei)); xr = nr; xi = ni; } }
        else { for (int q = 15; q > blk; --q) { const float er = ends[(q * 64 + pp) * 2], ei = ends[(q * 64 + pp) * 2 + 1]; const float nr = fmaf(Lr, xr, fmaf(-Li, xi, er)), ni = fmaf(Lr, xi, fmaf(Li, xr, ei)); xr = nr; xi = ni; } }
#pragma nounroll
        for (int cb = 0; cb < 32; cb += 8) {
            float2 v[8];
#pragma unroll
            for (int q = 0; q < 8; ++q) { const int c = dir ? (blk * 32 + 31 - cb - q) : (blk * 32 + cb + q); v[q] = *(const float2*)(X + (row0 + c) * 256 + xc); }
#pragma unroll
            for (int q = 0; q < 8; ++q) {
                const int c = dir ? (blk * 32 + 31 - cb - q) : (blk * 32 + cb + q);
                *(unsigned*)(A1 + (row0 + c) * 512 + 256 + xc) = pk2(xr, xi);
                const float nr = fmaf(lr, xr, fmaf(-li, xi, v[q].x)), ni = fmaf(lr, xi, fmaf(li, xr, v[q].y)); xr = nr; xi = ni;
            }
        }
    }
    __syncthreads();
}

__device__ __forceinline__ void odd_carry(const Params& p, int j, unsigned char* lds) {
    const int tid = otid();
    float* Lpm = (float*)lds;
    float* Lcur = Lpm + 4096;
    float* LCs = (float*)(WSP(p) + OD_CLC); const float* PM = (const float*)(WSP(p) + OD_CPM);
    int cstart = obid() - 128; if (cstart < 0) cstart += gridDim.x;
    for (int item = cstart; item < 128; item += gridDim.x) {
        const int seq = item >> 2, lr = tid >> 5, row = (item & 3) * 16 + lr, c0 = (tid & 31) * 2;
        float cu0 = 0.f, cu1 = 0.f;
        float4 pa = *(const float4*)(PM + (size_t)(seq * 16) * 4096 + tid * 8), pb = *(const float4*)(PM + (size_t)(seq * 16) * 4096 + tid * 8 + 4);
        for (int s = 0; s < NSEG; ++s) {
            const int unit = seq * 16 + s;
            __syncthreads();
            *(float4*)(Lpm + tid * 8) = pa; *(float4*)(Lpm + tid * 8 + 4) = pb;
            Lcur[lr * 65 + c0] = cu0; Lcur[lr * 65 + c0 + 1] = cu1;
            float* lp = LCs + (size_t)unit * 4096 + row * 64 + c0;
            const float2 tmp = *(const float2*)lp;
            *(float2*)lp = make_float2(cu0, cu1);
            __syncthreads();
            if (s + 1 < NSEG) { pa = *(const float4*)(PM + (size_t)(unit + 1) * 4096 + tid * 8); pb = *(const float4*)(PM + (size_t)(unit + 1) * 4096 + tid * 8 + 4); }
            float a0 = 0.f, a1 = 0.f;
#pragma unroll 8
            for (int i = 0; i < 64; ++i) { const float a = Lcur[lr * 65 + i]; const float2 pm = *(const float2*)(Lpm + i * 64 + c0); a0 = fmaf(a, pm.x, a0); a1 = fmaf(a, pm.y, a1); }
            cu0 = a0 + tmp.x; cu1 = a1 + tmp.y;
        }
    }
    __syncthreads();
}

__device__ __forceinline__ void odd_post(const Params& p, int j) {
    const int lane = otid() & 63, gw = obid() * 8 + (otid() >> 6), nw = gridDim.x * 8;
    const u16* CYF = (const u16*)(WSP(p) + OD_CYF); const u16* CYB = (const u16*)(WSP(p) + OD_CYB);
    const u16* R = (const u16*)(WSP(p) + OD_R); const u16* V = (const u16*)(WSP(p) + OD_V); const u16* G = (const u16*)(WSP(p) + OD_G);
    const u16* AF = (const u16*)(WSP(p) + OD_AF); const u16* AB = (const u16*)(WSP(p) + OD_AB); const u16* KPa = (const u16*)(WSP(p) + OD_KP);
    u16* O = (u16*)(WSP(p) + WS_XA);
    const int c = lane * 8;
    float lnw[8], lnb[8], rk[8], kav[8];
#pragma unroll
    for (int i = 0; i < 8; ++i) { lnw[i] = INP(p, I_LNW)[j * 512 + c + i]; lnb[i] = INP(p, I_LNB)[j * 512 + c + i]; rk[i] = INP(p, I_RK)[j * 512 + c + i]; kav[i] = INP(p, I_KA)[j * 512 + c + i]; }
    for (int rowb = gw * 2; rowb < T_TOK; rowb += nw * 2) {
        uint4 q[2][8];
#pragma unroll
        for (int r = 0; r < 2; ++r) {
            const size_t o = (size_t)(rowb + r) * 512 + c;
            q[r][0] = *(const uint4*)(CYF + o); q[r][1] = *(const uint4*)(CYB + o); q[r][2] = *(const uint4*)(AF + o); q[r][3] = *(const uint4*)(AB + o);
            q[r][4] = *(const uint4*)(R + o); q[r][5] = *(const uint4*)(KPa + o); q[r][6] = *(const uint4*)(V + o); q[r][7] = *(const uint4*)(G + o);
        }
#pragma unroll
        for (int r = 0; r < 2; ++r) {
            const size_t row = rowb + r;
            float y[8], t[8], t2[8], out[8];
            UNPACK8_BF(q[r][0], y); UNPACK8_BF(q[r][1], t);
            float sm = 0.f;
#pragma unroll
            for (int i = 0; i < 8; ++i) { y[i] += t[i]; sm += y[i]; }
            const float mean = red8(sm) * (1.f / 64.f);
            float sv = 0.f;
#pragma unroll
            for (int i = 0; i < 8; ++i) { y[i] -= mean; sv += y[i] * y[i]; }
            const float rstd = rsqrtf(red8(sv) * (1.f / 64.f) + 64e-5f);
            UNPACK8_BF(q[r][2], t); UNPACK8_BF(q[r][3], t2);
            float rr[8], kp8[8]; UNPACK8_BF(q[r][4], rr); UNPACK8_BF(q[r][5], kp8);
            float bs = 0.f;
#pragma unroll
            for (int i = 0; i < 8; ++i) bs = fmaf(rr[i] * kp8[i] * (2.f + (t[i] + t2[i] - 2.f) * kav[i]), rk[i], bs);
            bs = red8(bs);
            UNPACK8_BF(q[r][6], t); UNPACK8_BF(q[r][7], t2);
#pragma unroll
            for (int i = 0; i < 8; ++i) out[i] = (fmaf(y[i] * rstd, lnw[i], lnb[i]) + bs * t[i]) * t2[i];
            *(uint4*)(O + row * DM + c) = PACK8_BF(out);
        }
    }
}

template <class Epi, bool ALIGN = true>
__device__ __forceinline__ void run_gemm(unsigned char* lds, const u16* A, const u16* Bt, int N, int K, const Epi& E) {
    int Kr = K; asm volatile("" : "+s"(Kr));
    pg8::Gemm g{A, Bt, T_TOK, N, Kr, Kr, Kr}; pg8::StaticOrder S; S.init(T_TOK, N, (int)gridDim.x, obid());
    pg8::gemm_phase<Epi, pg8::StaticOrder, ALIGN, true>((PG8_LAS unsigned char*)lds, g, S, E);
}

__device__ __forceinline__ void run_phase(const Params& p, int layer, int ph, unsigned char* lds, const XcdBarrier& xbar) {
    const int j = layer >> 1; const bool even = (layer & 1) == 0;
    unsigned char* ws = WSP(p);
    u16* XA = (u16*)(ws + WS_XA);
    const float* hin = (layer == 0) ? INP(p, I_X) : OUTP(p);
    switch (ph) {
    case 0: if (PH_MASK & 1) {
        int item = obid(); const int gsz = gridDim.x;
        if (even) convert_weight(INP(p, I_EVIN) + (size_t)j * DM * 4112, DM, 4112, 4112, 0, (u16*)(ws + WS_WIN), EV_N, lds, item, gsz);
        else { convert_weight(INP(p, I_ODIN) + (size_t)j * DM * 2272, DM, 2272, 2048, 2, (u16*)(ws + WS_WIN), 2048, lds, item, gsz);
               convert_weight(INP(p, I_ODIN) + (size_t)j * DM * 2272, DM, 2272, 224, 3, (u16*)(ws + WS_WIN + 5 * MiB), 256, lds, item, gsz); }
        convert_weight((even ? INP(p, I_EVOUT) : INP(p, I_ODOUT)) + (size_t)j * DM * DM, DM, DM, DM, 0, (u16*)(ws + WS_WOUT), DM, lds, item, gsz);
        if (even || gsz != 256) {
        convert_weight(INP(p, I_FFI) + (size_t)layer * DM * 2 * DFF, DM, 2 * DFF, 2 * DFF, 1, (u16*)(ws + WS_WFI), 2 * DFF, lds, item, gsz);
        convert_weight(INP(p, I_FFO) + (size_t)layer * DFF * DM, DFF, DM, DM, 0, (u16*)(ws + WS_WFO), DM, lds, item, gsz);
        }
        if (!even) { convert_weight(INP(p, I_GLUW) + (size_t)j * 512 * 512, 512, 512, 512, 0, (u16*)(ws + WS_WGLU), 512, lds, item, gsz); build_lora_weight(p, j); }
        norm_rows_bf16(hin, INP(p, I_NMIX) + (size_t)layer * DM, XA);
    } break;
    case 1: if (PH_MASK & 2) {
        if (even) { EpiEven E{(u16*)(ws + WS_P), (float*)(ws + EV_DT), INP(p, I_HGLB), INP(p, I_M2DTB) + j * 16, j}; run_gemm(lds, XA, (const u16*)(ws + WS_WIN), 4096, DM, E); }
        else { EpiPlain E{(u16*)(ws + WS_P), OD_N, 0, 6, 224, 1 << 30}; run_gemm(lds, XA, (const u16*)(ws + WS_WIN), 2048, DM, E);
               EpiPlain E2{(u16*)(ws + WS_P), OD_N, 1536, 1 << 30, 0, 224}; run_gemm(lds, XA, (const u16*)(ws + WS_WIN + 5 * MiB), 256, DM, E2); }
    } break;
    case 2: if (!(PH_MASK & 4)) break; if (even) { even_conv(p, j); even_dt(p, j, lds); } else { odd_shift(p, j); xcd_barrier(xbar);
            EpiLora E{ws, INP(p, I_W0) + j * 1024, INP(p, I_A0) + j * 1024}; run_gemm<EpiLora, true>(lds, (const u16*)(ws + OD_XL), (const u16*)(ws + OD_BTL), 2560, 256, E); } break;
    case 3: if (!(PH_MASK & 8)) break; if (even) { hg_mma<1>(p, lds); m2_mma<1>(p, j, lds); } else { rw_mma<1>(p, j, lds); s5_weights(p, j, lds); } break;
    case 4: if (!(PH_MASK & 16)) break; if (even) even_carry(p); else {
            int Kr = 256; asm volatile("" : "+s"(Kr)); pg8::Gemm g{(const u16*)(ws + OD_A1), (const u16*)(ws + OD_BT0), 32768, 256, Kr, 512, 256}; S5Order S{(int)gridDim.x, obid()}; EpiXloc E{(float*)(ws + OD_XLOC)};
            pg8::gemm_phase<EpiXloc, S5Order, false, true>((PG8_LAS unsigned char*)lds, g, S, E); odd_carry(p, j, lds); } break;
    case 5: if (!(PH_MASK & 32)) break; if (even) { hg_mma<3>(p, lds); m2_mma<3>(p, j, lds); } else { rw_mma<3>(p, j, lds); s5_chunk_scan(p, j, lds); } break;
    case 6: if (!(PH_MASK & 64)) break; if (even) even_post(p, j); else { odd_post(p, j); __syncthreads();
            pg8::Gemm g{(const u16*)(ws + OD_A1), (const u16*)(ws + OD_BT1), 32768, 256, 512, 512, 512}; S5Order S{(int)gridDim.x, obid()}; EpiS5Out E{(u16*)(ws + OD_YG)};
            pg8::gemm_phase<EpiS5Out, S5Order, false, true>((PG8_LAS unsigned char*)lds, g, S, E); } break;
    case 7: if ((PH_MASK & 128) && !even) { EpiGlu E{(const u16*)(ws + OD_YG), INP(p, I_GLUB) + j * 512, XA}; run_gemm(lds, (const u16*)(ws + OD_YG), (const u16*)(ws + WS_WGLU), 512, 512, E);
        if (gridDim.x == 256 && obid() >= 128) {
            int item = obid() - 128;
            convert_weight(INP(p, I_FFI) + (size_t)layer * DM * 2 * DFF, DM, 2 * DFF, 2 * DFF, 1, (u16*)(ws + WS_WFI), 2 * DFF, lds, item, 128);
            convert_weight(INP(p, I_FFO) + (size_t)layer * DFF * DM, DFF, DM, DM, 0, (u16*)(ws + WS_WFO), DM, lds, item, 128);
        } } break;
    case 8: if (PH_MASK & 256) { EpiResid E{hin, OUTP(p)}; run_gemm(lds, XA, (const u16*)(ws + WS_WOUT), DM, DM, E); } break;
    case 9: if (PH_MASK & 512) norm_rows_bf16(OUTP(p), INP(p, I_NFFN) + (size_t)layer * DM, XA); break;
    case 10: if (PH_MASK & 1024) { EpiFfn E{(u16*)(ws + WS_ACT)}; run_gemm(lds, XA, (const u16*)(ws + WS_WFI), 2 * DFF, DM, E); } break;
    case 11: if (PH_MASK & 2048) { EpiResid E{OUTP(p), OUTP(p)}; run_gemm(lds, (const u16*)(ws + WS_ACT), (const u16*)(ws + WS_WFO), DM, DFF, E); } break;
    default: break;
    }
}

__global__ void __launch_bounds__(512, 2) fwd_kernel(Params p) {
    extern __shared__ __attribute__((aligned(16))) unsigned char lds[];
    volatile LAS unsigned* xst = (volatile LAS unsigned*)(lds + LDS_BYTES - 64);
    if (otid() < 2) xst[otid()] = 0u;
    __syncthreads();
    const XcdBarrier xbar = xcd_barrier_post((unsigned*)(p.ws + WS_BAR), xst);
#ifdef REP_LO
    int rep = 0;
#endif
    for (int gp = p.lo; gp < p.hi; ++gp) {
        const int layer = gp / 12, ph = gp % 12;
        if (gp == 48) { norm_rows_f32_inplace(OUTP(p), INP(p, I_NFIN)); break; }
        if (ph == 7 && (layer & 1) == 0) continue;
        run_phase(p, layer, ph, lds, xbar);
        if (gp + 1 < p.hi) xcd_barrier(xbar);
#ifdef REP_LO
        if (ph == REP_HI) { if (rep == 0) { rep = 1; gp -= (REP_HI - REP_LO + 1); } else rep = 0; }
#endif
    }
}

extern "C" void kernel_launch(void* const* d_in, const int* in_sizes, int n_in, void* d_out, int out_size, void* d_ws, size_t ws_size, hipStream_t stream) {
    static int grid = 0;
    if (grid == 0) {
        if (n_in != 39 || out_size != T_TOK * DM || ws_size < WS_NEED) { fprintf(stderr, "kernel_launch: unexpected problem (n_in %d out %d ws %zu)\n", n_in, out_size, ws_size); grid = -1; return; }
        int dev = 0, cus = 0, per_cu = 0;
        hipGetDevice(&dev); hipDeviceGetAttribute(&cus, hipDeviceAttributeMultiprocessorCount, dev);
        if (hipFuncSetAttribute((const void*)fwd_kernel, hipFuncAttributeMaxDynamicSharedMemorySize, LDS_BYTES) != hipSuccess) { fprintf(stderr, "kernel_launch: hipFuncSetAttribute failed\n"); grid = -1; return; }
        if (hipOccupancyMaxActiveBlocksPerMultiprocessor(&per_cu, (const void*)fwd_kernel, 512, LDS_BYTES) != hipSuccess || per_cu < 1) { fprintf(stderr, "kernel_launch: occupancy query gave %d\n", per_cu); per_cu = 1; }
        (void)hipGetLastError();
        grid = cus * 1;
        fprintf(stderr, "kernel_launch: grid %d (cus %d, per_cu %d)\n", grid, cus, per_cu);
    }
    if (grid < 0) return;
    if (hipMemsetAsync((unsigned char*)d_ws + WS_BAR, 0, XCD_BAR_WORDS * 4, stream) != hipSuccess) { fprintf(stderr, "kernel_launch: memset failed\n"); return; }
    Params p{};
    for (int i = 0; i < 39; ++i) p.in[i] = (const float*)d_in[i];
    p.out = (float*)d_out; p.ws = (unsigned char*)d_ws;
#if ONE_LAUNCH
    p.lo = 0; p.hi = 49;
    void* args[] = {&p};
    hipError_t e = hipLaunchCooperativeKernel((const void*)fwd_kernel, dim3(grid), dim3(512), args, LDS_BYTES, stream);
    if (e != hipSuccess) fprintf(stderr, "cooperative launch failed: %s (grid %d)\n", hipGetErrorString(e), grid);
#else
    for (int gp = 0; gp < 49; ++gp) {
        if (gp != 48 && (gp % 12) == 7 && ((gp / 12) & 1) == 0) continue;
        p.lo = gp; p.hi = gp + 1;
        hipLaunchKernelGGL(fwd_kernel, dim3(grid), dim3(512), LDS_BYTES, stream, p);
    }
#endif
}
```
